# Optimizing an MI355X kernel written in HIP

```python
import jax, jax.numpy as jnp
from jax import lax
import numpy as np

D_MODEL = 4096
BATCH = 2
SEQ = 4096
DEPTH = 2

CTX_LEN = 256
GRID_W = 64
HEAD_DIM = 128
A_HEADS = 8
A_KV_HEADS = 2
WINDOW = 128
B_HEADS = 8
B_KV_HEADS = 2
C_HEADS = 8
RET_DK = 128
RET_DV = 128
RET_CHUNK = 128
ATTN_BLOCK = 128
N_BRANCH = 3
BRANCH_W = 1024
D_FF = 11008
CONV_WIDTH = 3
ROPE_BASE = 10000.0
LN_EPS = 1e-5
RMS_EPS = 1e-6
GN_EPS = 1e-5
NEG_INF = -1e30
DEEPNORM_ALPHA = (2 * DEPTH) ** 0.25
DEEPNORM_BETA = (8 * DEPTH) ** -0.25
IN_SIZES = (A_HEADS * HEAD_DIM, A_KV_HEADS * HEAD_DIM, A_KV_HEADS * HEAD_DIM,
            B_HEADS * HEAD_DIM, B_KV_HEADS * HEAD_DIM, B_KV_HEADS * HEAD_DIM,
            C_HEADS * RET_DK, C_HEADS * RET_DK, C_HEADS * RET_DV, C_HEADS * RET_DV,
            N_BRANCH * D_MODEL)
IN_WIDTH = sum(IN_SIZES)

kernel_name = 'hybrid_parallel_mixer_flow_block'


def layer_norm(x, g, b):
    xf = x.astype(jnp.float32)
    mu = jnp.mean(xf, axis=-1, keepdims=True)
    var = jnp.mean(jnp.square(xf - mu), axis=-1, keepdims=True)
    y = (xf - mu) * lax.rsqrt(var + LN_EPS) * g.astype(jnp.float32) + b.astype(jnp.float32)
    return y.astype(x.dtype)


def rms_norm(x, g):
    xf = x.astype(jnp.float32)
    y = xf * lax.rsqrt(jnp.mean(jnp.square(xf), axis=-1, keepdims=True) + RMS_EPS) * g.astype(jnp.float32)
    return y.astype(x.dtype)


def head_group_norm(o, g):
    mu = jnp.mean(o, axis=-1, keepdims=True)
    var = jnp.mean(jnp.square(o - mu), axis=-1, keepdims=True)
    y = (o - mu) * lax.rsqrt(var + GN_EPS)
    return y.reshape(o.shape[:-2] + (-1,)) * g.astype(jnp.float32)


def split_cols(p, sizes):
    out, start = [], 0
    for n in sizes:
        out.append(p[..., start:start + n])
        start += n
    return out


def split_heads(t, n):
    return t.reshape(t.shape[:-1] + (n, t.shape[-1] // n))


def group_q(t, n_kv):
    return t.reshape(t.shape[:-2] + (n_kv, t.shape[-2] // n_kv, t.shape[-1]))


def flip_t(t):
    return t[:, ::-1]


def rope_half(x, cos, sin):
    half = x.shape[-1] // 2
    x1, x2 = x[..., :half], x[..., half:]
    cos = cos.astype(x.dtype)
    sin = sin.astype(x.dtype)
    return jnp.concatenate([x1 * cos - x2 * sin, x2 * cos + x1 * sin], axis=-1)


def axial_rope(x, cos_r, sin_r, cos_c, sin_c):
    half = x.shape[-1] // 2
    return jnp.concatenate([rope_half(x[..., :half], cos_r, sin_r),
                            rope_half(x[..., half:], cos_c, sin_c)], axis=-1)


def dense_attn(q, k, v, sink=None):
    s = jnp.einsum('bqhgd,bkhd->bhgqk', q, k).astype(jnp.float32) * (q.shape[-1] ** -0.5)
    if sink is not None:
        s_sink = jnp.broadcast_to(sink.astype(jnp.float32)[None, :, :, None, None], s.shape[:-1] + (1,))
        s = jnp.concatenate([s, s_sink], axis=-1)
    p = jax.nn.softmax(s, axis=-1)
    if sink is not None:
        p = p[..., :-1]
    return jnp.einsum('bhgqk,bkhd->bqhgd', p.astype(v.dtype), v)


def blocked_attn(q, k, v):
    B, S, KV, G, d = q.shape
    nb = S // ATTN_BLOCK
    qb = jnp.moveaxis(q.reshape(B, nb, ATTN_BLOCK, KV, G, d), 1, 0)
    ob = lax.map(lambda qi: dense_attn(qi, k, v), qb)
    return jnp.moveaxis(ob, 0, 1).reshape(B, S, KV * G * d)


def window_attn(q, k, v, kc, vc, sink):
    B, S, KV, G, d = q.shape
    nb = S // ATTN_BLOCK
    halo = -(-WINDOW // ATTN_BLOCK)
    pad = halo * ATTN_BLOCK
    qb = q.reshape(B, nb, ATTN_BLOCK, KV, G, d)

    def band(t):
        tp = jnp.pad(t, ((0, 0), (pad, pad), (0, 0), (0, 0))).reshape(B, nb + 2 * halo, ATTN_BLOCK, KV, d)
        return jnp.concatenate([tp[:, j:j + nb] for j in range(2 * halo + 1)], axis=2)

    kb, vb = band(k), band(v)
    n_kb = kb.shape[2]
    qpos = jnp.arange(nb)[:, None] * ATTN_BLOCK + jnp.arange(ATTN_BLOCK)[None, :]
    kpos = (jnp.arange(nb)[:, None] - halo) * ATTN_BLOCK + jnp.arange(n_kb)[None, :]
    valid = ((jnp.abs(qpos[:, :, None] - kpos[:, None, :]) <= WINDOW)
             & (kpos[:, None, :] >= 0) & (kpos[:, None, :] < S))
    scale = d ** -0.5
    s_loc = jnp.einsum('bnqhgd,bnkhd->bnhgqk', qb, kb).astype(jnp.float32) * scale
    s_loc = jnp.where(valid[None, :, None, None], s_loc, NEG_INF)
    s_ctx = jnp.einsum('bnqhgd,bkhd->bnhgqk', qb, kc).astype(jnp.float32) * scale
    s_sink = jnp.broadcast_to(sink.astype(jnp.float32)[None, None, :, :, None, None], s_ctx.shape[:-1] + (1,))
    p = jax.nn.softmax(jnp.concatenate([s_loc, s_ctx, s_sink], axis=-1), axis=-1).astype(v.dtype)
    n_ctx = kc.shape[1]
    o = (jnp.einsum('bnhgqk,bnkhd->bnqhgd', p[..., :n_kb], vb)
         + jnp.einsum('bnhgqk,bkhd->bnqhgd', p[..., n_kb:n_kb + n_ctx], vc))
    return o.reshape(B, S, KV * G * d)


def retention_scan(q, k, v, log_gamma, state0, inclusive):
    B, T, H, _ = q.shape
    dv = v.shape[-1]
    C = RET_CHUNK
    n = T // C

    def chunks(t):
        return jnp.moveaxis(t.reshape(B, n, C, H, t.shape[-1]), 1, 0).transpose(0, 1, 3, 2, 4)

    pos = jnp.arange(C, dtype=jnp.float32)
    diff = pos[:, None] - pos[None, :]
    mask = (diff >= 0) if inclusive else (diff > 0)
    d_intra = jnp.where(mask, jnp.exp(log_gamma[:, None, None] * jnp.maximum(diff, 0.0)), 0.0)
    d_q = jnp.exp(log_gamma[:, None] * (pos + 1.0))[..., None]
    d_k = jnp.exp(log_gamma[:, None] * (C - 1.0 - pos))[..., None]
    d_c = jnp.exp(log_gamma * C)[:, None, None]

    def step(state, qkv):
        qi, ki, vi = qkv
        att = jnp.einsum('bhqd,bhkd->bhqk', qi, ki) * d_intra
        o = (jnp.einsum('bhqk,bhkv->bhqv', att, vi)
             + jnp.einsum('bhqd,bhdv->bhqv', qi, state) * d_q)
        state = state * d_c + jnp.einsum('bhkd,bhkv->bhdv', ki * d_k, vi)
        return state, o

    state, o = lax.scan(step, state0, (chunks(q), chunks(k), chunks(v)))
    o = o.transpose(1, 0, 3, 2, 4).reshape(B, T, H, dv)
    return o, state


def gated_merge(gl, y_a, y_b, y_c, b_gate, w_branch, w_o):
    g = jax.nn.sigmoid((gl + b_gate).astype(jnp.float32)).astype(gl.dtype)
    g = g.reshape(g.shape[:-1] + (N_BRANCH, -1))
    m = (g[..., 0, :] * (y_a @ w_branch[0]) + g[..., 1, :] * (y_b @ w_branch[1])
         + g[..., 2, :] * (y_c @ w_branch[2]))
    return m @ w_o


def hybrid_mixer(h, hc, rope, w_in, b_gate, w_branch, w_o, sink, q_norm_g, k_norm_g,
                 ret_decay, ret_gn_g, with_ctx_out):
    B, S, _ = h.shape
    L = hc.shape[1]
    f32 = jnp.float32
    qa, ka, va, qb, kb, vb, qr, kr, vr, gr, gl = split_cols(h @ w_in, IN_SIZES)
    qa_c, ka_c, va_c, qb_c, kb_c, vb_c, qr_c, kr_c, vr_c, gr_c, gl_c = split_cols(hc @ w_in, IN_SIZES)

    sink_a = sink.reshape(A_KV_HEADS, A_HEADS // A_KV_HEADS)
    qa = group_q(axial_rope(split_heads(qa, A_HEADS), *rope), A_KV_HEADS)
    ka = axial_rope(split_heads(ka, A_KV_HEADS), *rope)
    va = split_heads(va, A_KV_HEADS)
    ka_c, va_c = split_heads(ka_c, A_KV_HEADS), split_heads(va_c, A_KV_HEADS)
    y_a = window_attn(qa, ka, va, ka_c, va_c, sink_a)

    qb = group_q(axial_rope(rms_norm(split_heads(qb, B_HEADS), q_norm_g), *rope), B_KV_HEADS)
    kb = axial_rope(rms_norm(split_heads(kb, B_KV_HEADS), k_norm_g), *rope)
    kb_c = rms_norm(split_heads(kb_c, B_KV_HEADS), k_norm_g)
    vb_c = split_heads(vb_c, B_KV_HEADS)
    k_all = jnp.concatenate([kb_c, kb], axis=1)
    v_all = jnp.concatenate([vb_c, split_heads(vb, B_KV_HEADS)], axis=1)
    y_b = blocked_attn(qb, k_all, v_all)

    log_gamma = -jnp.exp(ret_decay.astype(f32))
    k_scale = RET_DK ** -0.5
    qr = axial_rope(split_heads(qr, C_HEADS), *rope).astype(f32)
    kr = axial_rope(split_heads(kr, C_HEADS), *rope).astype(f32) * k_scale
    vr = split_heads(vr, C_HEADS).astype(f32)
    qr_c = split_heads(qr_c, C_HEADS).astype(f32)
    kr_c = split_heads(kr_c, C_HEADS).astype(f32) * k_scale
    vr_c = split_heads(vr_c, C_HEADS).astype(f32)
    zero = jnp.zeros((B, C_HEADS, RET_DK, RET_DV), f32)
    oc_f, st_f = retention_scan(qr_c, kr_c, vr_c, log_gamma[0], zero, True)
    oc_b, st_b = retention_scan(flip_t(qr_c), flip_t(kr_c), flip_t(vr_c), log_gamma[1], zero, False)
    o_f, _ = retention_scan(qr, kr, vr, log_gamma[0], st_f, True)
    o_b, _ = retention_scan(flip_t(qr), flip_t(kr), flip_t(vr), log_gamma[1], st_b, False)
    y_c = (jax.nn.silu(gr.astype(f32)) * head_group_norm(o_f + flip_t(o_b), ret_gn_g)).astype(h.dtype)

    out = gated_merge(gl, y_a, y_b, y_c, b_gate, w_branch, w_o)
    if not with_ctx_out:
        return out, None
    qa_c = group_q(split_heads(qa_c, A_HEADS), A_KV_HEADS)
    y_a_c = dense_attn(qa_c, ka_c, va_c, sink_a).reshape(B, L, -1)
    qb_c = group_q(rms_norm(split_heads(qb_c, B_HEADS), q_norm_g), B_KV_HEADS)
    y_b_c = dense_attn(qb_c, kb_c, vb_c).reshape(B, L, -1)
    y_c_c = (jax.nn.silu(gr_c.astype(f32)) * head_group_norm(oc_f + flip_t(oc_b), ret_gn_g)).astype(hc.dtype)
    out_c = gated_merge(gl_c, y_a_c, y_b_c, y_c_c, b_gate, w_branch, w_o)
    return out, out_c


def depthwise_conv(z, w, b):
    T = z.shape[1]
    r = CONV_WIDTH // 2
    zp = jnp.pad(z, ((0, 0), (r, CONV_WIDTH - 1 - r), (0, 0)))
    out = b
    for j in range(CONV_WIDTH):
        out = out + zp[:, j:j + T] * w[j]
    return out


def conv_ffn(h, w_up, conv_w, conv_b, w_down):
    gate_pre, up = jnp.split(h @ w_up, 2, axis=-1)
    a = jax.nn.silu(depthwise_conv(gate_pre, conv_w, conv_b)) * up
    return a @ w_down


def setup_inputs(seed: int = 0) -> dict:
    key = jax.random.key(seed)
    ks = jax.random.split(key, 24)
    f32 = jnp.float32

    def nrm(k, shape, scale):
        return jax.random.normal(k, shape, f32) * scale

    heads = jnp.arange(C_HEADS, dtype=f32)
    decay0 = jnp.log(-jnp.log1p(-jnp.exp2(-5.0 - heads)))
    return {
        'x': nrm(ks[0], (BATCH, SEQ, D_MODEL), 1.0),
        'c': nrm(ks[1], (BATCH, D_MODEL), 1.0),
        'ctx': nrm(ks[2], (BATCH, CTX_LEN, D_MODEL), 1.0),
        'c_ctx': nrm(ks[3], (D_MODEL,), 1.0),
        'w_mod': nrm(ks[4], (DEPTH, D_MODEL, 6 * D_MODEL), 0.5 * D_MODEL ** -0.5),
        'b_mod': nrm(ks[5], (DEPTH, 6 * D_MODEL), 0.02),
        'w_in': nrm(ks[6], (DEPTH, D_MODEL, IN_WIDTH), D_MODEL ** -0.5),
        'b_gate': nrm(ks[7], (DEPTH, N_BRANCH * D_MODEL), 0.02),
        'w_branch': nrm(ks[8], (DEPTH, N_BRANCH, BRANCH_W, D_MODEL), BRANCH_W ** -0.5),
        'w_o': nrm(ks[9], (DEPTH, D_MODEL, D_MODEL), DEEPNORM_BETA * D_MODEL ** -0.5),
        'attn_sink': nrm(ks[10], (DEPTH, A_HEADS), 0.5),
        'q_norm_g': 1.0 + nrm(ks[11], (DEPTH, HEAD_DIM), 0.05),
        'k_norm_g': 1.0 + nrm(ks[12], (DEPTH, HEAD_DIM), 0.05),
        'ret_decay': decay0 + nrm(ks[13], (DEPTH, 2, C_HEADS), 0.05),
        'ret_gn_g': 1.0 + nrm(ks[14], (DEPTH, C_HEADS * RET_DV), 0.05),
        'ln1_g': 1.0 + nrm(ks[15], (DEPTH, D_MODEL), 0.05),
        'ln1_b': nrm(ks[16], (DEPTH, D_MODEL), 0.02),
        'w_up': nrm(ks[17], (DEPTH, D_MODEL, 2 * D_FF), D_MODEL ** -0.5),
        'ffn_conv_w': nrm(ks[18], (DEPTH, CONV_WIDTH, D_FF), CONV_WIDTH ** -0.5),
        'ffn_conv_b': nrm(ks[19], (DEPTH, D_FF), 0.02),
        'w_down': nrm(ks[20], (DEPTH, D_FF, D_MODEL), DEEPNORM_BETA * D_FF ** -0.5),
        'ln2_g': 1.0 + nrm(ks[21], (DEPTH, D_MODEL), 0.05),
        'ln2_b': nrm(ks[22], (DEPTH, D_MODEL), 0.02),
    }


def reference(x, c, ctx, c_ctx, w_mod, b_mod, w_in, b_gate, w_branch, w_o, attn_sink, q_norm_g,
              k_norm_g, ret_decay, ret_gn_g, ln1_g, ln1_b, w_up, ffn_conv_w, ffn_conv_b, w_down,
              ln2_g, ln2_b):
    f32 = jnp.float32
    S = x.shape[1]
    ROWS = S // GRID_W
    r_idx, c_idx = jnp.meshgrid(jnp.arange(ROWS, dtype=f32), jnp.arange(GRID_W, dtype=f32), indexing='ij')
    axis_dim = HEAD_DIM // 2
    inv_freq = ROPE_BASE ** (-jnp.arange(0, axis_dim, 2, dtype=f32) / axis_dim)
    ang_r = r_idx.reshape(-1)[:, None] * inv_freq
    ang_c = c_idx.reshape(-1)[:, None] * inv_freq
    rope = (jnp.cos(ang_r)[:, None, :], jnp.sin(ang_r)[:, None, :],
            jnp.cos(ang_c)[:, None, :], jnp.sin(ang_c)[:, None, :])

    lat, cx = x, ctx
    for l in range(DEPTH):
        last = l == DEPTH - 1
        sh1, sc1, g1, sh2, sc2, g2 = [m[:, None, :] for m in
                                      jnp.split(jax.nn.silu(c) @ w_mod[l] + b_mod[l], 6, axis=-1)]
        csh1, csc1, cg1, csh2, csc2, cg2 = jnp.split(jax.nn.silu(c_ctx) @ w_mod[l] + b_mod[l], 6, axis=-1)

        y, y_ctx = hybrid_mixer(lat * (1 + sc1) + sh1, cx * (1 + csc1) + csh1, rope,
                                w_in[l], b_gate[l], w_branch[l], w_o[l], attn_sink[l],
                                q_norm_g[l], k_norm_g[l], ret_decay[l], ret_gn_g[l], not last)
        lat = layer_norm(DEEPNORM_ALPHA * lat + g1 * y, ln1_g[l], ln1_b[l])
        lat = layer_norm(DEEPNORM_ALPHA * lat
                         + g2 * conv_ffn(lat * (1 + sc2) + sh2, w_up[l], ffn_conv_w[l], ffn_conv_b[l], w_down[l]),
                         ln2_g[l], ln2_b[l])
        if not last:
            cx = layer_norm(DEEPNORM_ALPHA * cx + cg1 * y_ctx, ln1_g[l], ln1_b[l])
            cx = layer_norm(DEEPNORM_ALPHA * cx
                            + cg2 * conv_ffn(cx * (1 + csc2) + csh2, w_up[l], ffn_conv_w[l], ffn_conv_b[l], w_down[l]),
                            ln2_g[l], ln2_b[l])
    return lat
```

```cpp
#include <hip/hip_runtime.h>
#include <cstdio>
#include <cstdint>

#ifndef MK_PER_PHASE
#define MK_PER_PHASE 0
#endif
#ifndef XORDER
#define XORDER 1
#endif
#ifndef SK8_DN
#define SK8_DN 1
#endif
#ifndef SK8_IN
#define SK8_IN 1
#endif
#ifndef SK8_WO
#define SK8_WO 0
#endif
#ifndef SK_ENABLE
#define SK_ENABLE 0
#endif

#define LAS __attribute__((address_space(3)))
#define GAS __attribute__((address_space(1)))
typedef _Float16 f16;
typedef _Float16 h8 __attribute__((ext_vector_type(8)));
typedef _Float16 h4 __attribute__((ext_vector_type(4)));
typedef _Float16 h2 __attribute__((ext_vector_type(2)));
typedef short s16x4 __attribute__((ext_vector_type(4)));
typedef float f32x2 __attribute__((ext_vector_type(2)));
typedef float f32x4 __attribute__((ext_vector_type(4)));
typedef float f32x16 __attribute__((ext_vector_type(16)));
typedef unsigned u32x2 __attribute__((ext_vector_type(2)));
typedef unsigned u32x4 __attribute__((ext_vector_type(4)));

constexpr int DM = 4096, NBATCH = 2, SEQ = 4096, CTXL = 256, NLAT = NBATCH * SEQ, NCTX = NBATCH * CTXL, MTOT = NLAT + NCTX;
constexpr int HD = 128, INW = 19456, DFF = 11008, NMOD = 6 * DM;
constexpr int QA_OFF = 0, KA_OFF = 1024, VA_OFF = 1280, QB_OFF = 1536, KB_OFF = 2560, VB_OFF = 2816, QR_OFF = 3072, KR_OFF = 4096, VR_OFF = 5120, GR_OFF = 6144, GL_OFF = 7168;
constexpr float LN_EPS = 1e-5f, RMS_EPS = 1e-6f, GN_EPS = 1e-5f;
constexpr float DN_ALPHA = 1.4142135623730951f;
constexpr float ATT_SCALE = 0.088388347648318440f;
constexpr int NCHUNK = 68;

constexpr size_t MiB = 1u << 20;
constexpr size_t WS_CTL = 0, CTL_ZERO_BYTES = 1 * MiB;
constexpr size_t WS_MOD = 1 * MiB;
constexpr size_t WS_ROPE = 2 * MiB;
constexpr size_t WS_WIN = 4 * MiB, SZ_WIN = 152 * MiB;
constexpr size_t WS_WBR = 308 * MiB, SZ_WBR = 24 * MiB;
constexpr size_t WS_WO = 356 * MiB, SZ_WO = 32 * MiB;
constexpr size_t WS_WUP = 420 * MiB, SZ_WUP = 172 * MiB;
constexpr size_t WS_WDN = 764 * MiB, SZ_WDN = 86 * MiB;
constexpr size_t WS_H = 936 * MiB;
constexpr size_t WS_P = 1004 * MiB;
constexpr size_t WS_Y = 1370 * MiB, SZ_Y1 = 17 * MiB;
constexpr size_t WS_MF = 1421 * MiB;
constexpr size_t WS_MH = 1557 * MiB;
constexpr size_t WS_Z = 1625 * MiB;
constexpr size_t WS_LAT = 1761 * MiB;
constexpr size_t WS_ACT = 1897 * MiB;
constexpr size_t WS_UT = 2080 * MiB;
constexpr size_t WS_ST = 2148 * MiB;
constexpr size_t WS_SLAB = 2182 * MiB;
constexpr size_t WS_GLT = 2246 * MiB;
constexpr size_t WS_END = 2450 * MiB;
static_assert(WS_WIN + 2 * SZ_WIN <= WS_WBR && WS_WBR + 2 * SZ_WBR <= WS_WO && WS_WO + 2 * SZ_WO <= WS_WUP && WS_WUP + 2 * SZ_WUP <= WS_WDN && WS_WDN + 2 * SZ_WDN <= WS_H, "ws map");
static_assert(WS_P + (size_t)MTOT * 22016 * 2 <= WS_Y && WS_ACT + (size_t)MTOT * DFF * 2 <= WS_UT, "ws map");
constexpr int CW_Q = 512, CW_QD = 1024;
constexpr int CW_BAR = 4096;
constexpr int CW_LN = 60000, LN_BANK = 64 * 34;
constexpr int CW_SK = 16384, SK_BANK = 4096;
static_assert((CW_SK + 10 * SK_BANK) * 4 <= (int)CTL_ZERO_BYTES && CW_SK + 10 * SK_BANK <= CW_LN && (CW_LN + 4 * LN_BANK) * 4 <= (int)CTL_ZERO_BYTES, "ctl");

constexpr int RING_BYTES = 131072, MISC_OFF = RING_BYTES + 320, LDS_BYTES = 147456;

__device__ __forceinline__ unsigned pkh(float lo, float hi) { h2 v = __builtin_convertvector((f32x2){lo, hi}, h2); return __builtin_bit_cast(unsigned, v); }
__device__ __forceinline__ float wave_sum(float v) {
#pragma unroll
    for (int o = 1; o < 64; o <<= 1) v += __shfl_xor(v, o);
    return v;
}
__device__ __forceinline__ float sigmoidf_(float x) { return __builtin_amdgcn_rcpf(1.0f + __expf(-x)); }
__device__ __forceinline__ int tid_of(int wave0) { return (wave0 << 6) | (int)__builtin_amdgcn_mbcnt_hi(~0u, __builtin_amdgcn_mbcnt_lo(~0u, 0u)); }
#define LDS_WAIT() asm volatile("s_waitcnt lgkmcnt(0)" ::: "memory")
#define VM_WAIT() asm volatile("s_waitcnt vmcnt(0)" ::: "memory")

struct Args {
    const float *x, *c, *ctx, *c_ctx, *w_mod, *b_mod, *w_in, *b_gate, *w_branch, *w_o, *attn_sink, *q_norm_g, *k_norm_g, *ret_decay, *ret_gn_g, *ln1_g, *ln1_b, *w_up, *conv_w, *conv_b, *w_down, *ln2_g, *ln2_b;
    float* out; unsigned char* ws; int ph_lo, ph_hi, li, pad;
};

namespace pg8 {
constexpr int BM = 256, BK = 64, HALF = 128, HTB = HALF * BK * 2, STAGE_BYTES = 8 * HTB, NXCD = 8, WGM = 4;
__host__ __device__ __forceinline__ int lds_byte(int r, int c) { const int st = (r >> 4) * 2 + (c >> 5), rr = r & 15, cc = c & 31, ob = rr * 64 + cc * 2; return st * 1024 + (ob ^ (((ob >> 9) & 1) << 5)); }
__host__ __device__ __forceinline__ void stage_rc(int b, int& R, int& C) { const int st = b / 1024, sb = b % 1024, swz = sb ^ (((sb >> 9) & 1) << 5); R = (st >> 1) * 16 + swz / 64; C = (st & 1) * 32 + (swz % 64) / 2; }
__host__ __device__ __forceinline__ int perm32(int rho) { const int n = rho >> 4, i = rho & 15; return 8 * (i >> 2) + 4 * n + (i & 3); }
struct Unit { int pm, pn, k0, nt, sl, ns, rid; };
struct Gemm { const f16* A; const f16* Bt; int M, N, K; };
struct SKCtx { float* slab; unsigned* cnt; };
struct SKOrder {
    int nM, nN, nwg, G, c, nfull, R, ns, npairs, nextra, lnord, sk8, restcap;
    __device__ __forceinline__ void init(int M, int N, int K, int G_, int c_, int nextra_ = 0, int lnord_ = 0, int sk8_ = 0, int restcap_ = 1 << 30) { lnord = lnord_; sk8 = sk8_; restcap = restcap_; nM = M / BM; nN = N / BM; nwg = nM * nN; G = G_; asm volatile("" : "+s"(G)); c = c_; nextra = nextra_; nfull = (nwg / G) * G; R = nwg - nfull; npairs = K / 128;
        ns = 1; if (R > 0 && SK_ENABLE && nextra == 0) { ns = G / R; const int cap = npairs / 2; if (ns > cap) ns = cap; if (ns > 16) ns = 16; if (ns < 1) ns = 1; } }
    __device__ __forceinline__ bool next_x(int i, Unit& u) const {
        const int x = c & 7, w = c >> 3, nfullc = nN >> 3, remc = nN & 7;
        const int nrest = (nM - 32) * nN + nextra;
        const bool mainu = i < nfullc || (i == nfullc && (w >> 2) < remc);
        int r = 0;
        if (!mainu) { if (remc > 0) r = (i == nfullc) ? x * (4 * (8 - remc)) + (w - 4 * remc) : 32 * (8 - remc) + (i - nfullc - 1) * 256 + c; else r = (i - nfullc) * 256 + c; }
        const int t = (r >> 1) % 12;
        const int rpn = nextra > 0 ? (t < 2 ? 4 + t : (t < 4 ? 8 + t : 12 + t)) : (r >> 1);
        u.pm = mainu ? 4 * x + (w & 3) : 32 + (r & 1); u.pn = mainu ? 8 * i + (w >> 2) : rpn;
        if (lnord && mainu) { u.pm = 8 * (x >> 1) + 4 * i + (w & 3); u.pn = 8 * (x & 1) + (w >> 2); }
        u.k0 = 0; u.nt = 2 * npairs; u.sl = 0; u.ns = 1; u.rid = 0;
        return mainu || (r < nrest && r < restcap);
    }
    __device__ __forceinline__ bool next(int i, Unit& u) const {
        if (XORDER && G == 256 && nM >= 32 && nM <= 34 && !SK_ENABLE) return next_x(i, u);
        const long L = (long)i * G + c;
        const bool ok = L < (long)(nwg + nextra);
        const bool ext = L >= nwg;
        int wgid = ok && !ext ? (int)L : 0;
        int sl = 0, nsl = 1, rid = 0, k0 = 0, ntl = 2 * npairs;
#if SK_ENABLE
        if (ok && !ext && L >= nfull && ns > 1) { const int j = (int)(L - nfull); const int r = j / ns; sl = j - r * ns; wgid = nfull + r; nsl = ns; rid = r;
            const int p0 = (int)((long)sl * npairs / ns), p1 = (int)((long)(sl + 1) * npairs / ns); k0 = p0 * 128; ntl = 2 * (p1 - p0); }
#endif
        { const int q = nwg / NXCD, r = nwg % NXCD, xcd = wgid % NXCD, off = wgid / NXCD; wgid = (xcd < r ? xcd * (q + 1) : r * (q + 1) + (xcd - r) * q) + off; }
        const int nig = WGM * nN, gid = wgid / nig, fm = gid * WGM, gsz = (nM - fm) < WGM ? (nM - fm) : WGM;
        int pm = fm + ((wgid % nig) % gsz), pn = (wgid % nig) / gsz;
        const int e = ext ? (int)(L - nwg) : 0, t = e % 12;
        if (ext) { pm = 32 + e / 12; pn = t < 2 ? 4 + t : (t < 4 ? 8 + t : 12 + t); }
        u.pm = pm; u.pn = pn; u.k0 = k0; u.nt = ntl; u.sl = sl; u.ns = nsl; u.rid = rid;
        return ok;
    }
};
struct SK8Order {
    int c, npairs, r0, ntiles;
    __device__ __forceinline__ void init(int K, int c_, int r0_ = 0, int ntiles_ = 32) { c = c_; npairs = K / 128; r0 = r0_; ntiles = ntiles_; }
    __device__ __forceinline__ bool next(int i, Unit& u) const {
        const int rr = c >> 3, r = r0 + rr, sl = c & 7, p0 = sl * npairs / 8, p1 = (sl + 1) * npairs / 8;
        u.pm = 32 + (r & 1); u.pn = r >> 1; u.k0 = p0 * 128; u.nt = 2 * (p1 - p0); u.sl = sl; u.ns = 8; u.rid = rr;
        return i == 0 && rr < ntiles;
    }
};
struct EpiF16 {
    static constexpr bool PERM = true, HOOK = false, SK = false;
    f16* O; int ldc;
    __device__ __forceinline__ void pre(f32x4 (&)[2][2][4][2], const Unit&, int, int, int, int) const {}
    __device__ __forceinline__ void operator()(const f32x4 (&acc)[2][2][4][2], const Unit& u, int wr, int wc, int fr, int fq) const {
        const int row0 = u.pm * BM + wr * 64 + fr, col0 = u.pn * BM + wc * 32 + 8 * fq;
#pragma unroll
        for (int ai = 0; ai < 2; ++ai)
#pragma unroll
            for (int m = 0; m < 4; ++m) { f16* rowp = O + (size_t)(row0 + ai * HALF + m * 16) * ldc + col0;
#pragma unroll
                for (int bj = 0; bj < 2; ++bj) { const f32x4 v0 = acc[ai][bj][m][0], v1 = acc[ai][bj][m][1];
                    u32x4 w; w.x = pkh(v0[0], v0[1]); w.y = pkh(v0[2], v0[3]); w.z = pkh(v1[0], v1[1]); w.w = pkh(v1[2], v1[3]);
                    *(u32x4*)(rowp + bj * HALF) = w; } }
    }
};
struct EpiIn {
    static constexpr bool PERM = true, HOOK = false, SK = false;
    f16* O; const f32x2* rope; const float* qg; const float* kg; LAS float* red; f16* GLT; const float* bgate;
    __device__ __forceinline__ void pre(f32x4 (&)[2][2][4][2], const Unit&, int, int, int, int) const {}
    __device__ __forceinline__ void operator()(const f32x4 (&acc)[2][2][4][2], const Unit& u, int wr, int wc, int fr, int fq) const {
        const int pn = u.pn; const bool lat = u.pm < 32;
        if (pn >= 28) {
            const int gi = pn - 28, br = gi >> 4, pnn = gi & 15;
            int lo = fq * 16 + fr; asm volatile("" : "+v"(lo));
            f16* tp = GLT + ((size_t)((br * 34 + u.pm) * 16 + pnn) * 8 + (wr * 4 + wc)) * 8192 + lo * 8;
            const float* bp = bgate + gi * 256 + wc * 32 + 8 * (lo >> 4);
#pragma unroll
            for (int bj = 0; bj < 2; ++bj) { const f32x4 b0 = *(const f32x4*)(bp + bj * HALF), b1 = *(const f32x4*)(bp + bj * HALF + 4);
#pragma unroll
                for (int ai = 0; ai < 2; ++ai)
#pragma unroll
                    for (int m = 0; m < 4; ++m) { f32x4 v0 = acc[ai][bj][m][0] + b0, v1 = acc[ai][bj][m][1] + b1;
#pragma unroll
                        for (int j = 0; j < 4; ++j) { v0[j] = fminf(fmaxf(v0[j], -20.f), 20.f) * -1.4426950408889634f; v1[j] = fminf(fmaxf(v1[j], -20.f), 20.f) * -1.4426950408889634f; }
                        u32x4 w; w.x = pkh(v0[0], v0[1]); w.y = pkh(v0[2], v0[3]); w.z = pkh(v1[0], v1[1]); w.w = pkh(v1[2], v1[3]);
                        *(u32x4*)(tp + ((ai * 4 + m) * 2 + bj) * 512) = w; } }
            return;
        }
        int kind = 0;
        if (pn < 5) kind = 1; else if (pn >= 6 && pn < 10) kind = 2; else if (pn == 10) kind = 3; else if (pn >= 12 && pn < 16) kind = 1; else if (pn >= 16 && pn < 20) kind = 4;
        const int row0 = u.pm * BM + wr * 64 + fr, col0 = pn * BM + wc * 32 + 8 * fq;
        if (kind == 0 || (kind == 1 && !lat)) {
#pragma unroll
            for (int ai = 0; ai < 2; ++ai)
#pragma unroll
                for (int m = 0; m < 4; ++m) { f16* rowp = O + (size_t)(row0 + ai * HALF + m * 16) * INW + col0;
#pragma unroll
                    for (int bj = 0; bj < 2; ++bj) { const f32x4 v0 = acc[ai][bj][m][0], v1 = acc[ai][bj][m][1];
                        u32x4 w; w.x = pkh(v0[0], v0[1]); w.y = pkh(v0[2], v0[3]); w.z = pkh(v1[0], v1[1]); w.w = pkh(v1[2], v1[3]);
                        *(u32x4*)(rowp + bj * HALF) = w; } }
            return;
        }
        const bool rms = (kind == 2 || kind == 3);
        float rsv[2][2][4];
        if (rms) {
#pragma unroll
            for (int bj = 0; bj < 2; ++bj)
#pragma unroll
                for (int ai = 0; ai < 2; ++ai)
#pragma unroll
                    for (int m = 0; m < 4; ++m) { const f32x4 a0 = acc[ai][bj][m][0], a1 = acc[ai][bj][m][1];
                        float ss = (a0[0] * a0[0] + a0[1] * a0[1]) + (a0[2] * a0[2] + a0[3] * a0[3]) + (a1[0] * a1[0] + a1[1] * a1[1]) + (a1[2] * a1[2] + a1[3] * a1[3]);
                        ss += __shfl_xor(ss, 16); ss += __shfl_xor(ss, 32);
                        if (fq == 0) red[(bj * 256 + ai * HALF + wr * 64 + m * 16 + fr) * 4 + wc] = ss; }
            asm volatile("s_waitcnt lgkmcnt(0)" ::: "memory"); __builtin_amdgcn_s_barrier(); asm volatile("" ::: "memory");
#pragma unroll
            for (int bj = 0; bj < 2; ++bj)
#pragma unroll
                for (int ai = 0; ai < 2; ++ai)
#pragma unroll
                    for (int m = 0; m < 4; ++m) { const f32x4 t = *(const LAS f32x4*)(red + (bj * 256 + ai * HALF + wr * 64 + m * 16 + fr) * 4);
                        rsv[bj][ai][m] = 1.0f / sqrtf(((t[0] + t[1]) + (t[2] + t[3])) * (1.0f / HD) + RMS_EPS); }
        }
        const int dbase = 64 * (wc >> 1) + 16 * (wc & 1) + 4 * fq;
        f32x4 g0 = {1.f, 1.f, 1.f, 1.f}, g1 = g0;
        if (rms) { const float* g = (kind == 2 ? qg : kg) + dbase; g0 = *(const f32x4*)g; g1 = *(const f32x4*)(g + 32); }
        const float ksc = kind == 4 ? ATT_SCALE : 1.0f;
#pragma unroll
        for (int ai = 0; ai < 2; ++ai)
#pragma unroll
            for (int m = 0; m < 4; ++m) { const int row = row0 + ai * HALF + m * 16; const int t = row & (SEQ - 1); const int pos = (wc >> 1) ? (t & 63) : (t >> 6);
                f32x4 cv = {1.f, 1.f, 1.f, 1.f}, sv = {0.f, 0.f, 0.f, 0.f};
                if (lat) { const f32x4* cs = (const f32x4*)(rope + pos * 32 + 16 * (wc & 1) + 4 * fq); const f32x4 c01 = cs[0], c23 = cs[1]; cv = (f32x4){c01[0], c01[2], c23[0], c23[2]}; sv = (f32x4){c01[1], c01[3], c23[1], c23[3]}; }
                f16* rowp = O + (size_t)row * INW + col0;
#pragma unroll
                for (int bj = 0; bj < 2; ++bj) { f32x4 x1 = acc[ai][bj][m][0], x2 = acc[ai][bj][m][1];
                    if (rms) { x1 = x1 * rsv[bj][ai][m] * g0; x2 = x2 * rsv[bj][ai][m] * g1; }
                    const f32x4 o1 = (x1 * cv - x2 * sv) * ksc, o2 = (x2 * cv + x1 * sv) * ksc;
                    u32x4 w; w.x = pkh(o1[0], o1[1]); w.y = pkh(o1[2], o1[3]); w.z = pkh(o2[0], o2[1]); w.w = pkh(o2[2], o2[3]);
                    *(u32x4*)(rowp + bj * HALF) = w; } }
    }
};
struct EpiConv {
    static constexpr bool PERM = true, HOOK = false, SK = false;
    const float* cw; const float* cb; f16* ACT; float* GE; float* XP; float* UPE; LAS float* halo;
    __device__ __forceinline__ void pre(f32x4 (&)[2][2][4][2], const Unit&, int, int, int, int) const {}
    template <int CTRL> static __device__ __forceinline__ float dppf(float old, float src) {
        return __builtin_bit_cast(float, __builtin_amdgcn_update_dpp(__builtin_bit_cast(int, old), __builtin_bit_cast(int, src), CTRL, 0xf, 0xf, false)); }
    __device__ __forceinline__ void operator()(const f32x4 (&acc)[2][2][4][2], const Unit& u, int wr, int wc, int fr, int fq) const {
        const int f0 = u.pn * 128 + wc * 32 + 8 * fq;
        f32x4 w0[2], w1[2], w2[2], bb[2];
#pragma unroll
        for (int n = 0; n < 2; ++n) { w0[n] = *(const f32x4*)(cw + f0 + 4 * n); w1[n] = *(const f32x4*)(cw + DFF + f0 + 4 * n); w2[n] = *(const f32x4*)(cw + 2 * DFF + f0 + 4 * n); bb[n] = *(const f32x4*)(cb + f0 + 4 * n); }
        const int hcol = wc * 32 + 8 * fq;
#pragma unroll
        for (int ai = 0; ai < 2; ++ai) {
            if (fr == 0)  { *(LAS f32x4*)(halo + ((ai * 2 + wr) * 2 + 0) * 128 + hcol) = acc[ai][0][0][0]; *(LAS f32x4*)(halo + ((ai * 2 + wr) * 2 + 0) * 128 + hcol + 4) = acc[ai][0][0][1]; }
            if (fr == 15) { *(LAS f32x4*)(halo + ((ai * 2 + wr) * 2 + 1) * 128 + hcol) = acc[ai][0][3][0]; *(LAS f32x4*)(halo + ((ai * 2 + wr) * 2 + 1) * 128 + hcol + 4) = acc[ai][0][3][1]; }
        }
        if (wr == 0 && fr == 0)  { float* g = GE + (size_t)(u.pm * 2 + 0) * DFF + f0; *(f32x4*)g = acc[0][0][0][0]; *(f32x4*)(g + 4) = acc[0][0][0][1]; }
        if (wr == 1 && fr == 15) { float* g = GE + (size_t)(u.pm * 2 + 1) * DFF + f0; *(f32x4*)g = acc[1][0][3][0]; *(f32x4*)(g + 4) = acc[1][0][3][1]; }
        asm volatile("s_waitcnt lgkmcnt(0)" ::: "memory"); __builtin_amdgcn_s_barrier(); asm volatile("" ::: "memory");
#pragma unroll
        for (int ai = 0; ai < 2; ++ai) {
            f32x4 hp[2] = {{0.f, 0.f, 0.f, 0.f}, {0.f, 0.f, 0.f, 0.f}}, hn[2] = {{0.f, 0.f, 0.f, 0.f}, {0.f, 0.f, 0.f, 0.f}};
            if (wr == 1)      { hp[0] = *(const LAS f32x4*)(halo + ((ai * 2 + 0) * 2 + 1) * 128 + hcol); hp[1] = *(const LAS f32x4*)(halo + ((ai * 2 + 0) * 2 + 1) * 128 + hcol + 4); }
            else if (ai == 1) { hp[0] = *(const LAS f32x4*)(halo + ((0 * 2 + 1) * 2 + 1) * 128 + hcol);  hp[1] = *(const LAS f32x4*)(halo + ((0 * 2 + 1) * 2 + 1) * 128 + hcol + 4); }
            if (wr == 0)      { hn[0] = *(const LAS f32x4*)(halo + ((ai * 2 + 1) * 2 + 0) * 128 + hcol); hn[1] = *(const LAS f32x4*)(halo + ((ai * 2 + 1) * 2 + 0) * 128 + hcol + 4); }
            else if (ai == 0) { hn[0] = *(const LAS f32x4*)(halo + ((1 * 2 + 0) * 2 + 0) * 128 + hcol);  hn[1] = *(const LAS f32x4*)(halo + ((1 * 2 + 0) * 2 + 0) * 128 + hcol + 4); }
#pragma unroll
            for (int m = 0; m < 4; ++m) {
                float o[8], xs[8];
#pragma unroll
                for (int n = 0; n < 2; ++n)
#pragma unroll
                    for (int j = 0; j < 4; ++j) {
                        const float g = acc[ai][0][m][n][j];
                        const float oldp = m > 0 ? dppf<0x121>(0.f, acc[ai][0][m > 0 ? m - 1 : 0][n][j]) : hp[n][j];
                        const float pv = dppf<0x111>(oldp, g);
                        const float oldn = m < 3 ? dppf<0x12f>(0.f, acc[ai][0][m < 3 ? m + 1 : 3][n][j]) : hn[n][j];
                        const float nv = dppf<0x101>(oldn, g);
                        const float x = bb[n][j] + w0[n][j] * pv + w1[n][j] * g + w2[n][j] * nv;
                        xs[4 * n + j] = x; o[4 * n + j] = x * sigmoidf_(x) * acc[ai][1][m][n][j];
                    }
                const int row = u.pm * BM + ai * HALF + wr * 64 + m * 16 + fr;
                u32x4 w; w.x = pkh(o[0], o[1]); w.y = pkh(o[2], o[3]); w.z = pkh(o[4], o[5]); w.w = pkh(o[6], o[7]);
                *(u32x4*)(ACT + (size_t)row * DFF + f0) = w;
                if ((ai == 0 && m == 0 && wr == 0 && fr == 0) || (ai == 1 && m == 3 && wr == 1 && fr == 15)) {
                    const size_t eo = (size_t)(u.pm * 2 + ai) * DFF + f0;
                    *(f32x4*)(XP + eo) = (f32x4){xs[0], xs[1], xs[2], xs[3]}; *(f32x4*)(XP + eo + 4) = (f32x4){xs[4], xs[5], xs[6], xs[7]};
                    *(f32x4*)(UPE + eo) = acc[ai][1][m][0]; *(f32x4*)(UPE + eo + 4) = acc[ai][1][m][1];
                }
            }
        }
    }
};
struct EpiGateK {
    static constexpr bool PERM = true, HOOK = true, SK = false;
    const f16* GLT; f16* Mh;
    template <int MODE>
    __device__ __forceinline__ void scale(f32x4 (&acc)[2][2][4][2], const Unit& u, int sa, int sb, int wr, int wc, int fr, int fq) const {
        int lo = (fq * 16 + fr) * 8; asm volatile("" : "+v"(lo));
        const f16* ta = GLT + ((size_t)((sa * 34 + u.pm) * 16 + u.pn) * 8 + (wr * 4 + wc)) * 8192 + lo;
        const f16* tb = GLT + ((size_t)((sb * 34 + u.pm) * 16 + u.pn) * 8 + (wr * 4 + wc)) * 8192 + lo;
#pragma unroll
        for (int bj = 0; bj < 2; ++bj) {
#pragma unroll
            for (int ai = 0; ai < 2; ++ai) {
#pragma unroll
                for (int m = 0; m < 4; ++m) { const int q = ((ai * 4 + m) * 2 + bj) * 512;
                    const h8 ga = *(const h8*)(ta + q); h8 gb = ga; if (MODE == 0) gb = *(const h8*)(tb + q);
#pragma unroll
                    for (int j = 0; j < 8; ++j) {
                        float f = __builtin_amdgcn_rcpf(1.0f + __builtin_amdgcn_exp2f((float)ga[j]));
                        if (MODE == 0) f *= (1.0f + __builtin_amdgcn_exp2f((float)gb[j]));
                        acc[ai][bj][m][j >> 2][j & 3] *= f; } }
                asm volatile("" : "+v"(acc[ai][bj][0][0]), "+v"(acc[ai][bj][0][1]), "+v"(acc[ai][bj][1][0]), "+v"(acc[ai][bj][1][1]), "+v"(acc[ai][bj][2][0]), "+v"(acc[ai][bj][2][1]), "+v"(acc[ai][bj][3][0]), "+v"(acc[ai][bj][3][1]) :: "memory"); } }
    }
    __device__ __forceinline__ void hook(f32x4 (&acc)[2][2][4][2], const Unit& u, int gt, int wr, int wc, int fr, int fq) const { const int seg = gt >> 4; scale<0>(acc, u, seg - 1, seg, wr, wc, fr, fq); }
    __device__ __forceinline__ void pre(f32x4 (&acc)[2][2][4][2], const Unit& u, int wr, int wc, int fr, int fq) const { const int seg = SK_ENABLE ? (((u.k0 >> 6) + u.nt - 1) >> 4) : 2; scale<1>(acc, u, seg, seg, wr, wc, fr, fq); }
    __device__ __forceinline__ void operator()(const f32x4 (&acc)[2][2][4][2], const Unit& u, int wr, int wc, int fr, int fq) const {
        const int row0 = u.pm * BM + wr * 64 + fr, col0 = u.pn * BM + wc * 32 + 8 * fq;
#pragma unroll
        for (int ai = 0; ai < 2; ++ai)
#pragma unroll
            for (int m = 0; m < 4; ++m) { f16* rowp = Mh + (size_t)(row0 + ai * HALF + m * 16) * DM + col0;
#pragma unroll
                for (int bj = 0; bj < 2; ++bj) { const f32x4 v0 = acc[ai][bj][m][0], v1 = acc[ai][bj][m][1];
                    u32x4 w; w.x = pkh(v0[0], v0[1]); w.y = pkh(v0[2], v0[3]); w.z = pkh(v1[0], v1[1]); w.w = pkh(v1[2], v1[3]);
                    *(u32x4*)(rowp + bj * HALF) = w; } }
    }
};
struct EpiRes {
    static constexpr bool PERM = true, HOOK = false, SK = false;
    __device__ __forceinline__ void pre(f32x4 (&)[2][2][4][2], const Unit&, int, int, int, int) const {}
    const void* latA; const void* latB; const float* gv; f16* Z; int lat16;
    __device__ __forceinline__ void operator()(const f32x4 (&acc)[2][2][4][2], const Unit& u, int wr, int wc, int fr, int fq) const {
        const int row0 = u.pm * BM + wr * 64 + fr, col0 = u.pn * BM + wc * 32 + 8 * fq;
        const int mr = u.pm < 16 ? 0 : (u.pm < 32 ? 1 : 2);
        const size_t rbase = u.pm < 32 ? 0 : (size_t)NLAT * DM;
        const void* lat = u.pm < 32 ? latA : latB;
        const float* g = gv + (size_t)mr * NMOD;
#pragma unroll
        for (int bj = 0; bj < 2; ++bj) { const int col = col0 + bj * HALF;
            const f32x4 g0 = *(const f32x4*)(g + col), g1 = *(const f32x4*)(g + col + 4);
#pragma unroll
            for (int ai = 0; ai < 2; ++ai)
#pragma unroll
                for (int m = 0; m < 4; ++m) { const size_t off = (size_t)(row0 + ai * HALF + m * 16) * DM + col;
                    f32x4 l0, l1;
                    if (lat16) { const h8 t = *(const h8*)((const f16*)lat + (off - rbase)); l0 = (f32x4){(float)t[0], (float)t[1], (float)t[2], (float)t[3]}; l1 = (f32x4){(float)t[4], (float)t[5], (float)t[6], (float)t[7]}; }
                    else { l0 = *(const f32x4*)((const float*)lat + (off - rbase)); l1 = *(const f32x4*)((const float*)lat + (off - rbase) + 4); }
                    const f32x4 z0 = l0 * DN_ALPHA + g0 * acc[ai][bj][m][0], z1 = l1 * DN_ALPHA + g1 * acc[ai][bj][m][1];
                    u32x4 w; w.x = pkh(z0[0], z0[1]); w.y = pkh(z0[2], z0[3]); w.z = pkh(z1[0], z1[1]); w.w = pkh(z1[2], z1[3]); *(u32x4*)(Z + off) = w; } }
    }
};

struct EpiResLN {
    static constexpr bool PERM = true, HOOK = false, SK = true;
    const void* latA; const void* latB; const float* gv; int lat16;
    const float* lng; const float* lnb; const float* msh; const float* msc;
    f16* LAT; f16* H; float* out; int writeOut;
    unsigned long long* xslot; unsigned* cnt; LAS unsigned char* lx;
    __device__ __forceinline__ void pre(f32x4 (&acc)[2][2][4][2], const Unit& u, int wr, int wc, int fr, int fq) const {
        int row0 = u.pm * BM + wr * 64 + fr, col0 = u.pn * BM + wc * 32 + 8 * fq;
        asm volatile("" : "+v"(row0), "+v"(col0));
        const int mr = u.pm < 16 ? 0 : (u.pm < 32 ? 1 : 2);
        const size_t rbase = u.pm < 32 ? 0 : (size_t)NLAT * DM;
        const void* lat = u.pm < 32 ? latA : latB;
        const float* g = gv + (size_t)mr * NMOD;
#pragma unroll
        for (int bj = 0; bj < 2; ++bj) { const int col = col0 + bj * HALF;
            const f32x4 g0 = *(const f32x4*)(g + col), g1 = *(const f32x4*)(g + col + 4);
#pragma unroll
            for (int ai = 0; ai < 2; ++ai)
#pragma unroll
                for (int m = 0; m < 4; ++m) { const size_t off = (size_t)(row0 + ai * HALF + m * 16) * DM + col - rbase;
                    f32x4 l0, l1;
                    if (lat16) { const h8 t = *(const h8*)((const f16*)lat + off); l0 = (f32x4){(float)t[0], (float)t[1], (float)t[2], (float)t[3]}; l1 = (f32x4){(float)t[4], (float)t[5], (float)t[6], (float)t[7]}; }
                    else { l0 = *(const f32x4*)((const float*)lat + off); l1 = *(const f32x4*)((const float*)lat + off + 4); }
                    acc[ai][bj][m][0] = l0 * DN_ALPHA + g0 * acc[ai][bj][m][0]; acc[ai][bj][m][1] = l1 * DN_ALPHA + g1 * acc[ai][bj][m][1];
                    asm volatile("" : "+v"(acc[ai][bj][m][0]), "+v"(acc[ai][bj][m][1]) :: "memory"); } }
    }
    __device__ __forceinline__ void operator()(const f32x4 (&acc)[2][2][4][2], const Unit& u, int wr, int wc, int fr, int fq) const {
        LAS f32x2* P = (LAS f32x2*)lx; LAS f32x2* S = (LAS f32x2*)(lx + 8192); volatile LAS unsigned* flag = (volatile LAS unsigned*)(lx + 10240);
        const int wid = wr * 4 + wc, lane = fq * 16 + fr;
#pragma unroll
        for (int ai = 0; ai < 2; ++ai)
#pragma unroll
            for (int m = 0; m < 4; ++m) {
                float sm = 0.f;
#pragma unroll
                for (int bj = 0; bj < 2; ++bj)
#pragma unroll
                    for (int n = 0; n < 2; ++n) { const f32x4 xv = acc[ai][bj][m][n]; sm += (xv[0] + xv[1]) + (xv[2] + xv[3]); }
                sm += __shfl_xor(sm, 16); sm += __shfl_xor(sm, 32);
                const float mw = sm * (1.0f / 64.0f); float q = 0.f;
#pragma unroll
                for (int bj = 0; bj < 2; ++bj)
#pragma unroll
                    for (int n = 0; n < 2; ++n) { const f32x4 d = acc[ai][bj][m][n] - mw; q += (d[0] * d[0] + d[1] * d[1]) + (d[2] * d[2] + d[3] * d[3]); }
                q += __shfl_xor(q, 16); q += __shfl_xor(q, 32);
                if (fq == 0) P[(ai * HALF + wr * 64 + m * 16 + fr) * 4 + wc] = (f32x2){mw, q};
            }
        asm volatile("s_waitcnt lgkmcnt(0)" ::: "memory"); __builtin_amdgcn_s_barrier(); asm volatile("" ::: "memory");
        const int row = wid * 32 + (lane & 31);
        if (lane < 32) {
            const f32x2 pa = P[row * 4 + 0], pb = P[row * 4 + 1], pc = P[row * 4 + 2], pd = P[row * 4 + 3];
            const float mt = ((pa.x + pb.x) + (pc.x + pd.x)) * 0.25f;
            const float da = pa.x - mt, db = pb.x - mt, dc = pc.x - mt, dd = pd.x - mt;
            const float m2 = ((pa.y + pb.y) + (pc.y + pd.y)) + 64.0f * ((da * da + db * db) + (dc * dc + dd * dd));
            __hip_atomic_store(xslot + ((size_t)(u.pm * BM + row) * 16 + u.pn), ((unsigned long long)__float_as_uint(m2) << 32) | __float_as_uint(mt), __ATOMIC_RELAXED, __HIP_MEMORY_SCOPE_AGENT);
        }
        asm volatile("s_waitcnt vmcnt(0)" ::: "memory");
        if (lane == 0) __hip_atomic_fetch_add(cnt + 64 * u.pm, 1u, __ATOMIC_RELAXED, __HIP_MEMORY_SCOPE_AGENT);
        if (wid == 0) {
            unsigned sp = 0;
            while ((unsigned)__builtin_amdgcn_readfirstlane((int)__hip_atomic_load(cnt + 64 * u.pm, __ATOMIC_RELAXED, __HIP_MEMORY_SCOPE_AGENT)) < 128u) { __builtin_amdgcn_s_sleep(1); if (++sp > (1u << 22)) break; }
            __builtin_amdgcn_fence(__ATOMIC_ACQUIRE, "agent");
            if (lane == 0) flag[0] = 1u;
        }
        asm volatile("s_waitcnt vmcnt(0) lgkmcnt(0)" ::: "memory"); __builtin_amdgcn_s_barrier(); asm volatile("" ::: "memory");
        if (lane < 32) {
            const unsigned long long* sl = xslot + (size_t)(u.pm * BM + row) * 16; float mt[16], m2[16]; float ms = 0.f;
#pragma unroll
            for (int t = 0; t < 16; ++t) { const unsigned long long wv = __hip_atomic_load(sl + t, __ATOMIC_RELAXED, __HIP_MEMORY_SCOPE_AGENT); mt[t] = __uint_as_float((unsigned)wv); m2[t] = __uint_as_float((unsigned)(wv >> 32)); ms += mt[t]; }
            const float mean = ms * (1.0f / 16.0f); float q = 0.f;
#pragma unroll
            for (int t = 0; t < 16; ++t) { const float dm = mt[t] - mean; q += m2[t] + 256.0f * dm * dm; }
            S[row] = (f32x2){mean, 1.0f / sqrtf(q * (1.0f / DM) + LN_EPS)};
        }
        asm volatile("s_waitcnt lgkmcnt(0)" ::: "memory"); __builtin_amdgcn_s_barrier(); asm volatile("" ::: "memory");
        const int row0 = u.pm * BM + wr * 64 + fr, col0 = u.pn * BM + wc * 32 + 8 * fq;
        const int mr = u.pm < 16 ? 0 : (u.pm < 32 ? 1 : 2);
#pragma unroll
        for (int bj = 0; bj < 2; ++bj) { const int col = col0 + bj * HALF;
            const f32x4 g0 = *(const f32x4*)(lng + col), g1 = *(const f32x4*)(lng + col + 4), b0 = *(const f32x4*)(lnb + col), b1 = *(const f32x4*)(lnb + col + 4);
            f32x4 c0 = {0.f, 0.f, 0.f, 0.f}, c1 = c0, h0 = c0, h1 = c0;
            if (!writeOut) { const float* sc = msc + (size_t)mr * NMOD + col; const float* sh = msh + (size_t)mr * NMOD + col; c0 = *(const f32x4*)sc + 1.0f; c1 = *(const f32x4*)(sc + 4) + 1.0f; h0 = *(const f32x4*)sh; h1 = *(const f32x4*)(sh + 4); }
#pragma unroll
            for (int ai = 0; ai < 2; ++ai)
#pragma unroll
                for (int m = 0; m < 4; ++m) { const int rl = ai * HALF + wr * 64 + m * 16 + fr; const f32x2 st = S[rl]; const size_t off = (size_t)(row0 + ai * HALF + m * 16) * DM + col;
                    const f32x4 y0 = (acc[ai][bj][m][0] - st.x) * st.y * g0 + b0, y1 = (acc[ai][bj][m][1] - st.x) * st.y * g1 + b1;
                    if (writeOut) { if (u.pm < 32) { *(f32x4*)(out + off) = y0; *(f32x4*)(out + off + 4) = y1; } }
                    else { u32x4 w; w.x = pkh(y0[0], y0[1]); w.y = pkh(y0[2], y0[3]); w.z = pkh(y1[0], y1[1]); w.w = pkh(y1[2], y1[3]); *(u32x4*)(LAT + off) = w;
                        const f32x4 v0 = y0 * c0 + h0, v1 = y1 * c1 + h1; u32x4 w2; w2.x = pkh(v0[0], v0[1]); w2.y = pkh(v0[2], v0[3]); w2.z = pkh(v1[0], v1[1]); w2.w = pkh(v1[2], v1[3]); *(u32x4*)(H + off) = w2; } } }
    }
};

template <class Epi, class Sched, bool ALIGN_EPI = true, bool SP2 = true, bool SKW = false>
__device__ __forceinline__ void gemm_phase(LAS unsigned char* lds, const Gemm g, const Sched& S, const Epi& E, const SKCtx SK, const int wave0) {
    int tid = tid_of(wave0); asm volatile("" : "+v"(tid));
    const int wid = __builtin_amdgcn_readfirstlane(tid >> 6), lane = tid & 63, wr = wid >> 2, wc = wid & 3, fr = lane & 15, fq = lane >> 4;
    const int K = g.K;
    unsigned voffA[2], voffB[2];
#pragma unroll
    for (int i = 0; i < 2; ++i) { int R, C; stage_rc(tid * 16 + i * 8192, R, C); const int Rb = Epi::PERM ? ((R & ~31) + perm32(R & 31)) : R;
        voffA[i] = (unsigned)(R * K + C) * 2u; voffB[i] = (unsigned)(Rb * K + C) * 2u; }
    const size_t kstep = (size_t)(BK * 2);
    const size_t hstep = (size_t)HALF * K * 2;
    const size_t tstep = 2 * hstep;
    const unsigned ldsw = (unsigned)wid * 1024u;
    const int aoff = lds_byte(wr * 64 + fr, fq * 8), boff = lds_byte(wc * 32 + fr, fq * 8);
#define PG8_SA(b, h) (((b) * 2 + (h)) * HTB)
#define PG8_SB(b, h) ((4 + (b) * 2 + (h)) * HTB)
#define PG8_STAGE(bufoff, gbase, voff) do { _Pragma("unroll") for (int _i = 0; _i < 2; ++_i) \
        __builtin_amdgcn_global_load_lds((const unsigned*)((const char*)(gbase) + (voff)[_i]), (LAS unsigned*)(lds + (bufoff) + ldsw + _i * 8192), 16, 0, 0); } while (0)
#define PG8_LDA(dst, b, h) do { _Pragma("unroll") for (int m = 0; m < 4; ++m) _Pragma("unroll") for (int k = 0; k < 2; ++k) dst[m][k] = *(const LAS h8*)(lds + PG8_SA(b, h) + aoff + m * 2048 + k * 1024); } while (0)
#define PG8_LDB(dst, b, h) do { _Pragma("unroll") for (int n = 0; n < 2; ++n) _Pragma("unroll") for (int k = 0; k < 2; ++k) dst[n][k] = *(const LAS h8*)(lds + PG8_SB(b, h) + boff + n * 2048 + k * 1024); } while (0)
#define PG8_MMA(ai, bj, At, Bt) do { __builtin_amdgcn_s_setprio(1); _Pragma("unroll") for (int m = 0; m < 4; ++m) _Pragma("unroll") for (int n = 0; n < 2; ++n) _Pragma("unroll") for (int k = 0; k < 2; ++k) \
        acc[ai][bj][m][n] = __builtin_amdgcn_mfma_f32_16x16x32_f16(Bt[n][k], At[m][k], acc[ai][bj][m][n], 0, 0, 0); __builtin_amdgcn_s_setprio(0); } while (0)
#define PG8_WAIT_V(n) asm volatile("s_waitcnt vmcnt(" #n ")" ::: "memory")
#define PG8_WAIT_L(n) asm volatile("s_waitcnt lgkmcnt(" #n ")" ::: "memory")
#define PG8_BAR __builtin_amdgcn_s_barrier()
#define PG8_SCHED __builtin_amdgcn_sched_barrier(0)
    Unit cur, nxt; int ui = 0;
    if (!S.next(0, cur)) return;
    f32x4 acc[2][2][4][2];
#pragma unroll
    for (int a = 0; a < 2; ++a)
#pragma unroll
        for (int b = 0; b < 2; ++b)
#pragma unroll
            for (int m = 0; m < 4; ++m)
#pragma unroll
                for (int n = 0; n < 2; ++n) acc[a][b][m][n] = (f32x4){0.f, 0.f, 0.f, 0.f};
    h8 At[4][2], B0[2][2], B1[2][2];
    constexpr bool SKP = SK_ENABLE || SKW;
    const char* cA = (const char*)g.A + (size_t)cur.pm * tstep + (SKP ? (size_t)cur.k0 * 2 : 0); const char* cB = (const char*)g.Bt + (size_t)cur.pn * tstep + (SKP ? (size_t)cur.k0 * 2 : 0);
    if constexpr (SP2) {
        PG8_STAGE(PG8_SB(0, 0), cB, voffB); PG8_STAGE(PG8_SB(0, 1), cB + hstep, voffB); PG8_STAGE(PG8_SA(0, 0), cA, voffA); PG8_STAGE(PG8_SA(0, 1), cA + hstep, voffA);
        if (wr == 1) PG8_BAR;
        PG8_WAIT_V(2); PG8_BAR;
        PG8_STAGE(PG8_SB(1, 0), cB + kstep, voffB); PG8_STAGE(PG8_SA(1, 0), cA + kstep, voffA); PG8_STAGE(PG8_SB(1, 1), cB + hstep + kstep, voffB);
        PG8_WAIT_V(6); PG8_BAR;
    } else {
        PG8_STAGE(PG8_SB(0, 0), cB, voffB); PG8_STAGE(PG8_SA(0, 0), cA, voffA); PG8_STAGE(PG8_SB(0, 1), cB + hstep, voffB); PG8_STAGE(PG8_SA(0, 1), cA + hstep, voffA);
        if (wr == 1) PG8_BAR;
        PG8_WAIT_V(4); PG8_BAR;
        PG8_STAGE(PG8_SB(1, 0), cB + kstep, voffB); PG8_STAGE(PG8_SA(1, 0), cA + kstep, voffA); PG8_STAGE(PG8_SB(1, 1), cB + hstep + kstep, voffB);
        PG8_WAIT_V(6); PG8_BAR;
    }
    for (;;) {
        const bool has_next = S.next(ui + 1, nxt);
        const char* nA = has_next ? (const char*)g.A + (size_t)nxt.pm * tstep + (SKP ? (size_t)nxt.k0 * 2 : 0) : cA; const char* nB = has_next ? (const char*)g.Bt + (size_t)nxt.pn * tstep + (SKP ? (size_t)nxt.k0 * 2 : 0) : cB;
        const int nt = SKP ? cur.nt : K / BK, kt0 = SKP ? (cur.k0 >> 6) : 0;
        for (int t = 0; t < nt; t += 2) {
            const bool last = (t == nt - 2);
            if constexpr (Epi::HOOK) { const int gt = kt0 + t; if (t > 0 && (gt == 16 || gt == 32)) E.hook(acc, cur, gt, wr, wc, fr, fq); }
            const char* a1 = cA + (size_t)(t + 1) * kstep;
            const char* a2 = last ? nA : cA + (size_t)(t + 2) * kstep; const char* b2 = last ? nB : cB + (size_t)(t + 2) * kstep;
            const char* a3 = a2 + kstep; const char* b3 = b2 + kstep;
            if constexpr (SP2) {
            PG8_LDB(B0, 0, 0); PG8_LDB(B1, 0, 1); PG8_SCHED; PG8_LDA(At, 0, 0); PG8_STAGE(PG8_SA(1, 1), a1 + hstep, voffA);
            PG8_WAIT_V(8); PG8_WAIT_L(0); PG8_BAR; PG8_MMA(0, 0, At, B0); PG8_MMA(0, 1, At, B1); PG8_BAR; PG8_SCHED;
            PG8_LDA(At, 0, 1); PG8_STAGE(PG8_SB(0, 0), b2, voffB); PG8_STAGE(PG8_SB(0, 1), b2 + hstep, voffB); PG8_STAGE(PG8_SA(0, 0), a2, voffA);
            PG8_WAIT_V(8); PG8_WAIT_L(0); PG8_BAR; PG8_MMA(1, 0, At, B0); PG8_MMA(1, 1, At, B1); PG8_BAR; PG8_SCHED;
            PG8_LDB(B0, 1, 0); PG8_LDB(B1, 1, 1); PG8_SCHED; PG8_LDA(At, 1, 0); PG8_STAGE(PG8_SA(0, 1), a2 + hstep, voffA);
            PG8_WAIT_V(8); PG8_WAIT_L(0); PG8_BAR; PG8_MMA(0, 0, At, B0); PG8_MMA(0, 1, At, B1); PG8_BAR; PG8_SCHED;
            PG8_LDA(At, 1, 1); PG8_STAGE(PG8_SB(1, 0), b3, voffB); PG8_STAGE(PG8_SB(1, 1), b3 + hstep, voffB); PG8_STAGE(PG8_SA(1, 0), a3, voffA);
            PG8_WAIT_V(8); PG8_WAIT_L(0); PG8_BAR; PG8_MMA(1, 0, At, B0); PG8_MMA(1, 1, At, B1); PG8_BAR; PG8_SCHED;
            } else {
            PG8_LDB(B0, 0, 0); PG8_SCHED; PG8_LDA(At, 0, 0); PG8_STAGE(PG8_SA(1, 1), a1 + hstep, voffA);
            PG8_WAIT_L(8); PG8_BAR; PG8_WAIT_L(0); PG8_MMA(0, 0, At, B0); PG8_BAR; PG8_SCHED;
            PG8_LDB(B1, 0, 1); PG8_STAGE(PG8_SB(0, 0), b2, voffB);
            PG8_BAR; PG8_WAIT_L(0); PG8_MMA(0, 1, At, B1); PG8_BAR;
            PG8_LDA(At, 0, 1); PG8_STAGE(PG8_SA(0, 0), a2, voffA);
            PG8_BAR; PG8_WAIT_L(0); PG8_MMA(1, 0, At, B0); PG8_BAR; PG8_SCHED;
            PG8_STAGE(PG8_SB(0, 1), b2 + hstep, voffB);
            PG8_WAIT_V(6); PG8_BAR; PG8_MMA(1, 1, At, B1); PG8_BAR;
            PG8_LDB(B0, 1, 0); PG8_SCHED; PG8_LDA(At, 1, 0); PG8_STAGE(PG8_SA(0, 1), a2 + hstep, voffA);
            PG8_WAIT_L(8); PG8_BAR; PG8_WAIT_L(0); PG8_MMA(0, 0, At, B0); PG8_BAR; PG8_SCHED;
            PG8_LDB(B1, 1, 1); PG8_STAGE(PG8_SB(1, 0), b3, voffB);
            PG8_BAR; PG8_WAIT_L(0); PG8_MMA(0, 1, At, B1); PG8_BAR;
            PG8_LDA(At, 1, 1); PG8_STAGE(PG8_SA(1, 0), a3, voffA);
            PG8_BAR; PG8_WAIT_L(0); PG8_MMA(1, 0, At, B0); PG8_BAR; PG8_SCHED;
            PG8_STAGE(PG8_SB(1, 1), b3 + hstep, voffB);
            PG8_WAIT_V(6); PG8_BAR; PG8_MMA(1, 1, At, B1); PG8_BAR;
            }
        }
        if constexpr (ALIGN_EPI) { if (wr == 0) PG8_BAR; }
        if constexpr (SKW) {
            f32x4* af = &acc[0][0][0][0];
            const float* s0 = SK.slab + ((size_t)(cur.rid * cur.ns) * 8 + wid) * 8192;
            int voff = lane * 16; asm volatile("" : "+v"(voff));
            { uintptr_t sb = (uintptr_t)(s0 + (size_t)cur.sl * 8 * 8192); const unsigned lo = __builtin_amdgcn_readfirstlane((unsigned)sb), hi = __builtin_amdgcn_readfirstlane((unsigned)(sb >> 32));
              const __amdgpu_buffer_rsrc_t rs = __builtin_amdgcn_make_buffer_rsrc((void*)(((uintptr_t)hi << 32) | lo), 0, 32768, 0x00020000);
#pragma unroll
              for (int q = 0; q < 32; ++q) __builtin_amdgcn_raw_buffer_store_b128(__builtin_bit_cast(u32x4, af[q]), rs, voff, q * 1024, 16); }
            asm volatile("s_waitcnt vmcnt(0)" ::: "memory"); PG8_BAR;
            volatile LAS unsigned* mk = (volatile LAS unsigned*)(lds + MISC_OFF);
            if (wid == 0) { unsigned old = 0; if (voff == 0) old = __hip_atomic_fetch_add(SK.cnt + cur.rid * 16, 1u, __ATOMIC_RELAXED, __HIP_MEMORY_SCOPE_AGENT);
                old = __builtin_amdgcn_readfirstlane(old); if (voff == 0) mk[30] = old; }
            asm volatile("s_waitcnt vmcnt(0) lgkmcnt(0)" ::: "memory"); PG8_BAR;
            if ((unsigned)__builtin_amdgcn_readfirstlane((int)mk[30]) == (unsigned)(cur.ns - 1)) {
                __builtin_amdgcn_fence(__ATOMIC_ACQUIRE, "agent"); asm volatile("s_waitcnt vmcnt(0)" ::: "memory");
#pragma unroll
                for (int q = 0; q < 32; ++q) af[q] = (f32x4){0.f, 0.f, 0.f, 0.f};
                for (int sl = 0; sl < cur.ns; ++sl) {
                    uintptr_t sb = (uintptr_t)(s0 + (size_t)sl * 8 * 8192); const unsigned lo = __builtin_amdgcn_readfirstlane((unsigned)sb), hi = __builtin_amdgcn_readfirstlane((unsigned)(sb >> 32));
                    const __amdgpu_buffer_rsrc_t rs = __builtin_amdgcn_make_buffer_rsrc((void*)(((uintptr_t)hi << 32) | lo), 0, 32768, 0x00020000);
#pragma unroll
                    for (int qg = 0; qg < 4; ++qg) {
#pragma unroll
                        for (int q = 8 * qg; q < 8 * qg + 8; ++q) af[q] += __builtin_bit_cast(f32x4, __builtin_amdgcn_raw_buffer_load_b128(rs, voff, q * 1024, 0));
                        asm volatile("" : "+v"(af[8 * qg]), "+v"(af[8 * qg + 1]), "+v"(af[8 * qg + 2]), "+v"(af[8 * qg + 3]), "+v"(af[8 * qg + 4]), "+v"(af[8 * qg + 5]), "+v"(af[8 * qg + 6]), "+v"(af[8 * qg + 7]) :: "memory"); } }
                E.pre(acc, cur, wr, wc, fr, fq); E(acc, cur, wr, wc, fr, fq);
            }
        } else if (!SK_ENABLE || cur.ns == 1) { E.pre(acc, cur, wr, wc, fr, fq); E(acc, cur, wr, wc, fr, fq); }
        else {
            E.pre(acc, cur, wr, wc, fr, fq);
            f32x4* af = &acc[0][0][0][0];
            const float* s0 = SK.slab + ((size_t)(cur.rid * cur.ns) * 8 + wid) * 8192;
            int voff = lane * 16; asm volatile("" : "+v"(voff));
            { uintptr_t sb = (uintptr_t)(s0 + (size_t)cur.sl * 8 * 8192); const unsigned lo = __builtin_amdgcn_readfirstlane((unsigned)sb), hi = __builtin_amdgcn_readfirstlane((unsigned)(sb >> 32));
              const __amdgpu_buffer_rsrc_t rs = __builtin_amdgcn_make_buffer_rsrc((void*)(((uintptr_t)hi << 32) | lo), 0, 32768, 0x00020000);
#pragma unroll
              for (int q = 0; q < 32; ++q) __builtin_amdgcn_raw_buffer_store_b128(__builtin_bit_cast(u32x4, af[q]), rs, voff, q * 1024, 16); }
            asm volatile("s_waitcnt vmcnt(0)" ::: "memory");
            unsigned old = 0; if (lane == 0) old = __hip_atomic_fetch_add(SK.cnt + cur.rid * 16 + wid, 1u, __ATOMIC_RELAXED, __HIP_MEMORY_SCOPE_AGENT);
            old = __builtin_amdgcn_readfirstlane(old);
            if (old == (unsigned)(cur.ns - 1)) {
                __builtin_amdgcn_fence(__ATOMIC_ACQUIRE, "agent"); asm volatile("s_waitcnt vmcnt(0)" ::: "memory");
#pragma unroll
                for (int q = 0; q < 32; ++q) af[q] = (f32x4){0.f, 0.f, 0.f, 0.f};
                for (int sl = 0; sl < cur.ns; ++sl) {
                    uintptr_t sb = (uintptr_t)(s0 + (size_t)sl * 8 * 8192); const unsigned lo = __builtin_amdgcn_readfirstlane((unsigned)sb), hi = __builtin_amdgcn_readfirstlane((unsigned)(sb >> 32));
                    const __amdgpu_buffer_rsrc_t rs = __builtin_amdgcn_make_buffer_rsrc((void*)(((uintptr_t)hi << 32) | lo), 0, 32768, 0x00020000);
#pragma unroll
                    for (int qg = 0; qg < 4; ++qg) {
#pragma unroll
                        for (int q = 8 * qg; q < 8 * qg + 8; ++q) af[q] += __builtin_bit_cast(f32x4, __builtin_amdgcn_raw_buffer_load_b128(rs, voff, q * 1024, 0));
                        asm volatile("" : "+v"(af[8 * qg]), "+v"(af[8 * qg + 1]), "+v"(af[8 * qg + 2]), "+v"(af[8 * qg + 3]), "+v"(af[8 * qg + 4]), "+v"(af[8 * qg + 5]), "+v"(af[8 * qg + 6]), "+v"(af[8 * qg + 7]) :: "memory"); } }
                E(acc, cur, wr, wc, fr, fq);
            }
        }
        if (!has_next) break;
#pragma unroll
        for (int a = 0; a < 2; ++a)
#pragma unroll
            for (int b = 0; b < 2; ++b)
#pragma unroll
                for (int m = 0; m < 4; ++m)
#pragma unroll
                    for (int n = 0; n < 2; ++n) acc[a][b][m][n] = (f32x4){0.f, 0.f, 0.f, 0.f};
        cur = nxt; cA = nA; cB = nB; ++ui;
        if constexpr (ALIGN_EPI) { if (wr == 1) PG8_BAR; }
    }
    PG8_WAIT_V(0);
    if constexpr (!ALIGN_EPI) { if (wr == 0) PG8_BAR; }
    PG8_BAR;
#undef PG8_SA
#undef PG8_SB
#undef PG8_STAGE
#undef PG8_LDA
#undef PG8_LDB
#undef PG8_MMA
#undef PG8_WAIT_V
#undef PG8_WAIT_L
#undef PG8_BAR
#undef PG8_SCHED
}
}

#define XB_TMO      128
#define XB_XCNT(j)  (256  + 64 * (j))
#define XB_XSUB(j)  (1280 + 64 * (j))
#define XB_XGEN(j)  (2304 + 64 * (j))
#define XB_TOP      3328
#define XB_TOPGEN   3392
#define XCD_BAR_WORDS 3456
#define XB_SPIN_CAP (1u << 22)
__device__ __forceinline__ unsigned xb_ld(unsigned* p)              { return __hip_atomic_load(p, __ATOMIC_RELAXED, __HIP_MEMORY_SCOPE_AGENT); }
__device__ __forceinline__ unsigned xb_add(unsigned* p, unsigned v) { return __hip_atomic_fetch_add(p, v, __ATOMIC_RELAXED, __HIP_MEMORY_SCOPE_AGENT); }
__device__ __forceinline__ unsigned xb_xcc_id() { return (unsigned)__builtin_amdgcn_s_getreg((3 << 11) | 20) & 0xFu; }
#define XB_SPIN(cond, bar) do { unsigned _sp = 0; while (cond) { __builtin_amdgcn_s_sleep(1); \
    if ((++_sp & 255u) == 0u) { if (xb_ld(&(bar)[XB_TMO])) break; if (_sp > XB_SPIN_CAP) { atomicAdd(&(bar)[XB_TMO], 1u); break; } } } } while (0)
struct XcdBarrier { unsigned* bar; unsigned x; volatile LAS unsigned* st; };
__device__ __forceinline__ XcdBarrier xcd_barrier_post(unsigned* bar, volatile LAS unsigned* st, int tid0) {
    XcdBarrier b; b.bar = bar; b.x = xb_xcc_id(); b.st = st;
    if (tid0 == 0) (void)xb_add(&bar[XB_XCNT(b.x)], 1u);
    return b;
}
__device__ __forceinline__ void xcd_barrier_complete(unsigned* bar, unsigned x, unsigned& nloc, unsigned& nx) {
    const unsigned G = gridDim.x * gridDim.y * gridDim.z;
    unsigned sum, cnt, mine, sp = 0u;
    for (;;) {
        sum = 0u; cnt = 0u; mine = 0u;
#pragma unroll
        for (unsigned j = 0; j < 16; ++j) { const unsigned c = xb_ld(&bar[XB_XCNT(j)]); sum += c; cnt += (c > 0u) ? 1u : 0u; mine = (j == x) ? c : mine; }
        if (sum == G) break;
        __builtin_amdgcn_s_sleep(1);
        if ((++sp & 255u) == 0u) { if (xb_ld(&bar[XB_TMO])) break; if (sp > XB_SPIN_CAP) { atomicAdd(&bar[XB_TMO], 1u); break; } }
    }
    nloc = mine > 0u ? mine : 1u; nx = cnt > 0u ? cnt : 1u;
}
__device__ __forceinline__ void xcd_barrier(const XcdBarrier& b, const int wave0) {
    asm volatile("s_waitcnt vmcnt(0)" ::: "memory");
    __syncthreads();
    int t0_ = tid_of(wave0); asm volatile("" : "+v"(t0_));
    if (t0_ == 0) {
        unsigned* bar = b.bar;
        __builtin_amdgcn_s_waitcnt(0);
        unsigned nloc = b.st[0], nx = b.st[1];
        if (nloc == 0u) { unsigned xl = b.x; asm volatile("" : "+s"(xl)); xcd_barrier_complete(bar, xl, nloc, nx); b.st[0] = nloc; b.st[1] = nx; }
        const unsigned old = xb_add(&bar[XB_XSUB(b.x)], 1u);
        const unsigned gen = old / nloc;
        if (old + 1u == (gen + 1u) * nloc) {
            __builtin_amdgcn_fence(__ATOMIC_RELEASE, "agent");
            asm volatile("s_waitcnt vmcnt(0)" ::: "memory");
            const unsigned og = xb_add(&bar[XB_TOP], 1u);
            const unsigned tg = og / nx;
            if (og + 1u == (tg + 1u) * nx) xb_add(&bar[XB_TOPGEN], 1u);
            else XB_SPIN(xb_ld(&bar[XB_TOPGEN]) == tg, bar);
            __builtin_amdgcn_fence(__ATOMIC_ACQUIRE, "agent");
            xb_add(&bar[XB_XGEN(b.x)], 1u);
            asm volatile("s_waitcnt vmcnt(0)" ::: "memory");
        } else {
            XB_SPIN(xb_ld(&bar[XB_XGEN(b.x)]) == gen, bar);
            __builtin_amdgcn_fence(__ATOMIC_ACQUIRE, "agent");
            asm volatile("s_waitcnt vmcnt(0)" ::: "memory");
        }
    }
    __syncthreads();
}

__device__ __forceinline__ void rope_table(f32x2* tab, int tid) {
    for (int e = tid; e < 64 * 32; e += 512) {
        const int pos = e >> 5, i = e & 31;
        double invf = 1.0; for (int j = 0; j < i; ++j) invf *= 0.74989420933245582730;
        const float ang = (float)pos * (float)invf;
        const double xd = (double)ang;
        const double kq = __builtin_rint(xd * 0.63661977236758134308);
        const double r = (xd - kq * 1.5707963267948966192) - kq * 6.123233995736766e-17;
        const double r2 = r * r;
        double sn = r * (1.0 + r2 * (-1.0 / 6 + r2 * (1.0 / 120 + r2 * (-1.0 / 5040 + r2 * (1.0 / 362880 + r2 * (-1.0 / 39916800 + r2 * (1.0 / 6227020800.0 + r2 * (-1.0 / 1307674368000.0))))))));
        double cs = 1.0 + r2 * (-0.5 + r2 * (1.0 / 24 + r2 * (-1.0 / 720 + r2 * (1.0 / 40320 + r2 * (-1.0 / 3628800 + r2 * (1.0 / 479001600 + r2 * (-1.0 / 87178291200.0)))))));
        const int q = ((int)kq) & 3;
        double c2, s2;
        if (q == 0) { c2 = cs; s2 = sn; } else if (q == 1) { c2 = -sn; s2 = cs; } else if (q == 2) { c2 = -cs; s2 = -sn; } else { c2 = sn; s2 = -cs; }
        tab[e] = (f32x2){(float)c2, (float)s2};
    }
}
__device__ __forceinline__ void ph_modgemv(const Args& a, LAS unsigned char* lds, int tid, int lane, int wave, int first, int last_item, int stride) {
    LAS float* sv = (LAS float*)lds;
    LAS float* red = (LAS float*)(lds + 49152);
    float* MOD = (float*)(a.ws + WS_MOD);
    for (int i = tid; i < 3 * DM; i += 512) { const int r = i >> 12, k = i & 4095; const float c = r < 2 ? a.c[r * DM + k] : a.c_ctx[k]; sv[i] = c * sigmoidf_(c); }
    __syncthreads();
    for (int item = first; item < last_item; item += stride) {
        const int l = item >> 7, cb = item & 127;
        f32x4 acc0 = {0.f, 0.f, 0.f, 0.f}, acc1 = acc0, acc2 = acc0;
        if (lane < 48) {
            const float* wp = a.w_mod + (size_t)l * DM * NMOD + (size_t)(wave * 512) * NMOD + cb * 192 + lane * 4;
            const LAS float* s0 = sv + wave * 512;
            for (int k = 0; k < 512; k += 16) {
                f32x4 v[16];
#pragma unroll
                for (int j = 0; j < 16; ++j) v[j] = *(const f32x4*)(wp + (size_t)(k + j) * NMOD);
#pragma unroll
                for (int j = 0; j < 16; ++j) { acc0 += v[j] * s0[k + j]; acc1 += v[j] * s0[DM + k + j]; acc2 += v[j] * s0[2 * DM + k + j]; }
            }
            *(LAS f32x4*)(red + (wave * 3 + 0) * 192 + lane * 4) = acc0; *(LAS f32x4*)(red + (wave * 3 + 1) * 192 + lane * 4) = acc1; *(LAS f32x4*)(red + (wave * 3 + 2) * 192 + lane * 4) = acc2;
        }
        __syncthreads();
        for (int i = tid; i < 3 * 192; i += 512) { const int r = i / 192, n = i % 192; float s = 0.f;
#pragma unroll
            for (int w = 0; w < 8; ++w) s += red[(w * 3 + r) * 192 + n];
            MOD[(size_t)(l * 3 + r) * NMOD + cb * 192 + n] = s + a.b_mod[l * NMOD + cb * 192 + n]; }
        __syncthreads();
    }
}
__device__ __forceinline__ void cvt_item(const float* W, int K, int N, f16* WT, int ldk, LAS unsigned char* tile, int idx, int lane, bool pair_up = false, bool qk_perm = false) {
    const int nblk = N >> 6, kb = idx / nblk, nb = idx - kb * nblk, k0 = kb * 64, n0 = nb * 64;
    const int d0 = !pair_up ? n0 : (n0 < DFF ? (n0 >> 7) * 256 + (n0 & 127) : ((n0 - DFF) >> 7) * 256 + 128 + ((n0 - DFF) & 127));
    const int g = lane >> 4, q = lane & 15;
    const float* src = W + (size_t)(k0 + 2 * g) * N + n0 + 4 * q;
    f32x4 va[8], vb[8];
#pragma unroll
    for (int i = 0; i < 8; ++i) { va[i] = *(const f32x4*)(src + (size_t)(8 * i) * N); vb[i] = *(const f32x4*)(src + (size_t)(8 * i + 1) * N); }
    LAS unsigned* T32 = (LAS unsigned*)tile;
#pragma unroll
    for (int i = 0; i < 8; ++i)
#pragma unroll
        for (int j = 0; j < 4; ++j) T32[(4 * q + j) * 36 + 4 * i + g] = pkh(va[i][j], vb[i][j]);
    LDS_WAIT();
    const int c = lane & 7;
#pragma unroll
    for (int jj = 0; jj < 8; ++jj) { const int n = (lane >> 3) + 8 * jj; const u32x4 o = *(const LAS u32x4*)(tile + n * 144 + 16 * c);
        int dr = d0 + n;
        if (qk_perm) { const int cc = n0 + n; if (cc < 1280 || (cc >= 1536 && cc < 2816) || (cc >= 3072 && cc < 5120)) { const int d = cc & 127;
                dr = (cc & ~127) + 32 * (2 * (d >> 6) + ((d >> 4) & 1)) + 8 * ((d >> 2) & 3) + 4 * ((d >> 5) & 1) + (d & 3); } }
        *(u32x4*)(WT + (size_t)dr * ldk + k0 + 8 * c) = o; }
    LDS_WAIT();
}
constexpr int I_IN = 64 * 304, I_BR = 16 * 64, I_O = 64 * 64, I_UP = 64 * 344, I_DN = 172 * 64;
constexpr int QT_BR0 = 3 * I_BR, QT_O0 = QT_BR0 + I_O, QT_UP0 = QT_O0 + I_UP, QT_DN0 = QT_UP0 + I_DN, QT_IN1 = QT_DN0 + I_IN,
              QT_BR1 = QT_IN1 + 3 * I_BR, QT_O1 = QT_BR1 + I_O, QT_UP1 = QT_O1 + I_UP, QT_DN1 = QT_UP1 + I_DN, QTOT = QT_DN1;
__device__ __forceinline__ void ph_convert0(const Args& a, LAS unsigned char* lds, int lane, int wave, int wg, int nwgs) {
    LAS unsigned char* tile = lds + wave * 9216;
    for (int it = wg * 8 + wave; it < I_IN; it += nwgs * 8) cvt_item(a.w_in, DM, INW, (f16*)(a.ws + WS_WIN), DM, tile, it, lane, false, true);
}
__device__ __forceinline__ void cvt_queue_item(const Args& a, int q, LAS unsigned char* tile, int lane) {
    int l = 0, r = q;
    if (q >= QT_DN0) { r = q - QT_DN0; if (r < I_IN) { cvt_item(a.w_in + (size_t)DM * INW, DM, INW, (f16*)(a.ws + WS_WIN + SZ_WIN), DM, tile, r, lane, false, true); return; } r -= I_IN; l = 1; }
    if (r < 3 * I_BR) { const int br = r / I_BR; r -= br * I_BR; cvt_item(a.w_branch + (size_t)(l * 3 + br) * 1024 * DM, 1024, DM, (f16*)(a.ws + WS_WBR + l * SZ_WBR) + br * 1024, 3072, tile, r, lane); return; } r -= 3 * I_BR;
    if (r < I_O) { cvt_item(a.w_o + (size_t)l * DM * DM, DM, DM, (f16*)(a.ws + WS_WO + l * SZ_WO), DM, tile, r, lane); return; } r -= I_O;
    if (r < I_UP) { cvt_item(a.w_up + (size_t)l * DM * 2 * DFF, DM, 2 * DFF, (f16*)(a.ws + WS_WUP + l * SZ_WUP), DM, tile, r, lane, true); return; } r -= I_UP;
    cvt_item(a.w_down + (size_t)l * DFF * DM, DFF, DM, (f16*)(a.ws + WS_WDN + l * SZ_WDN), DFF, tile, r, lane);
}
__device__ __forceinline__ int q_need(int p) {
    return p < 6 ? 0 : p < 7 ? QT_BR0 : p < 8 ? QT_O0 : p < 11 ? QT_UP0 : p < 12 ? QT_DN0 : p < 18 ? QT_IN1 : p < 19 ? QT_BR1 : p < 20 ? QT_O1 : p < 23 ? QT_UP1 : QT_DN1;
}
__device__ __forceinline__ bool q_gemm_phase(int p) { const int j = (p - 2) % 12; return p >= 2 && (j == 0 || j == 5 || j == 6 || j == 8 || j == 10); }
__device__ __forceinline__ void bg_convert(const Args& a, LAS unsigned char* lds, volatile LAS unsigned* MISC, int p, int G, const int wave0) {
    unsigned* ctl = (unsigned*)(a.ws + WS_CTL);
    int tid = tid_of(wave0); asm volatile("" : "+v"(tid));
    const int lane = tid & 63, wave = __builtin_amdgcn_readfirstlane(tid >> 6);
    const bool opp = q_gemm_phase(p); const int need = q_need(p);
    if (opp && tid == 0) __hip_atomic_fetch_add(ctl + CW_QD + 64 * p, 1u, __ATOMIC_RELAXED, __HIP_MEMORY_SCOPE_AGENT);
    if (p == 10 && G >= 256 && (int)blockIdx.x >= 128) ph_modgemv(a, lds, tid, lane, wave, 128 + (int)blockIdx.x - 128, 256, 128);
    const int skip = G > 64 ? 32 : 0;
    if ((int)blockIdx.x < skip) return;
    const int NW = (G - skip) * 8, w = ((int)blockIdx.x - skip) * 8 + wave;
    LAS unsigned char* tile = lds + wave * 9216;
    int k = (int)MISC[16 + wave];
    for (;;) {
        const int q = w + k * NW;
        if (q >= QTOT) { if (wave == 0 && lane == 0) MISC[31] = (unsigned)(p + 1); break; }
        if (q >= need) {
            if (!opp) break;
            if (wave == 0) { if ((unsigned)__builtin_amdgcn_readfirstlane((int)__hip_atomic_load(ctl + CW_QD + 64 * p, __ATOMIC_RELAXED, __HIP_MEMORY_SCOPE_AGENT)) >= (unsigned)G) { if (lane == 0) MISC[31] = (unsigned)(p + 1); break; } }
            else if (MISC[31] == (unsigned)(p + 1)) break;
        }
        cvt_queue_item(a, q, tile, lane);
        ++k;
    }
    if (lane == 0) MISC[16 + wave] = (unsigned)k;
}
__device__ __forceinline__ void ph_modulate0(const Args& a, int lane, int wave) {
    const float* MOD = (const float*)(a.ws + WS_MOD);
    f16* H = (f16*)(a.ws + WS_H);
    for (int row = blockIdx.x * 8 + wave; row < MTOT; row += gridDim.x * 8) {
        const int mr = row < SEQ ? 0 : (row < NLAT ? 1 : 2);
        const f32x4* src = (const f32x4*)(row < NLAT ? a.x + (size_t)row * DM : a.ctx + (size_t)(row - NLAT) * DM) + lane;
        const f32x4* sh = (const f32x4*)(MOD + (size_t)mr * NMOD) + lane; const f32x4* sc = (const f32x4*)(MOD + (size_t)mr * NMOD + DM) + lane;
        u32x2* o = (u32x2*)(H + (size_t)row * DM) + lane;
#pragma unroll 4
        for (int j = 0; j < 16; ++j) { const f32x4 v = src[64 * j], s = sc[64 * j], t = sh[64 * j]; const f32x4 y = v * (s + 1.0f) + t;
            o[64 * j] = (u32x2){pkh(y[0], y[1]), pkh(y[2], y[3])}; }
    }
}

__device__ __forceinline__ void ph_post(const Args& a, int l, int lane, int wave) {
    f16* P = (f16*)(a.ws + WS_P);
    const f32x2* rope = (const f32x2*)(a.ws + WS_ROPE);
    const float* qg = a.q_norm_g + l * HD; const float* kg = a.k_norm_g + l * HD;
    const int gsub = lane >> 3, s = lane & 7;
    const int e0 = (s & 3) * 8 + (s >> 2) * 64;
    const int nitems = MTOT * 36;
    for (int it = (blockIdx.x * 8 + wave) * 8 + gsub; it < nitems; it += gridDim.x * 64) {
        const int row = it / 36, hv = it - row * 36;
        int col, kind;
        if (hv < 8) { col = QA_OFF + hv * HD; kind = 0; } else if (hv < 10) { col = KA_OFF + (hv - 8) * HD; kind = 0; }
        else if (hv < 18) { col = QB_OFF + (hv - 10) * HD; kind = 1; } else if (hv < 20) { col = KB_OFF + (hv - 18) * HD; kind = 2; }
        else if (hv < 28) { col = QR_OFF + (hv - 20) * HD; kind = 0; } else { col = KR_OFF + (hv - 28) * HD; kind = 3; }
        const bool lat = row < NLAT;
        if (!lat && kind == 0) continue;
        f16* p = P + (size_t)row * INW + col + e0;
        const h8 x1 = *(const h8*)p, x2 = *(const h8*)(p + 32);
        float f1[8], f2[8];
#pragma unroll
        for (int j = 0; j < 8; ++j) { f1[j] = (float)x1[j]; f2[j] = (float)x2[j]; }
        if (kind == 1 || kind == 2) {
            float ss = 0.f;
#pragma unroll
            for (int j = 0; j < 8; ++j) ss += f1[j] * f1[j] + f2[j] * f2[j];
            ss += __shfl_xor(ss, 1); ss += __shfl_xor(ss, 2); ss += __shfl_xor(ss, 4);
            const float rs = 1.0f / sqrtf(ss * (1.0f / HD) + RMS_EPS);
            const float* g = (kind == 1 ? qg : kg) + e0;
#pragma unroll
            for (int j = 0; j < 8; ++j) { f1[j] = f1[j] * rs * g[j]; f2[j] = f2[j] * rs * g[32 + j]; }
        }
        if (lat) {
            const int t = row & (SEQ - 1); const int pos = (s < 4) ? (t >> 6) : (t & 63);
            const f32x2* cs = rope + pos * 32 + (s & 3) * 8;
#pragma unroll
            for (int j = 0; j < 8; ++j) { const f32x2 w = cs[j]; const float o1 = f1[j] * w.x - f2[j] * w.y, o2 = f2[j] * w.x + f1[j] * w.y; f1[j] = o1; f2[j] = o2; }
        }
        if (kind == 3) {
#pragma unroll
            for (int j = 0; j < 8; ++j) { f1[j] *= ATT_SCALE; f2[j] *= ATT_SCALE; }
        }
        u32x4 w1, w2; w1.x = pkh(f1[0], f1[1]); w1.y = pkh(f1[2], f1[3]); w1.z = pkh(f1[4], f1[5]); w1.w = pkh(f1[6], f1[7]);
        w2.x = pkh(f2[0], f2[1]); w2.y = pkh(f2[2], f2[3]); w2.z = pkh(f2[4], f2[5]); w2.w = pkh(f2[6], f2[7]);
        *(u32x4*)p = w1; *(u32x4*)(p + 32) = w2;
    }
}
__device__ __forceinline__ void ph_ln(const Args& a, const float* g, const float* b, const float* msh, const float* msc, bool writeH, bool writeOut, int Mrows, int lane, int wave) {
    const f16* Z = (const f16*)(a.ws + WS_Z); f16* LAT = (f16*)(a.ws + WS_LAT); f16* H = (f16*)(a.ws + WS_H);
    for (int row = blockIdx.x * 8 + wave; row < Mrows; row += gridDim.x * 8) {
        const h8* zr = (const h8*)(Z + (size_t)row * DM) + lane;
        f32x4 v[8][2]; float s = 0.f;
#pragma unroll
        for (int j = 0; j < 8; ++j) { const h8 t = zr[64 * j]; v[j][0] = (f32x4){(float)t[0], (float)t[1], (float)t[2], (float)t[3]}; v[j][1] = (f32x4){(float)t[4], (float)t[5], (float)t[6], (float)t[7]};
            s += ((v[j][0][0] + v[j][0][1]) + (v[j][0][2] + v[j][0][3])) + ((v[j][1][0] + v[j][1][1]) + (v[j][1][2] + v[j][1][3])); }
        const float mean = wave_sum(s) * (1.0f / DM); float s2 = 0.f;
#pragma unroll
        for (int j = 0; j < 8; ++j)
#pragma unroll
            for (int hh = 0; hh < 2; ++hh) { v[j][hh] = v[j][hh] - mean; s2 += (v[j][hh][0] * v[j][hh][0] + v[j][hh][1] * v[j][hh][1]) + (v[j][hh][2] * v[j][hh][2] + v[j][hh][3] * v[j][hh][3]); }
        const float rstd = 1.0f / sqrtf(wave_sum(s2) * (1.0f / DM) + LN_EPS);
        const int mr = row < SEQ ? 0 : (row < NLAT ? 1 : 2);
        u32x4* lo = (u32x4*)(LAT + (size_t)row * DM) + lane;
        u32x4* ho = (u32x4*)(H + (size_t)row * DM) + lane;
        float* oo = a.out + (size_t)row * DM + lane * 8;
        const float* gg = g + lane * 8; const float* bb = b + lane * 8;
        const float* sh = msh + (size_t)mr * NMOD + lane * 8; const float* sc = msc + (size_t)mr * NMOD + lane * 8;
#pragma unroll
        for (int j = 0; j < 8; ++j) {
            const f32x4 y0 = v[j][0] * rstd * *(const f32x4*)(gg + 512 * j) + *(const f32x4*)(bb + 512 * j), y1 = v[j][1] * rstd * *(const f32x4*)(gg + 512 * j + 4) + *(const f32x4*)(bb + 512 * j + 4);
            if (writeOut) { if (row < NLAT) { *(f32x4*)(oo + 512 * j) = y0; *(f32x4*)(oo + 512 * j + 4) = y1; } }
            else lo[64 * j] = (u32x4){pkh(y0[0], y0[1]), pkh(y0[2], y0[3]), pkh(y1[0], y1[1]), pkh(y1[2], y1[3])};
            if (writeH) { const f32x4 h0 = y0 * (*(const f32x4*)(sc + 512 * j) + 1.0f) + *(const f32x4*)(sh + 512 * j), h1 = y1 * (*(const f32x4*)(sc + 512 * j + 4) + 1.0f) + *(const f32x4*)(sh + 512 * j + 4);
                ho[64 * j] = (u32x4){pkh(h0[0], h0[1]), pkh(h0[2], h0[3]), pkh(h1[0], h1[1]), pkh(h1[2], h1[3])}; } }
    }
}
__device__ __forceinline__ void ph_convfix(const Args& a, int l, int Mrows, int tid) {
    const float* GE = (const float*)(a.ws + WS_SLAB); const float* XP = GE + (size_t)34 * 2 * DFF; const float* UPE = XP + (size_t)34 * 2 * DFF;
    f16* ACT = (f16*)(a.ws + WS_ACT);
    const float* cw = a.conv_w + (size_t)l * 3 * DFF;
    constexpr int NF4 = DFF / 4;
    const int nitems = (Mrows / 256) * 2 * NF4;
    for (int it = blockIdx.x * 512 + tid; it < nitems; it += gridDim.x * 512) {
        const int pe = it / NF4, f = (it - pe * NF4) * 4, pm = pe >> 1, e = pe & 1;
        f32x4 x = *(const f32x4*)(XP + (size_t)pe * DFF + f); const f32x4 up = *(const f32x4*)(UPE + (size_t)pe * DFF + f);
        const bool has = e == 0 ? !(pm >= 32 || (pm & 15) == 0) : !(pm >= 32 || (pm & 15) == 15);
        if (has) { const f32x4 ge = *(const f32x4*)(GE + (size_t)((e ? pm + 1 : pm - 1) * 2 + (e ? 0 : 1)) * DFF + f); const f32x4 w = *(const f32x4*)(cw + (e ? 2 : 0) * DFF + f); x += w * ge; }
        float o[4];
#pragma unroll
        for (int j = 0; j < 4; ++j) o[j] = x[j] * sigmoidf_(x[j]) * up[j];
        *(u32x2*)(ACT + (size_t)(pm * 256 + 255 * e) * DFF + f) = (u32x2){pkh(o[0], o[1]), pkh(o[2], o[3])};
    }
}

namespace att {
constexpr int D = 128, NW = 8, QBLK = 32, KVBLK = 64;
constexpr float SCALE = ATT_SCALE;
constexpr float THR = 8.f;
constexpr int LDQ = INW, LDK = INW, LDO = 3072;
constexpr size_t SHM_V = KVBLK * D * 2, SHM_K = KVBLK * D * 2, SHM_ATTN = 2 * SHM_V + 2 * SHM_K + NW * 64 * 4;
#define KSWZ(row, colB) ((row) * 256 + ((colB) ^ (((row) & 7) << 4)))
#define SBAR() __builtin_amdgcn_sched_barrier(0)
__device__ __forceinline__ int crow(int r, int hi) { return (r & 3) + 8 * (r >> 2) + 4 * hi; }
struct Unit { const f16* Q; const f16* Kc; const f16* Vc; const f16* Kl; const f16* Vl; f16* O; int NT; int qpos0; int kpos0; float sink; int has_sink; };
template <bool MASK>
__device__ __forceinline__ void partialSM(f32x16& p0, f32x16& p1, float& m_reg, float& mn, float& alpha, int dq, bool domask) {
    constexpr float C = SCALE * 1.4426950408889634f;
    if (MASK) { if (domask) {
#pragma unroll
        for (int r = 0; r < 16; ++r) { const int k0 = (r & 3) + 8 * (r >> 2); const int d0 = dq - k0, d1 = dq - 32 - k0;
            p0[r] = (d0 > 128 || d0 < -128) ? -1e30f : p0[r]; p1[r] = (d1 > 128 || d1 < -128) ? -1e30f : p1[r]; } } }
    float pmax = p0[0];
#pragma unroll
    for (int r = 1; r < 16; ++r) pmax = fmaxf(pmax, p0[r]);
#pragma unroll
    for (int r = 0; r < 16; ++r) pmax = fmaxf(pmax, p1[r]);
    { auto rr = __builtin_amdgcn_permlane32_swap(__float_as_uint(pmax), __float_as_uint(pmax), false, false);
      pmax = fmaxf(__uint_as_float(rr[0]), __uint_as_float(rr[1])); }
    if (__builtin_expect(__all(pmax - m_reg <= THR / SCALE), 1)) { mn = m_reg; alpha = 1.f; }
    else { mn = fmaxf(m_reg, pmax); alpha = __builtin_amdgcn_exp2f((m_reg - mn) * C); m_reg = mn; }
    const float mnC = -mn * C;
#pragma unroll
    for (int r = 0; r < 16; ++r) p0[r] = fmaf(p0[r], C, mnC);
#pragma unroll
    for (int r = 0; r < 16; ++r) p1[r] = fmaf(p1[r], C, mnC);
#pragma unroll
    for (int r = 0; r < 16; ++r) p0[r] = __builtin_amdgcn_exp2f(p0[r]);
}
__device__ __forceinline__ void finishSM(f32x16& p0, f32x16& p1, float alpha, float& l_reg, h8& pa0, h8& pa1, h8& pa2, h8& pa3) {
#pragma unroll
    for (int r = 0; r < 16; ++r) p1[r] = __builtin_amdgcn_exp2f(p1[r]);
    float ps = 0;
#pragma unroll
    for (int r = 0; r < 16; ++r) ps += p0[r];
#pragma unroll
    for (int r = 0; r < 16; ++r) ps += p1[r];
    { auto rr = __builtin_amdgcn_permlane32_swap(__float_as_uint(ps), __float_as_uint(ps), false, false);
      ps = __uint_as_float(rr[0]) + __uint_as_float(rr[1]); }
    l_reg = l_reg * alpha + ps;
#define PK4(P, BASE, OUT) do { unsigned a0 = pkh(P[BASE + 0], P[BASE + 1]), a1 = pkh(P[BASE + 2], P[BASE + 3]);   \
    unsigned b0 = pkh(P[BASE + 4], P[BASE + 5]), b1 = pkh(P[BASE + 6], P[BASE + 7]);                              \
    auto r0 = __builtin_amdgcn_permlane32_swap(a0, b0, false, false); auto r1 = __builtin_amdgcn_permlane32_swap(a1, b1, false, false); \
    u32x4 w = {r0[0], r1[0], r0[1], r1[1]}; OUT = __builtin_bit_cast(h8, w); } while (0)
    PK4(p0, 0, pa0); PK4(p0, 8, pa1); PK4(p1, 0, pa2); PK4(p1, 8, pa3);
#undef PK4
}
__device__ __forceinline__ void qkt(f32x16& p0, f32x16& p1, const char* Ks, const h8* qr, int r32, int hi) {
    p0 = f32x16{}; p1 = f32x16{};
#pragma unroll
    for (int d0 = 0; d0 < 8; ++d0) { const int cb = (d0 * 16 + hi * 8) * 2;
        const h8 b0 = *reinterpret_cast<const h8*>(Ks + KSWZ(r32, cb));
        const h8 b1 = *reinterpret_cast<const h8*>(Ks + KSWZ(32 + r32, cb));
        p0 = __builtin_amdgcn_mfma_f32_32x32x16_f16(b0, qr[d0], p0, 0, 0, 0);
        p1 = __builtin_amdgcn_mfma_f32_32x32x16_f16(b1, qr[d0], p1, 0, 0, 0); }
}
__device__ __forceinline__ int v_st(int k, int c) { const int kk = (k & ~0xC) | ((k & 4) << 1) | ((k & 8) >> 1); return ((kk >> 3) * 4 + (c >> 5)) * 512 + ((kk & 7) * 32 + (c & 31)) * 2; }
__device__ __forceinline__ int v_rd_base(int lane) { return ((lane & 3) << 3) | (((lane >> 2) & 3) << 6) | (((lane >> 4) & 1) << 5) | (((lane >> 5) & 1) << 8); }
constexpr int v_rd_off(int d0, int ks, int half) { return d0 * 512 + ks * 4096 + half * 2048; }
template <int OFF> __device__ __forceinline__ s16x4 tr_read(int vb) {
    s16x4 r; asm volatile("ds_read_b64_tr_b16 %0, %1 offset:%2" : "=&v"(r) : "v"(vb), "i"(OFF) : "memory"); return r;
}
template <int D0> __device__ __forceinline__ void pv_one(f32x16& od, int vb, h8 pa0, h8 pa1, h8 pa2, h8 pa3) {
    const s16x4 l0 = tr_read<v_rd_off(D0, 0, 0)>(vb), h0 = tr_read<v_rd_off(D0, 0, 1)>(vb), l1 = tr_read<v_rd_off(D0, 1, 0)>(vb), h1 = tr_read<v_rd_off(D0, 1, 1)>(vb);
    const s16x4 l2 = tr_read<v_rd_off(D0, 2, 0)>(vb), h2_ = tr_read<v_rd_off(D0, 2, 1)>(vb), l3 = tr_read<v_rd_off(D0, 3, 0)>(vb), h3 = tr_read<v_rd_off(D0, 3, 1)>(vb);
    asm volatile("s_waitcnt lgkmcnt(0)" ::: "memory"); SBAR();
#define PK(L, H) __builtin_bit_cast(h8, (__attribute__((ext_vector_type(8))) short){L[0], L[1], L[2], L[3], H[0], H[1], H[2], H[3]})
    od = __builtin_amdgcn_mfma_f32_32x32x16_f16(pa0, PK(l0, h0), od, 0, 0, 0);
    od = __builtin_amdgcn_mfma_f32_32x32x16_f16(pa1, PK(l1, h1), od, 0, 0, 0);
    od = __builtin_amdgcn_mfma_f32_32x32x16_f16(pa2, PK(l2, h2_), od, 0, 0, 0);
    od = __builtin_amdgcn_mfma_f32_32x32x16_f16(pa3, PK(l3, h3), od, 0, 0, 0);
#undef PK
}
__device__ __forceinline__ void pv_d0(f32x16* o, int vb, h8 pa0, h8 pa1, h8 pa2, h8 pa3) {
    pv_one<0>(o[0], vb, pa0, pa1, pa2, pa3); pv_one<1>(o[1], vb, pa0, pa1, pa2, pa3); pv_one<2>(o[2], vb, pa0, pa1, pa2, pa3); pv_one<3>(o[3], vb, pa0, pa1, pa2, pa3);
}
template <bool MASK>
__device__ __forceinline__ void attn_unit(const Unit& u, char* lds, const int wave0) {
    int tid = tid_of(wave0); asm volatile("" : "+v"(tid));
    const int wid = tid >> 6, lane = tid & 63, r32 = lane & 31, hi = lane >> 5;
    char* V_lds = lds; char* K_lds = lds + 2 * SHM_V;
    float* ws = (float*)(lds + 2 * SHM_V + 2 * SHM_K) + wid * 64; float* li_l = ws; float* al_l = ws + 32;
    float m_reg = u.has_sink ? u.sink * (1.0f / SCALE) : -1e30f, l_reg = u.has_sink ? 1.0f : 0.0f; f32x16 o[4] = {}; h8 qr[8];
    const f16* Qw = u.Q + (long)(wid * QBLK + r32) * LDQ + hi * 8;
#pragma unroll
    for (int d0 = 0; d0 < 8; ++d0) qr[d0] = *reinterpret_cast<const h8*>(Qw + d0 * 16);
    const int sr = tid >> 4, sc = (tid & 15) * 8, vst0 = v_st(sr, sc), vst1 = v_st(32 + sr, sc);
    const int vb0 = (int)(uintptr_t)V_lds + v_rd_base(lane);
    struct { h8 vs0, vs1, ks0, ks1; } sr_[2];
    const int qposw = u.qpos0 + wid * QBLK + r32;
#define TILEK(j) ((j) < 4 ? u.Kc + (long)(j) * KVBLK * LDK : u.Kl + (long)((j) - 4) * KVBLK * LDK)
#define TILEV(j) ((j) < 4 ? u.Vc + (long)(j) * KVBLK * LDK : u.Vl + (long)((j) - 4) * KVBLK * LDK)
#define SLOAD(i, j) do { const f16* kp_ = TILEK(j); const f16* vp_ = TILEV(j); sr_[i].vs0 = *(const h8*)(vp_ + (long)sr * LDK + sc); sr_[i].vs1 = *(const h8*)(vp_ + (long)(32 + sr) * LDK + sc); \
    sr_[i].ks0 = *(const h8*)(kp_ + (long)sr * LDK + sc); sr_[i].ks1 = *(const h8*)(kp_ + (long)(32 + sr) * LDK + sc); } while (0)
#define SWRITE(b, i) do { *(h8*)(V_lds + (b) * SHM_V + vst0) = sr_[i].vs0;          \
    *(h8*)(V_lds + (b) * SHM_V + vst1) = sr_[i].vs1; const int kc = sc * 2;               \
    *(h8*)(K_lds + (b) * SHM_K + KSWZ(sr, kc)) = sr_[i].ks0;                       \
    *(h8*)(K_lds + (b) * SHM_K + KSWZ(32 + sr, kc)) = sr_[i].ks1; } while (0)
#define SWAIT() asm volatile("s_waitcnt vmcnt(4)" ::: "memory")
#define RESC(a) do { if (__any((a) < 1.f)) { if (hi == 0) al_l[r32] = (a); asm volatile("s_waitcnt lgkmcnt(0)" ::: "memory"); \
    _Pragma("unroll") for (int d = 0; d < 4; ++d) _Pragma("unroll") for (int r = 0; r < 16; ++r) o[d][r] *= al_l[crow(r, hi)]; } } while (0)
#define DQ(j) (qposw - (u.kpos0 + ((j) - 4) * KVBLK) - 4 * hi)
    f32x16 pA0, pA1, pB0, pB1; float mnA, mnB, alA, alB; h8 pa0, pa1, pa2, pa3; const int NT = u.NT;
    constexpr int SE = 0, SO = 1;
    SLOAD(SE, 0); asm volatile("s_waitcnt vmcnt(0)" ::: "memory"); SWRITE(0, SE); __syncthreads();
    qkt(pA0, pA1, K_lds, qr, r32, hi); partialSM<MASK>(pA0, pA1, m_reg, mnA, alA, 0, false);
    SLOAD(SO, 1); if (2 < NT) SLOAD(SE, 2);
    SWAIT(); SWRITE(1, SO); __syncthreads();
    for (int j = 1; j + 1 < NT; j += 2) {
        SBAR(); qkt(pB0, pB1, K_lds + SHM_K, qr, r32, hi);
        finishSM(pA0, pA1, alA, l_reg, pa0, pa1, pa2, pa3); SBAR();
        SLOAD(SO, j + 2); SBAR();
        pv_d0(o, vb0, pa0, pa1, pa2, pa3); partialSM<MASK>(pB0, pB1, m_reg, mnB, alB, DQ(j), j >= 4);
        __syncthreads(); SWAIT(); SWRITE(0, SE);
        RESC(alB); __syncthreads();
        SBAR(); qkt(pA0, pA1, K_lds, qr, r32, hi);
        finishSM(pB0, pB1, alB, l_reg, pa0, pa1, pa2, pa3); SBAR();
        if (j + 3 < NT) SLOAD(SE, j + 3); SBAR();
        pv_d0(o, vb0 + (int)SHM_V, pa0, pa1, pa2, pa3); partialSM<MASK>(pA0, pA1, m_reg, mnA, alA, DQ(j + 1), j + 1 >= 4);
        __syncthreads(); SWAIT(); SWRITE(1, SO);
        RESC(alA); __syncthreads();
    }
    SBAR(); qkt(pB0, pB1, K_lds + SHM_K, qr, r32, hi);
    finishSM(pA0, pA1, alA, l_reg, pa0, pa1, pa2, pa3); SBAR();
    pv_d0(o, vb0, pa0, pa1, pa2, pa3); partialSM<MASK>(pB0, pB1, m_reg, mnB, alB, DQ(NT - 1), NT - 1 >= 4);
    __syncthreads(); RESC(alB);
    finishSM(pB0, pB1, alB, l_reg, pa0, pa1, pa2, pa3); SBAR();
    pv_d0(o, vb0 + (int)SHM_V, pa0, pa1, pa2, pa3);
    if (hi == 0) li_l[r32] = l_reg; asm volatile("s_waitcnt lgkmcnt(0)" ::: "memory");
    float rli[16];
#pragma unroll
    for (int r = 0; r < 16; ++r) rli[r] = __builtin_amdgcn_rcpf(li_l[crow(r, hi)]);
    f16* Ow = u.O + (long)(wid * QBLK) * LDO;
#pragma unroll
    for (int r = 0; r < 16; ++r) { const int orow = crow(r, hi);
#pragma unroll
        for (int d0 = 0; d0 < 4; ++d0) Ow[(long)orow * LDO + d0 * 32 + r32] = (f16)(o[d0][r] * rli[r]); }
    __syncthreads();
#undef TILEK
#undef TILEV
#undef SLOAD
#undef SWRITE
#undef SWAIT
#undef RESC
#undef DQ
}
}

__device__ __forceinline__ int chunk_row0(int cidx) { const int b = cidx / 34, cid = cidx - b * 34; return cid < 2 ? NLAT + b * CTXL + cid * 128 : b * SEQ + (cid - 2) * 128; }
constexpr int RS = 136;
template <int NOUT>
__device__ __forceinline__ void load_transposed(const f16* src, LAS f16* T0, LAS f16* T1, float lg0, float lg1, int tid) {
#pragma unroll
    for (int it = 0; it < 4; ++it) { const int idx = tid + it * 512, g = idx >> 7, t = idx & 127;
        const h8 x = *(const h8*)(src + (size_t)t * INW + g * 8);
        if (NOUT == 1) {
#pragma unroll
            for (int i = 0; i < 8; ++i) T0[(g * 8 + i) * RS + t] = x[i];
        } else {
            const float wf = __builtin_amdgcn_exp2f(lg0 * (float)(127 - t)), wb = __builtin_amdgcn_exp2f(lg1 * (float)t);
#pragma unroll
            for (int i = 0; i < 8; ++i) { T0[(g * 8 + i) * RS + t] = (f16)((float)x[i] * wf); T1[(g * 8 + i) * RS + t] = (f16)((float)x[i] * wb); }
        } }
}
__device__ __forceinline__ void load_rows(const f16* src, size_t ld, LAS f16* T, int tid) {
#pragma unroll
    for (int it = 0; it < 4; ++it) { const int idx = tid + it * 512, r = idx >> 4, c = (idx & 15) * 8;
        *(LAS h8*)(T + r * RS + c) = *(const h8*)(src + (size_t)r * ld + c); }
}
__device__ __forceinline__ void ret_c1_unit(const Args& a, int l, int cidx, int h, LAS unsigned char* lds, const int wave0) {
    int tid = tid_of(wave0); asm volatile("" : "+v"(tid));
    const int lane = tid & 63, wave = __builtin_amdgcn_readfirstlane(tid >> 6);
    const f16* P = (const f16*)(a.ws + WS_P);
    float* UT = (float*)(a.ws + WS_UT);
    LAS f16* VT = (LAS f16*)lds; LAS f16* KTf = VT + 128 * RS; LAS f16* KTb = KTf + 128 * RS;
    const float lgf = -__expf(a.ret_decay[(l * 2 + 0) * 8 + h]) * 1.4426950408889634f, lgb = -__expf(a.ret_decay[(l * 2 + 1) * 8 + h]) * 1.4426950408889634f;
    const int row0 = chunk_row0(cidx);
    load_transposed<1>(P + (size_t)row0 * INW + VR_OFF + h * HD, VT, VT, 0.f, 0.f, tid);
    load_transposed<2>(P + (size_t)row0 * INW + KR_OFF + h * HD, KTf, KTb, lgf, lgb, tid);
    __syncthreads();
    const int fr = lane & 15, fq = lane >> 4;
    f32x4 af[8], ab[8];
#pragma unroll
    for (int n = 0; n < 8; ++n) { af[n] = (f32x4){0.f, 0.f, 0.f, 0.f}; ab[n] = af[n]; }
#pragma unroll
    for (int ks = 0; ks < 4; ++ks) {
        const h8 A = *(const LAS h8*)(VT + (16 * wave + fr) * RS + 32 * ks + 8 * fq);
#pragma unroll
        for (int n = 0; n < 8; ++n) {
            const h8 Bf = *(const LAS h8*)(KTf + (16 * n + fr) * RS + 32 * ks + 8 * fq);
            const h8 Bb = *(const LAS h8*)(KTb + (16 * n + fr) * RS + 32 * ks + 8 * fq);
            af[n] = __builtin_amdgcn_mfma_f32_16x16x32_f16(Bf, A, af[n], 0, 0, 0);
            ab[n] = __builtin_amdgcn_mfma_f32_16x16x32_f16(Bb, A, ab[n], 0, 0, 0);
        }
    }
    float* uf = UT + ((size_t)(cidx * 8 + h) * 2 + 0) * 16384 + (16 * wave + fr) * 128 + 4 * fq; float* ub = uf + 16384;
#pragma unroll
    for (int n = 0; n < 8; ++n) { *(f32x4*)(uf + 16 * n) = af[n]; *(f32x4*)(ub + 16 * n) = ab[n]; }
    __syncthreads();
}
__device__ __forceinline__ void ph_scan(const Args& a, int l, int tid) {
    const float* UT = (const float*)(a.ws + WS_UT); f16* ST = (f16*)(a.ws + WS_ST);
    for (int it = blockIdx.x * 512 + tid; it < NBATCH * 8 * 2 * 4096; it += gridDim.x * 512) {
        const int e4 = it & 4095, dir = (it >> 12) & 1, h = (it >> 13) & 7, b = it >> 16;
        const float decay = __expf(-__expf(a.ret_decay[(l * 2 + dir) * 8 + h]) * 128.0f);
        f32x4 s = {0.f, 0.f, 0.f, 0.f};
#pragma unroll 17
        for (int i = 0; i < 34; ++i) {
            const int cid = dir == 0 ? i : (i < 2 ? 1 - i : 35 - i);
            const size_t off = ((size_t)((b * 34 + cid) * 8 + h) * 2 + dir) * 16384 + (size_t)e4 * 4;
            const f32x4 uv = *(const f32x4*)(UT + off);
            *(u32x2*)(ST + off) = (u32x2){pkh(s[0], s[1]), pkh(s[2], s[3])};
            s = s * decay + uv;
        }
    }
}
__device__ __forceinline__ void ret_c3_unit(const Args& a, int l, int cidx, int h, LAS unsigned char* lds, const int wave0) {
    int tid = tid_of(wave0); asm volatile("" : "+v"(tid));
    const int lane = tid & 63, wave = __builtin_amdgcn_readfirstlane(tid >> 6);
    unsigned char* wsl = a.ws; asm volatile("" : "+s"(wsl));
    const f16* P = (const f16*)(wsl + WS_P);
    const f16* ST = (const f16*)(wsl + WS_ST);
    f16* Yc = (f16*)(wsl + WS_Y) + 2048;
    LAS f16* KS = (LAS f16*)lds; LAS f16* VT = KS + 128 * RS; LAS f16* ATT = VT + 128 * RS + wave * 16 * RS;
    const float lgf = -__expf(a.ret_decay[(l * 2 + 0) * 8 + h]) * 1.4426950408889634f, lgb = -__expf(a.ret_decay[(l * 2 + 1) * 8 + h]) * 1.4426950408889634f;
    const int row0 = chunk_row0(cidx);
    const int fr = lane & 15, fq = lane >> 4;
    const int pc = 16 * wave + fr;
    const f16* STf = ST + ((size_t)(cidx * 8 + h) * 2 + 0) * 16384; const f16* STb = STf + 16384;
    h8 kr[4], vr[4], sf[4], sb[4], qf[4]; h4 grv[8]; f32x4 gnv[8];
#pragma unroll
    for (int it = 0; it < 4; ++it) { const int idx = tid + it * 512, r = idx >> 4, c = (idx & 15) * 8, g = idx >> 7, t = idx & 127;
        kr[it] = *(const h8*)(P + (size_t)(row0 + r) * INW + KR_OFF + h * HD + c);
        vr[it] = *(const h8*)(P + (size_t)(row0 + t) * INW + VR_OFF + h * HD + g * 8); }
#pragma unroll
    for (int ks = 0; ks < 4; ++ks) qf[ks] = *(const h8*)(P + (size_t)(row0 + pc) * INW + QR_OFF + h * HD + 32 * ks + 8 * fq);
#pragma unroll
    for (int it = 0; it < 4; ++it) { const int idx = tid + it * 512, r = idx >> 4, c = (idx & 15) * 8; sf[it] = *(const h8*)(STf + r * 128 + c); }
    const float* gn = a.ret_gn_g + l * 1024 + h * HD;
#pragma unroll
    for (int it = 0; it < 4; ++it) { const int idx = tid + it * 512, r = idx >> 4, c = (idx & 15) * 8, g = idx >> 7, t = idx & 127;
        *(LAS h8*)(KS + r * RS + c) = kr[it];
#pragma unroll
        for (int i = 0; i < 8; ++i) VT[(g * 8 + i) * RS + t] = vr[it][i]; }
    __syncthreads();
#pragma unroll
    for (int it = 0; it < 4; ++it) { const int idx = tid + it * 512, r = idx >> 4, c = (idx & 15) * 8; sb[it] = *(const h8*)(STb + r * 128 + c); }
#pragma unroll
    for (int n = 0; n < 8; ++n) grv[n] = *(const h4*)(P + (size_t)(row0 + pc) * INW + GR_OFF + h * HD + 16 * n + 4 * fq);
    f32x4 acc[8];
#pragma unroll
    for (int n = 0; n < 8; ++n) acc[n] = (f32x4){0.f, 0.f, 0.f, 0.f};
#pragma unroll
    for (int ks = 0; ks < 4; ++ks)
#pragma unroll
        for (int n = 0; n < 8; ++n) acc[n] = __builtin_amdgcn_mfma_f32_16x16x32_f16(*(const LAS h8*)(KS + (16 * n + fr) * RS + 32 * ks + 8 * fq), qf[ks], acc[n], 0, 0, 0);
#pragma unroll
    for (int n = 0; n < 8; ++n) { h4 w;
#pragma unroll
        for (int r = 0; r < 4; ++r) { const int m = 16 * n + 4 * fq + r, dl = pc - m;
            const float wgt = dl >= 0 ? __builtin_amdgcn_exp2f(lgf * (float)dl) : __builtin_amdgcn_exp2f(lgb * (float)(-dl));
            w[r] = (f16)(acc[n][r] * wgt); }
        *(LAS h4*)(ATT + fr * RS + 16 * n + 4 * fq) = w; }
    __syncthreads();
#pragma unroll
    for (int it = 0; it < 4; ++it) { const int idx = tid + it * 512, r = idx >> 4, c = (idx & 15) * 8; *(LAS h8*)(KS + r * RS + c) = sf[it]; }
    f32x4 o[8];
#pragma unroll
    for (int n = 0; n < 8; ++n) o[n] = (f32x4){0.f, 0.f, 0.f, 0.f};
#pragma unroll
    for (int ks = 0; ks < 4; ++ks) { const h8 B = *(const LAS h8*)(ATT + fr * RS + 32 * ks + 8 * fq);
#pragma unroll
        for (int n = 0; n < 8; ++n) o[n] = __builtin_amdgcn_mfma_f32_16x16x32_f16(*(const LAS h8*)(VT + (16 * n + fr) * RS + 32 * ks + 8 * fq), B, o[n], 0, 0, 0); }
    __syncthreads();
#pragma unroll
    for (int it = 0; it < 4; ++it) { const int idx = tid + it * 512, r = idx >> 4, c = (idx & 15) * 8; *(LAS h8*)(VT + r * RS + c) = sb[it]; }
#pragma unroll
    for (int n = 0; n < 8; ++n) acc[n] = (f32x4){0.f, 0.f, 0.f, 0.f};
#pragma unroll
    for (int ks = 0; ks < 4; ++ks)
#pragma unroll
        for (int n = 0; n < 8; ++n) acc[n] = __builtin_amdgcn_mfma_f32_16x16x32_f16(*(const LAS h8*)(KS + (16 * n + fr) * RS + 32 * ks + 8 * fq), qf[ks], acc[n], 0, 0, 0);
    { const float dq = __builtin_amdgcn_exp2f(lgf * (float)(pc + 1));
#pragma unroll
      for (int n = 0; n < 8; ++n) o[n] += dq * acc[n]; }
    __syncthreads();
#pragma unroll
    for (int n = 0; n < 8; ++n) gnv[n] = *(const f32x4*)(gn + 16 * n + 4 * fq);
#pragma unroll
    for (int n = 0; n < 8; ++n) acc[n] = (f32x4){0.f, 0.f, 0.f, 0.f};
#pragma unroll
    for (int ks = 0; ks < 4; ++ks)
#pragma unroll
        for (int n = 0; n < 8; ++n) acc[n] = __builtin_amdgcn_mfma_f32_16x16x32_f16(*(const LAS h8*)(VT + (16 * n + fr) * RS + 32 * ks + 8 * fq), qf[ks], acc[n], 0, 0, 0);
    { const float dq = __builtin_amdgcn_exp2f(lgb * (float)(128 - pc));
#pragma unroll
      for (int n = 0; n < 8; ++n) o[n] += dq * acc[n]; }
    float s = 0.f;
#pragma unroll
    for (int n = 0; n < 8; ++n) s += (o[n][0] + o[n][1]) + (o[n][2] + o[n][3]);
    s += __shfl_xor(s, 16); s += __shfl_xor(s, 32);
    const float mean = s * (1.0f / 128.0f); float q = 0.f;
#pragma unroll
    for (int n = 0; n < 8; ++n) { const f32x4 d = o[n] - mean; q += (d[0] * d[0] + d[1] * d[1]) + (d[2] * d[2] + d[3] * d[3]); }
    q += __shfl_xor(q, 16); q += __shfl_xor(q, 32);
    const float rstd = 1.0f / sqrtf(q * (1.0f / 128.0f) + GN_EPS);
    f16* yrow = Yc + (size_t)(row0 + pc) * 3072 + h * HD + 4 * fq;
#pragma unroll
    for (int n = 0; n < 8; ++n) { h4 w;
#pragma unroll
        for (int r = 0; r < 4; ++r) { const float gr = (float)grv[n][r]; w[r] = (f16)(gr * sigmoidf_(gr) * ((o[n][r] - mean) * rstd * gnv[n][r])); }
        *(h4*)(yrow + 16 * n) = w; }
    __syncthreads();
}

constexpr int N_PHASES = 26;
__global__ void __launch_bounds__(512, 2) mixer_fwd(Args a) {
    extern __shared__ __attribute__((aligned(16))) unsigned char lds_raw[];
    LAS unsigned char* lds = (LAS unsigned char*)lds_raw;
    const int tid = threadIdx.x, lane = tid & 63, wave = __builtin_amdgcn_readfirstlane(tid >> 6);
    const int wave0 = wave;
    const int G = gridDim.x;
    volatile LAS unsigned* MISC = (volatile LAS unsigned*)(lds + MISC_OFF);
    for (int u = tid; u < (LDS_BYTES - RING_BYTES) / 4; u += 512) ((LAS unsigned*)(lds + RING_BYTES))[u] = 0u;
    __syncthreads();
    unsigned* ctl = (unsigned*)(a.ws + WS_CTL);
    XcdBarrier bar; bar.bar = ctl + CW_BAR; bar.x = 0; bar.st = nullptr;
    if (!MK_PER_PHASE) bar = xcd_barrier_post(ctl + CW_BAR, MISC + 8, tid);
    const int lo = a.ph_lo, hi = a.ph_hi;
#ifndef PH_MASK
#define PH_MASK 0xFFFFFFFFu
#endif
#define PH_ON(b) (((PH_MASK) >> (b)) & 1u)
#ifndef RPT_MASK
#define RPT_MASK 0u
#endif
#define NREP(b) ((((RPT_MASK) >> (b)) & 1u) ? 2 : 1)
#define REPBAR(b, rep) do { if (NREP(b) == 2 && (rep) == 0) xcd_barrier(bar, wave0); } while (0)
#define IN(k) (lo <= (k) && (k) < hi)
#define SEAM(k) do { if (IN(k)) { if ((k) >= 2) bg_convert(a, lds, MISC, (k), G, wave0); if (IN((k) + 1)) xcd_barrier(bar, wave0); } } while (0)
#define TL() int tid = tid_of(wave0); asm volatile("" : "+v"(tid)); const int lane = tid & 63, wave = __builtin_amdgcn_readfirstlane(tid >> 6); (void)lane; (void)wave;
#define WSP() unsigned char* ws_ = a.ws; asm volatile("" : "+s"(ws_)); \
    float* MOD = (float*)(ws_ + WS_MOD); f16* H = (f16*)(ws_ + WS_H); f16* P = (f16*)(ws_ + WS_P); f16* Y = (f16*)(ws_ + WS_Y); f16* MH = (f16*)(ws_ + WS_MH); \
    f16* Z = (f16*)(ws_ + WS_Z); f16* LAT = (f16*)(ws_ + WS_LAT); f16* ACT = (f16*)(ws_ + WS_ACT); float* slab = (float*)(ws_ + WS_SLAB); unsigned* ctl_ = (unsigned*)(ws_ + WS_CTL); \
    const float* modl = MOD + (size_t)l * 3 * NMOD; (void)H; (void)P; (void)Y; (void)MH; (void)Z; (void)LAT; (void)ACT; (void)slab; (void)ctl_; (void)modl;
    if (PH_ON(0) && IN(0)) _Pragma("unroll") for (int rep_ = 0; rep_ < NREP(0); ++rep_) { {
        if (blockIdx.x == 0) rope_table((f32x2*)(a.ws + WS_ROPE), tid);
        if (G >= 256) {
            if ((int)blockIdx.x < 128) ph_modgemv(a, lds, tid, lane, wave, (int)blockIdx.x, 128, 128);
            else ph_convert0(a, lds, lane, wave, (int)blockIdx.x - 128, G - 128);
        } else { ph_modgemv(a, lds, tid, lane, wave, (int)blockIdx.x, 256, G); ph_convert0(a, lds, lane, wave, (int)blockIdx.x, G); }
    } REPBAR(0, rep_); }
    SEAM(0);
    if (PH_ON(1) && IN(1)) _Pragma("unroll") for (int rep_ = 0; rep_ < NREP(1); ++rep_) { { ph_modulate0(a, lane, wave); } REPBAR(1, rep_); }
    SEAM(1);

#pragma unroll 1
    for (int l = 0; l < 2; ++l) {
        const int pb = 2 + 12 * l;
        const bool last = (l == 1);
        const int Mrows = last ? NLAT : MTOT;
        if (PH_ON(2) && IN(pb + 0)) _Pragma("unroll") for (int rep_ = 0; rep_ < NREP(2); ++rep_) { { WSP();
            pg8::Gemm g{H, (const f16*)(a.ws + WS_WIN + l * SZ_WIN), MTOT, INW, DM}; int Gi_ = G; asm volatile("" : "+s"(Gi_)); const bool sk8i = SK8_IN && !last && Gi_ == 256 && XORDER;
            pg8::SKOrder S; S.init(last ? NLAT : MTOT, INW, DM, G, (int)blockIdx.x, last ? 24 : 0, 0, 0, sk8i ? 128 : (1 << 30));
            pg8::EpiIn E{P, (const f32x2*)(ws_ + WS_ROPE), a.q_norm_g + l * HD, a.k_norm_g + l * HD, (LAS float*)(lds + RING_BYTES + 1024), (f16*)(ws_ + WS_GLT), a.b_gate + l * 3 * DM};
            pg8::gemm_phase<pg8::EpiIn, pg8::SKOrder>(lds, g, S, E, pg8::SKCtx{slab, ctl_ + CW_SK + (l * 5 + 0) * SK_BANK}, wave0);
            if (sk8i) { pg8::SK8Order S8; S8.init(DM, (int)blockIdx.x, 128, 24);
                pg8::gemm_phase<pg8::EpiIn, pg8::SK8Order, true, true, true>(lds, g, S8, E, pg8::SKCtx{(float*)(ws_ + WS_MF), ctl_ + CW_SK + (l * 5 + 0) * SK_BANK}, wave0); }
        } REPBAR(2, rep_); }
        do { if (IN(pb + 0)) { bg_convert(a, lds, MISC, pb + 0, G, wave0); if (IN(pb + 1) || IN(pb + 2)) xcd_barrier(bar, wave0); } } while (0);
        if (PH_ON(4) && IN(pb + 2)) _Pragma("unroll") for (int rep_ = 0; rep_ < NREP(4); ++rep_) { { WSP();
            for (int ui = blockIdx.x; ui < 256; ui += G) {
                const int b = ui >> 7, h = (ui >> 4) & 7, qb = ui & 15, g = h >> 2;
                const int kl0 = qb == 0 ? 0 : qb * 256 - 128, kend = qb == 15 ? SEQ : qb * 256 + 384;
                att::Unit u;
                u.Q = P + (size_t)(b * SEQ + qb * 256) * INW + QA_OFF + h * HD;
                u.Kc = P + (size_t)(NLAT + b * CTXL) * INW + KA_OFF + g * HD; u.Vc = P + (size_t)(NLAT + b * CTXL) * INW + VA_OFF + g * HD;
                u.Kl = P + (size_t)(b * SEQ + kl0) * INW + KA_OFF + g * HD; u.Vl = P + (size_t)(b * SEQ + kl0) * INW + VA_OFF + g * HD;
                u.O = Y + (size_t)(b * SEQ + qb * 256) * 3072 + h * HD; u.NT = 4 + (kend - kl0) / 64; u.qpos0 = qb * 256; u.kpos0 = kl0;
                u.sink = a.attn_sink[l * 8 + h]; u.has_sink = 1;
                att::attn_unit<true>(u, (char*)lds_raw, wave0);
            }
            if (!last) {
                for (int v = blockIdx.x; v < 32; v += G) {
                    const int isB = v >> 4, b = (v >> 3) & 1, h = v & 7, g = h >> 2;
                    att::Unit u;
                    const size_t r0 = (size_t)(NLAT + b * CTXL);
                    u.Q = P + r0 * INW + (isB ? QB_OFF : QA_OFF) + h * HD;
                    u.Kc = P + r0 * INW + (isB ? KB_OFF : KA_OFF) + g * HD; u.Vc = P + r0 * INW + (isB ? VB_OFF : VA_OFF) + g * HD;
                    u.Kl = u.Kc; u.Vl = u.Vc; u.O = Y + r0 * 3072 + (isB ? 1024 : 0) + h * HD; u.NT = 4; u.qpos0 = 0; u.kpos0 = 0;
                    u.sink = a.attn_sink[l * 8 + h]; u.has_sink = isB ? 0 : 1;
                    att::attn_unit<false>(u, (char*)lds_raw, wave0);
                }
            }
            for (int v = G - 1 - (int)blockIdx.x; v < NCHUNK * 8; v += G) ret_c1_unit(a, l, v >> 3, v & 7, lds, wave0);
        } REPBAR(4, rep_); }
        SEAM(pb + 2);
        if (PH_ON(5) && IN(pb + 3)) _Pragma("unroll") for (int rep_ = 0; rep_ < NREP(5); ++rep_) { { TL(); ph_scan(a, l, tid); } REPBAR(5, rep_); }
        SEAM(pb + 3);
        if (PH_ON(6) && IN(pb + 4)) _Pragma("unroll") for (int rep_ = 0; rep_ < NREP(6); ++rep_) { { WSP();
            for (int ui = blockIdx.x; ui < 256; ui += G) {
                const int b = ui >> 7, h = (ui >> 4) & 7, qb = ui & 15, g = h >> 2;
                att::Unit u;
                u.Q = P + (size_t)(b * SEQ + qb * 256) * INW + QB_OFF + h * HD;
                u.Kc = P + (size_t)(NLAT + b * CTXL) * INW + KB_OFF + g * HD; u.Vc = P + (size_t)(NLAT + b * CTXL) * INW + VB_OFF + g * HD;
                u.Kl = P + (size_t)(b * SEQ) * INW + KB_OFF + g * HD; u.Vl = P + (size_t)(b * SEQ) * INW + VB_OFF + g * HD;
                u.O = Y + (size_t)(b * SEQ + qb * 256) * 3072 + 1024 + h * HD; u.NT = 4 + SEQ / 64; u.qpos0 = 0; u.kpos0 = 0; u.sink = 0.f; u.has_sink = 0;
                att::attn_unit<false>(u, (char*)lds_raw, wave0);
            }
            for (int v = G - 1 - (int)blockIdx.x; v < NCHUNK * 8; v += G) {
                if (last && (v >> 3) % 34 < 2) continue;
                ret_c3_unit(a, l, v >> 3, v & 7, lds, wave0);
            }
        } REPBAR(6, rep_); }
        SEAM(pb + 4);
        if (PH_ON(7) && IN(pb + 5)) _Pragma("unroll") for (int rep_ = 0; rep_ < NREP(7); ++rep_) { { WSP();
            pg8::Gemm g{Y, (const f16*)(a.ws + WS_WBR + l * SZ_WBR), Mrows, DM, 3072}; pg8::SKOrder S; S.init(Mrows, DM, 3072, G, (int)blockIdx.x);
            pg8::EpiGateK E{(const f16*)(ws_ + WS_GLT), MH};
            pg8::gemm_phase<pg8::EpiGateK, pg8::SKOrder>(lds, g, S, E, pg8::SKCtx{slab, ctl_ + CW_SK + (l * 5 + 1) * SK_BANK}, wave0);
        } REPBAR(7, rep_); }
        SEAM(pb + 5);
        if (PH_ON(8) && IN(pb + 6)) _Pragma("unroll") for (int rep_ = 0; rep_ < NREP(8); ++rep_) { { WSP();
            pg8::Gemm g{MH, (const f16*)(a.ws + WS_WO + l * SZ_WO), Mrows, DM, DM}; pg8::SKOrder S; S.init(Mrows, DM, DM, G, (int)blockIdx.x, 0, 1);
            pg8::EpiResLN E{l == 0 ? (const void*)a.x : (const void*)LAT, l == 0 ? (const void*)a.ctx : (const void*)(LAT + (size_t)NLAT * DM), modl + 2 * DM, l == 0 ? 0 : 1,
                            a.ln1_g + l * DM, a.ln1_b + l * DM, modl + 3 * DM, modl + 4 * DM, LAT, H, a.out, 0,
                            (unsigned long long*)(slab + (size_t)4 * 1024 * 1024), ctl_ + CW_LN + (l * 2 + 0) * LN_BANK, lds + RING_BYTES + 1024};
            pg8::gemm_phase<pg8::EpiResLN, pg8::SKOrder>(lds, g, S, E, pg8::SKCtx{slab, ctl_ + CW_SK + (l * 5 + 2) * SK_BANK}, wave0);
        } REPBAR(8, rep_); }
        do { if (IN(pb + 6)) { bg_convert(a, lds, MISC, pb + 6, G, wave0); if (IN(pb + 7) || IN(pb + 8)) xcd_barrier(bar, wave0); } } while (0);
        if (PH_ON(10) && IN(pb + 8)) _Pragma("unroll") for (int rep_ = 0; rep_ < NREP(10); ++rep_) { { WSP();
            pg8::Gemm g{H, (const f16*)(a.ws + WS_WUP + l * SZ_WUP), Mrows, 2 * DFF, DM}; pg8::SKOrder S; S.init(Mrows, 2 * DFF, DM, G, (int)blockIdx.x);
            pg8::EpiConv E{a.conv_w + (size_t)l * 3 * DFF, a.conv_b + (size_t)l * DFF, ACT, slab, slab + (size_t)34 * 2 * DFF, slab + (size_t)2 * 34 * 2 * DFF, (LAS float*)(lds + RING_BYTES + 1024)};
            pg8::gemm_phase<pg8::EpiConv, pg8::SKOrder>(lds, g, S, E, pg8::SKCtx{slab, ctl_ + CW_SK + (l * 5 + 3) * SK_BANK}, wave0);
        } REPBAR(10, rep_); }
        SEAM(pb + 8);
        if (PH_ON(11) && IN(pb + 9)) _Pragma("unroll") for (int rep_ = 0; rep_ < NREP(11); ++rep_) { { TL(); ph_convfix(a, l, Mrows, tid); } REPBAR(11, rep_); }
        SEAM(pb + 9);
        if (PH_ON(12) && IN(pb + 10)) _Pragma("unroll") for (int rep_ = 0; rep_ < NREP(12); ++rep_) { { WSP();
            const float* modn = MOD + (size_t)(l + 1) * 3 * NMOD;
            int Gs_ = G; asm volatile("" : "+s"(Gs_));
            const bool sk8 = SK8_DN && l == 0 && Gs_ == 256;
            pg8::Gemm g{ACT, (const f16*)(a.ws + WS_WDN + l * SZ_WDN), Mrows, DM, DFF}; pg8::SKOrder S; S.init(sk8 ? NLAT : Mrows, DM, DFF, G, (int)blockIdx.x, 0, 1);
            pg8::EpiResLN E{(const void*)LAT, (const void*)(LAT + (size_t)NLAT * DM), modl + 5 * DM, 1,
                            a.ln2_g + l * DM, a.ln2_b + l * DM, last ? modl : modn, last ? modl : modn + DM, LAT, H, a.out, last ? 1 : 0,
                            (unsigned long long*)(slab + (size_t)4 * 1024 * 1024), ctl_ + CW_LN + (l * 2 + 1) * LN_BANK, lds + RING_BYTES + 1024};
            pg8::gemm_phase<pg8::EpiResLN, pg8::SKOrder>(lds, g, S, E, pg8::SKCtx{slab, ctl_ + CW_SK + (l * 5 + 4) * SK_BANK}, wave0);
            if (sk8) { pg8::SK8Order S8; S8.init(DFF, (int)blockIdx.x);
                pg8::gemm_phase<pg8::EpiResLN, pg8::SK8Order, true, true, true>(lds, g, S8, E, pg8::SKCtx{(float*)(ws_ + WS_MF), ctl_ + CW_SK + (l * 5 + 4) * SK_BANK}, wave0); }
        } REPBAR(12, rep_); }
        if (!last) do { if (IN(pb + 10)) { bg_convert(a, lds, MISC, pb + 10, G, wave0); if (IN(pb + 11) || IN(pb + 12)) xcd_barrier(bar, wave0); } } while (0);
    }
#undef IN
#undef SEAM
}

extern "C" void kernel_launch(void* const* d_in, const int* in_sizes, int n_in, void* d_out, int out_size, void* d_ws, size_t ws_size, hipStream_t stream) {
    static int grid = 0;
    if (grid == 0) {
        if (n_in != 23 || out_size != NLAT * DM || ws_size < WS_END) { fprintf(stderr, "kernel_launch: unexpected shapes (n_in %d out %d ws %zu, need %zu)\n", n_in, out_size, ws_size, (size_t)WS_END); grid = -1; return; }
        int dev = 0, cus = 0, per_cu = 0;
        if (hipGetDevice(&dev) != hipSuccess || hipDeviceGetAttribute(&cus, hipDeviceAttributeMultiprocessorCount, dev) != hipSuccess) { grid = -1; return; }
        if (hipFuncSetAttribute((const void*)mixer_fwd, hipFuncAttributeMaxDynamicSharedMemorySize, LDS_BYTES) != hipSuccess) { fprintf(stderr, "kernel_launch: hipFuncSetAttribute failed\n"); grid = -1; return; }
        if (hipOccupancyMaxActiveBlocksPerMultiprocessor(&per_cu, (const void*)mixer_fwd, 512, LDS_BYTES) != hipSuccess || per_cu < 1)
            fprintf(stderr, "kernel_launch: occupancy query reports %d workgroups per CU\n", per_cu);
        (void)hipGetLastError();
        grid = cus;
    }
    if (grid < 0) return;
    if (hipMemsetAsync((char*)d_ws + WS_CTL, 0, CTL_ZERO_BYTES, stream) != hipSuccess) return;
    Args a{};
    const float** ap = (const float**)&a;
    for (int i = 0; i < 23; ++i) ap[i] = (const float*)d_in[i];
    a.out = (float*)d_out; a.ws = (unsigned char*)d_ws; a.li = 0; a.pad = 0;
#if MK_PER_PHASE
    for (int p = 0; p < N_PHASES; ++p) { a.ph_lo = p; a.ph_hi = p + 1; hipLaunchKernelGGL(mixer_fwd, dim3(grid), dim3(512), LDS_BYTES, stream, a); }
#else
    a.ph_lo = 0; a.ph_hi = N_PHASES;
    hipLaunchKernelGGL(mixer_fwd, dim3(grid), dim3(512), LDS_BYTES, stream, a);
#endif
    const hipError_t le = hipPeekAtLastError();
    if (le != hipSuccess) fprintf(stderr, "kernel_launch: launch failed: %s\n", hipGetErrorName(le));
}
```

```cpp
#include <hip/hip_runtime.h>
#include <cstdio>
#include <cstdint>

#ifndef MK_PER_PHASE
#define MK_PER_PHASE 0
#endif
#ifndef XORDER
#define XORDER 1
#endif
#ifndef SK8_DN
#define SK8_DN 1
#endif
#ifndef SK8_WO
#define SK8_WO 0
#endif
#ifndef SK_ENABLE
#define SK_ENABLE 0
#endif

#define LAS __attribute__((address_space(3)))
#define GAS __attribute__((address_space(1)))
typedef _Float16 f16;
typedef _Float16 h8 __attribute__((ext_vector_type(8)));
typedef _Float16 h4 __attribute__((ext_vector_type(4)));
typedef _Float16 h2 __attribute__((ext_vector_type(2)));
typedef short s16x4 __attribute__((ext_vector_type(4)));
typedef float f32x2 __attribute__((ext_vector_type(2)));
typedef float f32x4 __attribute__((ext_vector_type(4)));
typedef float f32x16 __attribute__((ext_vector_type(16)));
typedef unsigned u32x2 __attribute__((ext_vector_type(2)));
typedef unsigned u32x4 __attribute__((ext_vector_type(4)));

constexpr int DM = 4096, NBATCH = 2, SEQ = 4096, CTXL = 256, NLAT = NBATCH * SEQ, NCTX = NBATCH * CTXL, MTOT = NLAT + NCTX;
constexpr int HD = 128, INW = 19456, DFF = 11008, NMOD = 6 * DM;
constexpr int QA_OFF = 0, KA_OFF = 1024, VA_OFF = 1280, QB_OFF = 1536, KB_OFF = 2560, VB_OFF = 2816, QR_OFF = 3072, KR_OFF = 4096, VR_OFF = 5120, GR_OFF = 6144, GL_OFF = 7168;
constexpr float LN_EPS = 1e-5f, RMS_EPS = 1e-6f, GN_EPS = 1e-5f;
constexpr float DN_ALPHA = 1.4142135623730951f;
constexpr float ATT_SCALE = 0.088388347648318440f;
constexpr int NCHUNK = 68;

constexpr size_t MiB = 1u << 20;
constexpr size_t WS_CTL = 0, CTL_ZERO_BYTES = 1 * MiB;
constexpr size_t WS_MOD = 1 * MiB;
constexpr size_t WS_ROPE = 2 * MiB;
constexpr size_t WS_WIN = 4 * MiB, SZ_WIN = 152 * MiB;
constexpr size_t WS_WBR = 308 * MiB, SZ_WBR = 24 * MiB;
constexpr size_t WS_WO = 356 * MiB, SZ_WO = 32 * MiB;
constexpr size_t WS_WUP = 420 * MiB, SZ_WUP = 172 * MiB;
constexpr size_t WS_WDN = 764 * MiB, SZ_WDN = 86 * MiB;
constexpr size_t WS_H = 936 * MiB;
constexpr size_t WS_P = 1004 * MiB;
constexpr size_t WS_Y = 1370 * MiB, SZ_Y1 = 17 * MiB;
constexpr size_t WS_MF = 1421 * MiB;
constexpr size_t WS_MH = 1557 * MiB;
constexpr size_t WS_Z = 1625 * MiB;
constexpr size_t WS_LAT = 1761 * MiB;
constexpr size_t WS_ACT = 1897 * MiB;
constexpr size_t WS_UT = 2080 * MiB;
constexpr size_t WS_ST = 2148 * MiB;
constexpr size_t WS_SLAB = 2182 * MiB;
constexpr size_t WS_GLT = 2246 * MiB;
constexpr size_t WS_END = 2450 * MiB;
static_assert(WS_WIN + 2 * SZ_WIN <= WS_WBR && WS_WBR + 2 * SZ_WBR <= WS_WO && WS_WO + 2 * SZ_WO <= WS_WUP && WS_WUP + 2 * SZ_WUP <= WS_WDN && WS_WDN + 2 * SZ_WDN <= WS_H, "ws map");
static_assert(WS_P + (size_t)MTOT * 22016 * 2 <= WS_Y && WS_ACT + (size_t)MTOT * DFF * 2 <= WS_UT, "ws map");
constexpr int CW_Q = 512, CW_QD = 1024;
constexpr int CW_BAR = 4096;
constexpr int CW_LN = 60000, LN_BANK = 64 * 34;
constexpr int CW_SK = 16384, SK_BANK = 4096;
static_assert((CW_SK + 10 * SK_BANK) * 4 <= (int)CTL_ZERO_BYTES && CW_SK + 10 * SK_BANK <= CW_LN && (CW_LN + 4 * LN_BANK) * 4 <= (int)CTL_ZERO_BYTES, "ctl");

constexpr int RING_BYTES = 131072, MISC_OFF = RING_BYTES + 320, LDS_BYTES = 147456;

__device__ __forceinline__ unsigned pkh(float lo, float hi) { h2 v = __builtin_convertvector((f32x2){lo, hi}, h2); return __builtin_bit_cast(unsigned, v); }
__device__ __forceinline__ float wave_sum(float v) {
#pragma unroll
    for (int o = 1; o < 64; o <<= 1) v += __shfl_xor(v, o);
    return v;
}
__device__ __forceinline__ float sigmoidf_(float x) { return __builtin_amdgcn_rcpf(1.0f + __expf(-x)); }
__device__ __forceinline__ int tid_of(int wave0) { return (wave0 << 6) | (int)__builtin_amdgcn_mbcnt_hi(~0u, __builtin_amdgcn_mbcnt_lo(~0u, 0u)); }
#define LDS_WAIT() asm volatile("s_waitcnt lgkmcnt(0)" ::: "memory")
#define VM_WAIT() asm volatile("s_waitcnt vmcnt(0)" ::: "memory")

struct Args {
    const float *x, *c, *ctx, *c_ctx, *w_mod, *b_mod, *w_in, *b_gate, *w_branch, *w_o, *attn_sink, *q_norm_g, *k_norm_g, *ret_decay, *ret_gn_g, *ln1_g, *ln1_b, *w_up, *conv_w, *conv_b, *w_down, *ln2_g, *ln2_b;
    float* out; unsigned char* ws; int ph_lo, ph_hi, li, pad;
};

namespace pg8 {
constexpr int BM = 256, BK = 64, HALF = 128, HTB = HALF * BK * 2, STAGE_BYTES = 8 * HTB, NXCD = 8, WGM = 4;
__host__ __device__ __forceinline__ int lds_byte(int r, int c) { const int st = (r >> 4) * 2 + (c >> 5), rr = r & 15, cc = c & 31, ob = rr * 64 + cc * 2; return st * 1024 + (ob ^ (((ob >> 9) & 1) << 5)); }
__host__ __device__ __forceinline__ void stage_rc(int b, int& R, int& C) { const int st = b / 1024, sb = b % 1024, swz = sb ^ (((sb >> 9) & 1) << 5); R = (st >> 1) * 16 + swz / 64; C = (st & 1) * 32 + (swz % 64) / 2; }
__host__ __device__ __forceinline__ int perm32(int rho) { const int n = rho >> 4, i = rho & 15; return 8 * (i >> 2) + 4 * n + (i & 3); }
struct Unit { int pm, pn, k0, nt, sl, ns, rid; };
struct Gemm { const f16* A; const f16* Bt; int M, N, K; };
struct SKCtx { float* slab; unsigned* cnt; };
struct SKOrder {
    int nM, nN, nwg, G, c, nfull, R, ns, npairs, nextra, lnord, sk8;
    __device__ __forceinline__ void init(int M, int N, int K, int G_, int c_, int nextra_ = 0, int lnord_ = 0, int sk8_ = 0) { lnord = lnord_; sk8 = sk8_; nM = M / BM; nN = N / BM; nwg = nM * nN; G = G_; asm volatile("" : "+s"(G)); c = c_; nextra = nextra_; nfull = (nwg / G) * G; R = nwg - nfull; npairs = K / 128;
        ns = 1; if (R > 0 && SK_ENABLE && nextra == 0) { ns = G / R; const int cap = npairs / 2; if (ns > cap) ns = cap; if (ns > 16) ns = 16; if (ns < 1) ns = 1; } }
    __device__ __forceinline__ bool next_x(int i, Unit& u) const {
        const int x = c & 7, w = c >> 3, nfullc = nN >> 3, remc = nN & 7;
        const int nrest = (nM - 32) * nN + nextra;
        const bool mainu = i < nfullc || (i == nfullc && (w >> 2) < remc);
        int r = 0;
        if (!mainu) { if (remc > 0) r = (i == nfullc) ? x * (4 * (8 - remc)) + (w - 4 * remc) : 32 * (8 - remc) + (i - nfullc - 1) * 256 + c; else r = (i - nfullc) * 256 + c; }
        const int t = (r >> 1) % 12;
        const int rpn = nextra > 0 ? (t < 2 ? 4 + t : (t < 4 ? 8 + t : 12 + t)) : (r >> 1);
        u.pm = mainu ? 4 * x + (w & 3) : 32 + (r & 1); u.pn = mainu ? 8 * i + (w >> 2) : rpn;
        if (lnord && mainu) { u.pm = 8 * (x >> 1) + 4 * i + (w & 3); u.pn = 8 * (x & 1) + (w >> 2); }
        u.k0 = 0; u.nt = 2 * npairs; u.sl = 0; u.ns = 1; u.rid = 0;
        return mainu || r < nrest;
    }
    __device__ __forceinline__ bool next(int i, Unit& u) const {
        if (XORDER && G == 256 && nM >= 32 && nM <= 34 && !SK_ENABLE) return next_x(i, u);
        const long L = (long)i * G + c;
        const bool ok = L < (long)(nwg + nextra);
        const bool ext = L >= nwg;
        int wgid = ok && !ext ? (int)L : 0;
        int sl = 0, nsl = 1, rid = 0, k0 = 0, ntl = 2 * npairs;
#if SK_ENABLE
        if (ok && !ext && L >= nfull && ns > 1) { const int j = (int)(L - nfull); const int r = j / ns; sl = j - r * ns; wgid = nfull + r; nsl = ns; rid = r;
            const int p0 = (int)((long)sl * npairs / ns), p1 = (int)((long)(sl + 1) * npairs / ns); k0 = p0 * 128; ntl = 2 * (p1 - p0); }
#endif
        { const int q = nwg / NXCD, r = nwg % NXCD, xcd = wgid % NXCD, off = wgid / NXCD; wgid = (xcd < r ? xcd * (q + 1) : r * (q + 1) + (xcd - r) * q) + off; }
        const int nig = WGM * nN, gid = wgid / nig, fm = gid * WGM, gsz = (nM - fm) < WGM ? (nM - fm) : WGM;
        int pm = fm + ((wgid % nig) % gsz), pn = (wgid % nig) / gsz;
        const int e = ext ? (int)(L - nwg) : 0, t = e % 12;
        if (ext) { pm = 32 + e / 12; pn = t < 2 ? 4 + t : (t < 4 ? 8 + t : 12 + t); }
        u.pm = pm; u.pn = pn; u.k0 = k0; u.nt = ntl; u.sl = sl; u.ns = nsl; u.rid = rid;
        return ok;
    }
};
struct SK8Order {
    int c, npairs;
    __device__ __forceinline__ void init(int K, int c_) { c = c_; npairs = K / 128; }
    __device__ __forceinline__ bool next(int i, Unit& u) const {
        const int rr = c >> 3, sl = c & 7, p0 = sl * npairs / 8, p1 = (sl + 1) * npairs / 8;
        u.pm = 32 + (rr & 1); u.pn = rr >> 1; u.k0 = p0 * 128; u.nt = 2 * (p1 - p0); u.sl = sl; u.ns = 8; u.rid = rr;
        return i == 0;
    }
};
struct EpiF16 {
    static constexpr bool PERM = true, HOOK = false, SK = false;
    f16* O; int ldc;
    __device__ __forceinline__ void pre(f32x4 (&)[2][2][4][2], const Unit&, int, int, int, int) const {}
    __device__ __forceinline__ void operator()(const f32x4 (&acc)[2][2][4][2], const Unit& u, int wr, int wc, int fr, int fq) const {
        const int row0 = u.pm * BM + wr * 64 + fr, col0 = u.pn * BM + wc * 32 + 8 * fq;
#pragma unroll
        for (int ai = 0; ai < 2; ++ai)
#pragma unroll
            for (int m = 0; m < 4; ++m) { f16* rowp = O + (size_t)(row0 + ai * HALF + m * 16) * ldc + col0;
#pragma unroll
                for (int bj = 0; bj < 2; ++bj) { const f32x4 v0 = acc[ai][bj][m][0], v1 = acc[ai][bj][m][1];
                    u32x4 w; w.x = pkh(v0[0], v0[1]); w.y = pkh(v0[2], v0[3]); w.z = pkh(v1[0], v1[1]); w.w = pkh(v1[2], v1[3]);
                    *(u32x4*)(rowp + bj * HALF) = w; } }
    }
};
struct EpiIn {
    static constexpr bool PERM = true, HOOK = false, SK = false;
    f16* O; const f32x2* rope; const float* qg; const float* kg; LAS float* red; f16* GLT; const float* bgate;
    __device__ __forceinline__ void pre(f32x4 (&)[2][2][4][2], const Unit&, int, int, int, int) const {}
    __device__ __forceinline__ void operator()(const f32x4 (&acc)[2][2][4][2], const Unit& u, int wr, int wc, int fr, int fq) const {
        const int pn = u.pn; const bool lat = u.pm < 32;
        if (pn >= 28) {
            const int gi = pn - 28, br = gi >> 4, pnn = gi & 15;
            int lo = fq * 16 + fr; asm volatile("" : "+v"(lo));
            f16* tp = GLT + ((size_t)((br * 34 + u.pm) * 16 + pnn) * 8 + (wr * 4 + wc)) * 8192 + lo * 8;
            const float* bp = bgate + gi * 256 + wc * 32 + 8 * (lo >> 4);
#pragma unroll
            for (int bj = 0; bj < 2; ++bj) { const f32x4 b0 = *(const f32x4*)(bp + bj * HALF), b1 = *(const f32x4*)(bp + bj * HALF + 4);
#pragma unroll
                for (int ai = 0; ai < 2; ++ai)
#pragma unroll
                    for (int m = 0; m < 4; ++m) { f32x4 v0 = acc[ai][bj][m][0] + b0, v1 = acc[ai][bj][m][1] + b1;
#pragma unroll
                        for (int j = 0; j < 4; ++j) { v0[j] = fminf(fmaxf(v0[j], -20.f), 20.f) * -1.4426950408889634f; v1[j] = fminf(fmaxf(v1[j], -20.f), 20.f) * -1.4426950408889634f; }
                        u32x4 w; w.x = pkh(v0[0], v0[1]); w.y = pkh(v0[2], v0[3]); w.z = pkh(v1[0], v1[1]); w.w = pkh(v1[2], v1[3]);
                        *(u32x4*)(tp + ((ai * 4 + m) * 2 + bj) * 512) = w; } }
            return;
        }
        int kind = 0;
        if (pn < 5) kind = 1; else if (pn >= 6 && pn < 10) kind = 2; else if (pn == 10) kind = 3; else if (pn >= 12 && pn < 16) kind = 1; else if (pn >= 16 && pn < 20) kind = 4;
        const int row0 = u.pm * BM + wr * 64 + fr, col0 = pn * BM + wc * 32 + 8 * fq;
        if (kind == 0 || (kind == 1 && !lat)) {
#pragma unroll
            for (int ai = 0; ai < 2; ++ai)
#pragma unroll
                for (int m = 0; m < 4; ++m) { f16* rowp = O + (size_t)(row0 + ai * HALF + m * 16) * INW + col0;
#pragma unroll
                    for (int bj = 0; bj < 2; ++bj) { const f32x4 v0 = acc[ai][bj][m][0], v1 = acc[ai][bj][m][1];
                        u32x4 w; w.x = pkh(v0[0], v0[1]); w.y = pkh(v0[2], v0[3]); w.z = pkh(v1[0], v1[1]); w.w = pkh(v1[2], v1[3]);
                        *(u32x4*)(rowp + bj * HALF) = w; } }
            return;
        }
        const bool rms = (kind == 2 || kind == 3);
        float rsv[2][2][4];
        if (rms) {
#pragma unroll
            for (int bj = 0; bj < 2; ++bj)
#pragma unroll
                for (int ai = 0; ai < 2; ++ai)
#pragma unroll
                    for (int m = 0; m < 4; ++m) { const f32x4 a0 = acc[ai][bj][m][0], a1 = acc[ai][bj][m][1];
                        float ss = (a0[0] * a0[0] + a0[1] * a0[1]) + (a0[2] * a0[2] + a0[3] * a0[3]) + (a1[0] * a1[0] + a1[1] * a1[1]) + (a1[2] * a1[2] + a1[3] * a1[3]);
                        ss += __shfl_xor(ss, 16); ss += __shfl_xor(ss, 32);
                        if (fq == 0) red[(bj * 256 + ai * HALF + wr * 64 + m * 16 + fr) * 4 + wc] = ss; }
            asm volatile("s_waitcnt lgkmcnt(0)" ::: "memory"); __builtin_amdgcn_s_barrier(); asm volatile("" ::: "memory");
#pragma unroll
            for (int bj = 0; bj < 2; ++bj)
#pragma unroll
                for (int ai = 0; ai < 2; ++ai)
#pragma unroll
                    for (int m = 0; m < 4; ++m) { const f32x4 t = *(const LAS f32x4*)(red + (bj * 256 + ai * HALF + wr * 64 + m * 16 + fr) * 4);
                        rsv[bj][ai][m] = 1.0f / sqrtf(((t[0] + t[1]) + (t[2] + t[3])) * (1.0f / HD) + RMS_EPS); }
        }
        const int dbase = 64 * (wc >> 1) + 16 * (wc & 1) + 4 * fq;
        f32x4 g0 = {1.f, 1.f, 1.f, 1.f}, g1 = g0;
        if (rms) { const float* g = (kind == 2 ? qg : kg) + dbase; g0 = *(const f32x4*)g; g1 = *(const f32x4*)(g + 32); }
        const float ksc = kind == 4 ? ATT_SCALE : 1.0f;
#pragma unroll
        for (int ai = 0; ai < 2; ++ai)
#pragma unroll
            for (int m = 0; m < 4; ++m) { const int row = row0 + ai * HALF + m * 16; const int t = row & (SEQ - 1); const int pos = (wc >> 1) ? (t & 63) : (t >> 6);
                f32x4 cv = {1.f, 1.f, 1.f, 1.f}, sv = {0.f, 0.f, 0.f, 0.f};
                if (lat) { const f32x4* cs = (const f32x4*)(rope + pos * 32 + 16 * (wc & 1) + 4 * fq); const f32x4 c01 = cs[0], c23 = cs[1]; cv = (f32x4){c01[0], c01[2], c23[0], c23[2]}; sv = (f32x4){c01[1], c01[3], c23[1], c23[3]}; }
                f16* rowp = O + (size_t)row * INW + col0;
#pragma unroll
                for (int bj = 0; bj < 2; ++bj) { f32x4 x1 = acc[ai][bj][m][0], x2 = acc[ai][bj][m][1];
                    if (rms) { x1 = x1 * rsv[bj][ai][m] * g0; x2 = x2 * rsv[bj][ai][m] * g1; }
                    const f32x4 o1 = (x1 * cv - x2 * sv) * ksc, o2 = (x2 * cv + x1 * sv) * ksc;
                    u32x4 w; w.x = pkh(o1[0], o1[1]); w.y = pkh(o1[2], o1[3]); w.z = pkh(o2[0], o2[1]); w.w = pkh(o2[2], o2[3]);
                    *(u32x4*)(rowp + bj * HALF) = w; } }
    }
};
struct EpiConv {
    static constexpr bool PERM = true, HOOK = false, SK = false;
    const float* cw; const float* cb; f16* ACT; float* GE; float* XP; float* UPE; LAS float* halo;
    __device__ __forceinline__ void pre(f32x4 (&)[2][2][4][2], const Unit&, int, int, int, int) const {}
    template <int CTRL> static __device__ __forceinline__ float dppf(float old, float src) {
        return __builtin_bit_cast(float, __builtin_amdgcn_update_dpp(__builtin_bit_cast(int, old), __builtin_bit_cast(int, src), CTRL, 0xf, 0xf, false)); }
    __device__ __forceinline__ void operator()(const f32x4 (&acc)[2][2][4][2], const Unit& u, int wr, int wc, int fr, int fq) const {
        const int f0 = u.pn * 128 + wc * 32 + 8 * fq;
        f32x4 w0[2], w1[2], w2[2], bb[2];
#pragma unroll
        for (int n = 0; n < 2; ++n) { w0[n] = *(const f32x4*)(cw + f0 + 4 * n); w1[n] = *(const f32x4*)(cw + DFF + f0 + 4 * n); w2[n] = *(const f32x4*)(cw + 2 * DFF + f0 + 4 * n); bb[n] = *(const f32x4*)(cb + f0 + 4 * n); }
        const int hcol = wc * 32 + 8 * fq;
#pragma unroll
        for (int ai = 0; ai < 2; ++ai) {
            if (fr == 0)  { *(LAS f32x4*)(halo + ((ai * 2 + wr) * 2 + 0) * 128 + hcol) = acc[ai][0][0][0]; *(LAS f32x4*)(halo + ((ai * 2 + wr) * 2 + 0) * 128 + hcol + 4) = acc[ai][0][0][1]; }
            if (fr == 15) { *(LAS f32x4*)(halo + ((ai * 2 + wr) * 2 + 1) * 128 + hcol) = acc[ai][0][3][0]; *(LAS f32x4*)(halo + ((ai * 2 + wr) * 2 + 1) * 128 + hcol + 4) = acc[ai][0][3][1]; }
        }
        if (wr == 0 && fr == 0)  { float* g = GE + (size_t)(u.pm * 2 + 0) * DFF + f0; *(f32x4*)g = acc[0][0][0][0]; *(f32x4*)(g + 4) = acc[0][0][0][1]; }
        if (wr == 1 && fr == 15) { float* g = GE + (size_t)(u.pm * 2 + 1) * DFF + f0; *(f32x4*)g = acc[1][0][3][0]; *(f32x4*)(g + 4) = acc[1][0][3][1]; }
        asm volatile("s_waitcnt lgkmcnt(0)" ::: "memory"); __builtin_amdgcn_s_barrier(); asm volatile("" ::: "memory");
#pragma unroll
        for (int ai = 0; ai < 2; ++ai) {
            f32x4 hp[2] = {{0.f, 0.f, 0.f, 0.f}, {0.f, 0.f, 0.f, 0.f}}, hn[2] = {{0.f, 0.f, 0.f, 0.f}, {0.f, 0.f, 0.f, 0.f}};
            if (wr == 1)      { hp[0] = *(const LAS f32x4*)(halo + ((ai * 2 + 0) * 2 + 1) * 128 + hcol); hp[1] = *(const LAS f32x4*)(halo + ((ai * 2 + 0) * 2 + 1) * 128 + hcol + 4); }
            else if (ai == 1) { hp[0] = *(const LAS f32x4*)(halo + ((0 * 2 + 1) * 2 + 1) * 128 + hcol);  hp[1] = *(const LAS f32x4*)(halo + ((0 * 2 + 1) * 2 + 1) * 128 + hcol + 4); }
            if (wr == 0)      { hn[0] = *(const LAS f32x4*)(halo + ((ai * 2 + 1) * 2 + 0) * 128 + hcol); hn[1] = *(const LAS f32x4*)(halo + ((ai * 2 + 1) * 2 + 0) * 128 + hcol + 4); }
            else if (ai == 0) { hn[0] = *(const LAS f32x4*)(halo + ((1 * 2 + 0) * 2 + 0) * 128 + hcol);  hn[1] = *(const LAS f32x4*)(halo + ((1 * 2 + 0) * 2 + 0) * 128 + hcol + 4); }
#pragma unroll
            for (int m = 0; m < 4; ++m) {
                float o[8], xs[8];
#pragma unroll
                for (int n = 0; n < 2; ++n)
#pragma unroll
                    for (int j = 0; j < 4; ++j) {
                        const float g = acc[ai][0][m][n][j];
                        const float oldp = m > 0 ? dppf<0x121>(0.f, acc[ai][0][m > 0 ? m - 1 : 0][n][j]) : hp[n][j];
                        const float pv = dppf<0x111>(oldp, g);
                        const float oldn = m < 3 ? dppf<0x12f>(0.f, acc[ai][0][m < 3 ? m + 1 : 3][n][j]) : hn[n][j];
                        const float nv = dppf<0x101>(oldn, g);
                        const float x = bb[n][j] + w0[n][j] * pv + w1[n][j] * g + w2[n][j] * nv;
                        xs[4 * n + j] = x; o[4 * n + j] = x * sigmoidf_(x) * acc[ai][1][m][n][j];
                    }
                const int row = u.pm * BM + ai * HALF + wr * 64 + m * 16 + fr;
                u32x4 w; w.x = pkh(o[0], o[1]); w.y = pkh(o[2], o[3]); w.z = pkh(o[4], o[5]); w.w = pkh(o[6], o[7]);
                *(u32x4*)(ACT + (size_t)row * DFF + f0) = w;
                if ((ai == 0 && m == 0 && wr == 0 && fr == 0) || (ai == 1 && m == 3 && wr == 1 && fr == 15)) {
                    const size_t eo = (size_t)(u.pm * 2 + ai) * DFF + f0;
                    *(f32x4*)(XP + eo) = (f32x4){xs[0], xs[1], xs[2], xs[3]}; *(f32x4*)(XP + eo + 4) = (f32x4){xs[4], xs[5], xs[6], xs[7]};
                    *(f32x4*)(UPE + eo) = acc[ai][1][m][0]; *(f32x4*)(UPE + eo + 4) = acc[ai][1][m][1];
                }
            }
        }
    }
};
struct EpiGateK {
    static constexpr bool PERM = true, HOOK = true, SK = false;
    const f16* GLT; f16* Mh;
    template <int MODE>
    __device__ __forceinline__ void scale(f32x4 (&acc)[2][2][4][2], const Unit& u, int sa, int sb, int wr, int wc, int fr, int fq) const {
        int lo = (fq * 16 + fr) * 8; asm volatile("" : "+v"(lo));
        const f16* ta = GLT + ((size_t)((sa * 34 + u.pm) * 16 + u.pn) * 8 + (wr * 4 + wc)) * 8192 + lo;
        const f16* tb = GLT + ((size_t)((sb * 34 + u.pm) * 16 + u.pn) * 8 + (wr * 4 + wc)) * 8192 + lo;
#pragma unroll
        for (int bj = 0; bj < 2; ++bj) {
#pragma unroll
            for (int ai = 0; ai < 2; ++ai) {
#pragma unroll
                for (int m = 0; m < 4; ++m) { const int q = ((ai * 4 + m) * 2 + bj) * 512;
                    const h8 ga = *(const h8*)(ta + q); h8 gb = ga; if (MODE == 0) gb = *(const h8*)(tb + q);
#pragma unroll
                    for (int j = 0; j < 8; ++j) {
                        float f = __builtin_amdgcn_rcpf(1.0f + __builtin_amdgcn_exp2f((float)ga[j]));
                        if (MODE == 0) f *= (1.0f + __builtin_amdgcn_exp2f((float)gb[j]));
                        acc[ai][bj][m][j >> 2][j & 3] *= f; } }
                asm volatile("" : "+v"(acc[ai][bj][0][0]), "+v"(acc[ai][bj][0][1]), "+v"(acc[ai][bj][1][0]), "+v"(acc[ai][bj][1][1]), "+v"(acc[ai][bj][2][0]), "+v"(acc[ai][bj][2][1]), "+v"(acc[ai][bj][3][0]), "+v"(acc[ai][bj][3][1]) :: "memory"); } }
    }
    __device__ __forceinline__ void hook(f32x4 (&acc)[2][2][4][2], const Unit& u, int gt, int wr, int wc, int fr, int fq) const { const int seg = gt >> 4; scale<0>(acc, u, seg - 1, seg, wr, wc, fr, fq); }
    __device__ __forceinline__ void pre(f32x4 (&acc)[2][2][4][2], const Unit& u, int wr, int wc, int fr, int fq) const { const int seg = SK_ENABLE ? (((u.k0 >> 6) + u.nt - 1) >> 4) : 2; scale<1>(acc, u, seg, seg, wr, wc, fr, fq); }
    __device__ __forceinline__ void operator()(const f32x4 (&acc)[2][2][4][2], const Unit& u, int wr, int wc, int fr, int fq) const {
        const int row0 = u.pm * BM + wr * 64 + fr, col0 = u.pn * BM + wc * 32 + 8 * fq;
#pragma unroll
        for (int ai = 0; ai < 2; ++ai)
#pragma unroll
            for (int m = 0; m < 4; ++m) { f16* rowp = Mh + (size_t)(row0 + ai * HALF + m * 16) * DM + col0;
#pragma unroll
                for (int bj = 0; bj < 2; ++bj) { const f32x4 v0 = acc[ai][bj][m][0], v1 = acc[ai][bj][m][1];
                    u32x4 w; w.x = pkh(v0[0], v0[1]); w.y = pkh(v0[2], v0[3]); w.z = pkh(v1[0], v1[1]); w.w = pkh(v1[2], v1[3]);
                    *(u32x4*)(rowp + bj * HALF) = w; } }
    }
};
struct EpiRes {
    static constexpr bool PERM = true, HOOK = false, SK = false;
    __device__ __forceinline__ void pre(f32x4 (&)[2][2][4][2], const Unit&, int, int, int, int) const {}
    const void* latA; const void* latB; const float* gv; f16* Z; int lat16;
    __device__ __forceinline__ void operator()(const f32x4 (&acc)[2][2][4][2], const Unit& u, int wr, int wc, int fr, int fq) const {
        const int row0 = u.pm * BM + wr * 64 + fr, col0 = u.pn * BM + wc * 32 + 8 * fq;
        const int mr = u.pm < 16 ? 0 : (u.pm < 32 ? 1 : 2);
        const size_t rbase = u.pm < 32 ? 0 : (size_t)NLAT * DM;
        const void* lat = u.pm < 32 ? latA : latB;
        const float* g = gv + (size_t)mr * NMOD;
#pragma unroll
        for (int bj = 0; bj < 2; ++bj) { const int col = col0 + bj * HALF;
            const f32x4 g0 = *(const f32x4*)(g + col), g1 = *(const f32x4*)(g + col + 4);
#pragma unroll
            for (int ai = 0; ai < 2; ++ai)
#pragma unroll
                for (int m = 0; m < 4; ++m) { const size_t off = (size_t)(row0 + ai * HALF + m * 16) * DM + col;
                    f32x4 l0, l1;
                    if (lat16) { const h8 t = *(const h8*)((const f16*)lat + (off - rbase)); l0 = (f32x4){(float)t[0], (float)t[1], (float)t[2], (float)t[3]}; l1 = (f32x4){(float)t[4], (float)t[5], (float)t[6], (float)t[7]}; }
                    else { l0 = *(const f32x4*)((const float*)lat + (off - rbase)); l1 = *(const f32x4*)((const float*)lat + (off - rbase) + 4); }
                    const f32x4 z0 = l0 * DN_ALPHA + g0 * acc[ai][bj][m][0], z1 = l1 * DN_ALPHA + g1 * acc[ai][bj][m][1];
                    u32x4 w; w.x = pkh(z0[0], z0[1]); w.y = pkh(z0[2], z0[3]); w.z = pkh(z1[0], z1[1]); w.w = pkh(z1[2], z1[3]); *(u32x4*)(Z + off) = w; } }
    }
};

struct EpiResLN {
    static constexpr bool PERM = true, HOOK = false, SK = true;
    const void* latA; const void* latB; const float* gv; int lat16;
    const float* lng; const float* lnb; const float* msh; const float* msc;
    f16* LAT; f16* H; float* out; int writeOut;
    unsigned long long* xslot; unsigned* cnt; LAS unsigned char* lx;
    __device__ __forceinline__ void pre(f32x4 (&acc)[2][2][4][2], const Unit& u, int wr, int wc, int fr, int fq) const {
        int row0 = u.pm * BM + wr * 64 + fr, col0 = u.pn * BM + wc * 32 + 8 * fq;
        asm volatile("" : "+v"(row0), "+v"(col0));
        const int mr = u.pm < 16 ? 0 : (u.pm < 32 ? 1 : 2);
        const size_t rbase = u.pm < 32 ? 0 : (size_t)NLAT * DM;
        const void* lat = u.pm < 32 ? latA : latB;
        const float* g = gv + (size_t)mr * NMOD;
#pragma unroll
        for (int bj = 0; bj < 2; ++bj) { const int col = col0 + bj * HALF;
            const f32x4 g0 = *(const f32x4*)(g + col), g1 = *(const f32x4*)(g + col + 4);
#pragma unroll
            for (int ai = 0; ai < 2; ++ai) {
#pragma unroll
                for (int m = 0; m < 4; ++m) { const size_t off = (size_t)(row0 + ai * HALF + m * 16) * DM + col - rbase;
                    f32x4 l0, l1;
                    if (lat16) { const h8 t = *(const h8*)((const f16*)lat + off); l0 = (f32x4){(float)t[0], (float)t[1], (float)t[2], (float)t[3]}; l1 = (f32x4){(float)t[4], (float)t[5], (float)t[6], (float)t[7]}; }
                    else { l0 = *(const f32x4*)((const float*)lat + off); l1 = *(const f32x4*)((const float*)lat + off + 4); }
                    acc[ai][bj][m][0] = l0 * DN_ALPHA + g0 * acc[ai][bj][m][0]; acc[ai][bj][m][1] = l1 * DN_ALPHA + g1 * acc[ai][bj][m][1]; }
                asm volatile("" : "+v"(acc[ai][bj][0][0]), "+v"(acc[ai][bj][0][1]), "+v"(acc[ai][bj][1][0]), "+v"(acc[ai][bj][1][1]), "+v"(acc[ai][bj][2][0]), "+v"(acc[ai][bj][2][1]), "+v"(acc[ai][bj][3][0]), "+v"(acc[ai][bj][3][1]) :: "memory"); } }
    }
    __device__ __forceinline__ void operator()(const f32x4 (&acc)[2][2][4][2], const Unit& u, int wr, int wc, int fr, int fq) const {
        LAS f32x2* P = (LAS f32x2*)lx; LAS f32x2* S = (LAS f32x2*)(lx + 8192); volatile LAS unsigned* flag = (volatile LAS unsigned*)(lx + 10240);
        const int wid = wr * 4 + wc, lane = fq * 16 + fr;
#pragma unroll
        for (int ai = 0; ai < 2; ++ai)
#pragma unroll
            for (int m = 0; m < 4; ++m) {
                float sm = 0.f;
#pragma unroll
                for (int bj = 0; bj < 2; ++bj)
#pragma unroll
                    for (int n = 0; n < 2; ++n) { const f32x4 xv = acc[ai][bj][m][n]; sm += (xv[0] + xv[1]) + (xv[2] + xv[3]); }
                sm += __shfl_xor(sm, 16); sm += __shfl_xor(sm, 32);
                const float mw = sm * (1.0f / 64.0f); float q = 0.f;
#pragma unroll
                for (int bj = 0; bj < 2; ++bj)
#pragma unroll
                    for (int n = 0; n < 2; ++n) { const f32x4 d = acc[ai][bj][m][n] - mw; q += (d[0] * d[0] + d[1] * d[1]) + (d[2] * d[2] + d[3] * d[3]); }
                q += __shfl_xor(q, 16); q += __shfl_xor(q, 32);
                if (fq == 0) P[(ai * HALF + wr * 64 + m * 16 + fr) * 4 + wc] = (f32x2){mw, q};
            }
        asm volatile("s_waitcnt lgkmcnt(0)" ::: "memory"); __builtin_amdgcn_s_barrier(); asm volatile("" ::: "memory");
        const int row = wid * 32 + (lane & 31);
        if (lane < 32) {
            const f32x2 pa = P[row * 4 + 0], pb = P[row * 4 + 1], pc = P[row * 4 + 2], pd = P[row * 4 + 3];
            const float mt = ((pa.x + pb.x) + (pc.x + pd.x)) * 0.25f;
            const float da = pa.x - mt, db = pb.x - mt, dc = pc.x - mt, dd = pd.x - mt;
            const float m2 = ((pa.y + pb.y) + (pc.y + pd.y)) + 64.0f * ((da * da + db * db) + (dc * dc + dd * dd));
            __hip_atomic_store(xslot + ((size_t)(u.pm * BM + row) * 16 + u.pn), ((unsigned long long)__float_as_uint(m2) << 32) | __float_as_uint(mt), __ATOMIC_RELAXED, __HIP_MEMORY_SCOPE_AGENT);
        }
        asm volatile("s_waitcnt vmcnt(0)" ::: "memory");
        if (lane == 0) __hip_atomic_fetch_add(cnt + 64 * u.pm, 1u, __ATOMIC_RELAXED, __HIP_MEMORY_SCOPE_AGENT);
        if (wid == 0) {
            unsigned sp = 0;
            while ((unsigned)__builtin_amdgcn_readfirstlane((int)__hip_atomic_load(cnt + 64 * u.pm, __ATOMIC_RELAXED, __HIP_MEMORY_SCOPE_AGENT)) < 128u) { __builtin_amdgcn_s_sleep(1); if (++sp > (1u << 22)) break; }
            __builtin_amdgcn_fence(__ATOMIC_ACQUIRE, "agent");
            if (lane == 0) flag[0] = 1u;
        }
        asm volatile("s_waitcnt vmcnt(0) lgkmcnt(0)" ::: "memory"); __builtin_amdgcn_s_barrier(); asm volatile("" ::: "memory");
        if (lane < 32) {
            const unsigned long long* sl = xslot + (size_t)(u.pm * BM + row) * 16; float mt[16], m2[16]; float ms = 0.f;
#pragma unroll
            for (int t = 0; t < 16; ++t) { const unsigned long long wv = __hip_atomic_load(sl + t, __ATOMIC_RELAXED, __HIP_MEMORY_SCOPE_AGENT); mt[t] = __uint_as_float((unsigned)wv); m2[t] = __uint_as_float((unsigned)(wv >> 32)); ms += mt[t]; }
            const float mean = ms * (1.0f / 16.0f); float q = 0.f;
#pragma unroll
            for (int t = 0; t < 16; ++t) { const float dm = mt[t] - mean; q += m2[t] + 256.0f * dm * dm; }
            S[row] = (f32x2){mean, 1.0f / sqrtf(q * (1.0f / DM) + LN_EPS)};
        }
        asm volatile("s_waitcnt lgkmcnt(0)" ::: "memory"); __builtin_amdgcn_s_barrier(); asm volatile("" ::: "memory");
        const int row0 = u.pm * BM + wr * 64 + fr, col0 = u.pn * BM + wc * 32 + 8 * fq;
        const int mr = u.pm < 16 ? 0 : (u.pm < 32 ? 1 : 2);
#pragma unroll
        for (int bj = 0; bj < 2; ++bj) { const int col = col0 + bj * HALF;
            const f32x4 g0 = *(const f32x4*)(lng + col), g1 = *(const f32x4*)(lng + col + 4), b0 = *(const f32x4*)(lnb + col), b1 = *(const f32x4*)(lnb + col + 4);
            f32x4 c0 = {0.f, 0.f, 0.f, 0.f}, c1 = c0, h0 = c0, h1 = c0;
            if (!writeOut) { const float* sc = msc + (size_t)mr * NMOD + col; const float* sh = msh + (size_t)mr * NMOD + col; c0 = *(const f32x4*)sc + 1.0f; c1 = *(const f32x4*)(sc + 4) + 1.0f; h0 = *(const f32x4*)sh; h1 = *(const f32x4*)(sh + 4); }
#pragma unroll
            for (int ai = 0; ai < 2; ++ai)
#pragma unroll
                for (int m = 0; m < 4; ++m) { const int rl = ai * HALF + wr * 64 + m * 16 + fr; const f32x2 st = S[rl]; const size_t off = (size_t)(row0 + ai * HALF + m * 16) * DM + col;
                    const f32x4 y0 = (acc[ai][bj][m][0] - st.x) * st.y * g0 + b0, y1 = (acc[ai][bj][m][1] - st.x) * st.y * g1 + b1;
                    if (writeOut) { if (u.pm < 32) { *(f32x4*)(out + off) = y0; *(f32x4*)(out + off + 4) = y1; } }
                    else { u32x4 w; w.x = pkh(y0[0], y0[1]); w.y = pkh(y0[2], y0[3]); w.z = pkh(y1[0], y1[1]); w.w = pkh(y1[2], y1[3]); *(u32x4*)(LAT + off) = w;
                        const f32x4 v0 = y0 * c0 + h0, v1 = y1 * c1 + h1; u32x4 w2; w2.x = pkh(v0[0], v0[1]); w2.y = pkh(v0[2], v0[3]); w2.z = pkh(v1[0], v1[1]); w2.w = pkh(v1[2], v1[3]); *(u32x4*)(H + off) = w2; } } }
    }
};

template <class Epi, class Sched, bool ALIGN_EPI = true, bool SP2 = true, bool SKW = false>
__device__ __forceinline__ void gemm_phase(LAS unsigned char* lds, const Gemm g, const Sched& S, const Epi& E, const SKCtx SK, const int wave0) {
    int tid = tid_of(wave0); asm volatile("" : "+v"(tid));
    const int wid = __builtin_amdgcn_readfirstlane(tid >> 6), lane = tid & 63, wr = wid >> 2, wc = wid & 3, fr = lane & 15, fq = lane >> 4;
    const int K = g.K;
    unsigned voffA[2], voffB[2];
#pragma unroll
    for (int i = 0; i < 2; ++i) { int R, C; stage_rc(tid * 16 + i * 8192, R, C); const int Rb = Epi::PERM ? ((R & ~31) + perm32(R & 31)) : R;
        voffA[i] = (unsigned)(R * K + C) * 2u; voffB[i] = (unsigned)(Rb * K + C) * 2u; }
    const size_t kstep = (size_t)(BK * 2);
    const size_t hstep = (size_t)HALF * K * 2;
    const size_t tstep = 2 * hstep;
    const unsigned ldsw = (unsigned)wid * 1024u;
    const int aoff = lds_byte(wr * 64 + fr, fq * 8), boff = lds_byte(wc * 32 + fr, fq * 8);
#define PG8_SA(b, h) (((b) * 2 + (h)) * HTB)
#define PG8_SB(b, h) ((4 + (b) * 2 + (h)) * HTB)
#define PG8_STAGE(bufoff, gbase, voff) do { _Pragma("unroll") for (int _i = 0; _i < 2; ++_i) \
        __builtin_amdgcn_global_load_lds((const unsigned*)((const char*)(gbase) + (voff)[_i]), (LAS unsigned*)(lds + (bufoff) + ldsw + _i * 8192), 16, 0, 0); } while (0)
#define PG8_LDA(dst, b, h) do { _Pragma("unroll") for (int m = 0; m < 4; ++m) _Pragma("unroll") for (int k = 0; k < 2; ++k) dst[m][k] = *(const LAS h8*)(lds + PG8_SA(b, h) + aoff + m * 2048 + k * 1024); } while (0)
#define PG8_LDB(dst, b, h) do { _Pragma("unroll") for (int n = 0; n < 2; ++n) _Pragma("unroll") for (int k = 0; k < 2; ++k) dst[n][k] = *(const LAS h8*)(lds + PG8_SB(b, h) + boff + n * 2048 + k * 1024); } while (0)
#define PG8_MMA(ai, bj, At, Bt) do { __builtin_amdgcn_s_setprio(1); _Pragma("unroll") for (int m = 0; m < 4; ++m) _Pragma("unroll") for (int n = 0; n < 2; ++n) _Pragma("unroll") for (int k = 0; k < 2; ++k) \
        acc[ai][bj][m][n] = __builtin_amdgcn_mfma_f32_16x16x32_f16(Bt[n][k], At[m][k], acc[ai][bj][m][n], 0, 0, 0); __builtin_amdgcn_s_setprio(0); } while (0)
#define PG8_WAIT_V(n) asm volatile("s_waitcnt vmcnt(" #n ")" ::: "memory")
#define PG8_WAIT_L(n) asm volatile("s_waitcnt lgkmcnt(" #n ")" ::: "memory")
#define PG8_BAR __builtin_amdgcn_s_barrier()
#define PG8_SCHED __builtin_amdgcn_sched_barrier(0)
    Unit cur, nxt; int ui = 0;
    if (!S.next(0, cur)) return;
    f32x4 acc[2][2][4][2];
#pragma unroll
    for (int a = 0; a < 2; ++a)
#pragma unroll
        for (int b = 0; b < 2; ++b)
#pragma unroll
            for (int m = 0; m < 4; ++m)
#pragma unroll
                for (int n = 0; n < 2; ++n) acc[a][b][m][n] = (f32x4){0.f, 0.f, 0.f, 0.f};
    h8 At[4][2], B0[2][2], B1[2][2];
    constexpr bool SKP = SK_ENABLE || SKW;
    const char* cA = (const char*)g.A + (size_t)cur.pm * tstep + (SKP ? (size_t)cur.k0 * 2 : 0); const char* cB = (const char*)g.Bt + (size_t)cur.pn * tstep + (SKP ? (size_t)cur.k0 * 2 : 0);
    if constexpr (SP2) {
        PG8_STAGE(PG8_SB(0, 0), cB, voffB); PG8_STAGE(PG8_SB(0, 1), cB + hstep, voffB); PG8_STAGE(PG8_SA(0, 0), cA, voffA); PG8_STAGE(PG8_SA(0, 1), cA + hstep, voffA);
        if (wr == 1) PG8_BAR;
        PG8_WAIT_V(2); PG8_BAR;
        PG8_STAGE(PG8_SB(1, 0), cB + kstep, voffB); PG8_STAGE(PG8_SA(1, 0), cA + kstep, voffA); PG8_STAGE(PG8_SB(1, 1), cB + hstep + kstep, voffB);
        PG8_WAIT_V(6); PG8_BAR;
    } else {
        PG8_STAGE(PG8_SB(0, 0), cB, voffB); PG8_STAGE(PG8_SA(0, 0), cA, voffA); PG8_STAGE(PG8_SB(0, 1), cB + hstep, voffB); PG8_STAGE(PG8_SA(0, 1), cA + hstep, voffA);
        if (wr == 1) PG8_BAR;
        PG8_WAIT_V(4); PG8_BAR;
        PG8_STAGE(PG8_SB(1, 0), cB + kstep, voffB); PG8_STAGE(PG8_SA(1, 0), cA + kstep, voffA); PG8_STAGE(PG8_SB(1, 1), cB + hstep + kstep, voffB);
        PG8_WAIT_V(6); PG8_BAR;
    }
    for (;;) {
        const bool has_next = S.next(ui + 1, nxt);
        const char* nA = has_next ? (const char*)g.A + (size_t)nxt.pm * tstep + (SKP ? (size_t)nxt.k0 * 2 : 0) : cA; const char* nB = has_next ? (const char*)g.Bt + (size_t)nxt.pn * tstep + (SKP ? (size_t)nxt.k0 * 2 : 0) : cB;
        const int nt = SKP ? cur.nt : K / BK, kt0 = SKP ? (cur.k0 >> 6) : 0;
        for (int t = 0; t < nt; t += 2) {
            const bool last = (t == nt - 2);
            if constexpr (Epi::HOOK) { const int gt = kt0 + t; if (t > 0 && (gt == 16 || gt == 32)) E.hook(acc, cur, gt, wr, wc, fr, fq); }
            const char* a1 = cA + (size_t)(t + 1) * kstep;
            const char* a2 = last ? nA : cA + (size_t)(t + 2) * kstep; const char* b2 = last ? nB : cB + (size_t)(t + 2) * kstep;
            const char* a3 = a2 + kstep; const char* b3 = b2 + kstep;
            if constexpr (SP2) {
            PG8_LDB(B0, 0, 0); PG8_LDB(B1, 0, 1); PG8_SCHED; PG8_LDA(At, 0, 0); PG8_STAGE(PG8_SA(1, 1), a1 + hstep, voffA);
            PG8_WAIT_V(8); PG8_WAIT_L(0); PG8_BAR; PG8_MMA(0, 0, At, B0); PG8_MMA(0, 1, At, B1); PG8_BAR; PG8_SCHED;
            PG8_LDA(At, 0, 1); PG8_STAGE(PG8_SB(0, 0), b2, voffB); PG8_STAGE(PG8_SB(0, 1), b2 + hstep, voffB); PG8_STAGE(PG8_SA(0, 0), a2, voffA);
            PG8_WAIT_V(8); PG8_WAIT_L(0); PG8_BAR; PG8_MMA(1, 0, At, B0); PG8_MMA(1, 1, At, B1); PG8_BAR; PG8_SCHED;
            PG8_LDB(B0, 1, 0); PG8_LDB(B1, 1, 1); PG8_SCHED; PG8_LDA(At, 1, 0); PG8_STAGE(PG8_SA(0, 1), a2 + hstep, voffA);
            PG8_WAIT_V(8); PG8_WAIT_L(0); PG8_BAR; PG8_MMA(0, 0, At, B0); PG8_MMA(0, 1, At, B1); PG8_BAR; PG8_SCHED;
            PG8_LDA(At, 1, 1); PG8_STAGE(PG8_SB(1, 0), b3, voffB); PG8_STAGE(PG8_SB(1, 1), b3 + hstep, voffB); PG8_STAGE(PG8_SA(1, 0), a3, voffA);
            PG8_WAIT_V(8); PG8_WAIT_L(0); PG8_BAR; PG8_MMA(1, 0, At, B0); PG8_MMA(1, 1, At, B1); PG8_BAR; PG8_SCHED;
            } else {
            PG8_LDB(B0, 0, 0); PG8_SCHED; PG8_LDA(At, 0, 0); PG8_STAGE(PG8_SA(1, 1), a1 + hstep, voffA);
            PG8_WAIT_L(8); PG8_BAR; PG8_WAIT_L(0); PG8_MMA(0, 0, At, B0); PG8_BAR; PG8_SCHED;
            PG8_LDB(B1, 0, 1); PG8_STAGE(PG8_SB(0, 0), b2, voffB);
            PG8_BAR; PG8_WAIT_L(0); PG8_MMA(0, 1, At, B1); PG8_BAR;
            PG8_LDA(At, 0, 1); PG8_STAGE(PG8_SA(0, 0), a2, voffA);
            PG8_BAR; PG8_WAIT_L(0); PG8_MMA(1, 0, At, B0); PG8_BAR; PG8_SCHED;
            PG8_STAGE(PG8_SB(0, 1), b2 + hstep, voffB);
            PG8_WAIT_V(6); PG8_BAR; PG8_MMA(1, 1, At, B1); PG8_BAR;
            PG8_LDB(B0, 1, 0); PG8_SCHED; PG8_LDA(At, 1, 0); PG8_STAGE(PG8_SA(0, 1), a2 + hstep, voffA);
            PG8_WAIT_L(8); PG8_BAR; PG8_WAIT_L(0); PG8_MMA(0, 0, At, B0); PG8_BAR; PG8_SCHED;
            PG8_LDB(B1, 1, 1); PG8_STAGE(PG8_SB(1, 0), b3, voffB);
            PG8_BAR; PG8_WAIT_L(0); PG8_MMA(0, 1, At, B1); PG8_BAR;
            PG8_LDA(At, 1, 1); PG8_STAGE(PG8_SA(1, 0), a3, voffA);
            PG8_BAR; PG8_WAIT_L(0); PG8_MMA(1, 0, At, B0); PG8_BAR; PG8_SCHED;
            PG8_STAGE(PG8_SB(1, 1), b3 + hstep, voffB);
            PG8_WAIT_V(6); PG8_BAR; PG8_MMA(1, 1, At, B1); PG8_BAR;
            }
        }
        if constexpr (ALIGN_EPI) { if (wr == 0) PG8_BAR; }
        if constexpr (SKW) {
            f32x4* af = &acc[0][0][0][0];
            const float* s0 = SK.slab + ((size_t)(cur.rid * cur.ns) * 8 + wid) * 8192;
            int voff = lane * 16; asm volatile("" : "+v"(voff));
            { uintptr_t sb = (uintptr_t)(s0 + (size_t)cur.sl * 8 * 8192); const unsigned lo = __builtin_amdgcn_readfirstlane((unsigned)sb), hi = __builtin_amdgcn_readfirstlane((unsigned)(sb >> 32));
              const __amdgpu_buffer_rsrc_t rs = __builtin_amdgcn_make_buffer_rsrc((void*)(((uintptr_t)hi << 32) | lo), 0, 32768, 0x00020000);
#pragma unroll
              for (int q = 0; q < 32; ++q) __builtin_amdgcn_raw_buffer_store_b128(__builtin_bit_cast(u32x4, af[q]), rs, voff, q * 1024, 16); }
            asm volatile("s_waitcnt vmcnt(0)" ::: "memory"); PG8_BAR;
            volatile LAS unsigned* mk = (volatile LAS unsigned*)(lds + MISC_OFF);
            if (wid == 0) { unsigned old = 0; if (voff == 0) old = __hip_atomic_fetch_add(SK.cnt + cur.rid * 16, 1u, __ATOMIC_RELAXED, __HIP_MEMORY_SCOPE_AGENT);
                old = __builtin_amdgcn_readfirstlane(old); if (voff == 0) mk[30] = old; }
            asm volatile("s_waitcnt vmcnt(0) lgkmcnt(0)" ::: "memory"); PG8_BAR;
            if ((unsigned)__builtin_amdgcn_readfirstlane((int)mk[30]) == (unsigned)(cur.ns - 1)) {
                __builtin_amdgcn_fence(__ATOMIC_ACQUIRE, "agent"); asm volatile("s_waitcnt vmcnt(0)" ::: "memory");
#pragma unroll
                for (int q = 0; q < 32; ++q) af[q] = (f32x4){0.f, 0.f, 0.f, 0.f};
                for (int sl = 0; sl < cur.ns; ++sl) {
                    uintptr_t sb = (uintptr_t)(s0 + (size_t)sl * 8 * 8192); const unsigned lo = __builtin_amdgcn_readfirstlane((unsigned)sb), hi = __builtin_amdgcn_readfirstlane((unsigned)(sb >> 32));
                    const __amdgpu_buffer_rsrc_t rs = __builtin_amdgcn_make_buffer_rsrc((void*)(((uintptr_t)hi << 32) | lo), 0, 32768, 0x00020000);
#pragma unroll
                    for (int qg = 0; qg < 4; ++qg) {
#pragma unroll
                        for (int q = 8 * qg; q < 8 * qg + 8; ++q) af[q] += __builtin_bit_cast(f32x4, __builtin_amdgcn_raw_buffer_load_b128(rs, voff, q * 1024, 0));
                        asm volatile("" : "+v"(af[8 * qg]), "+v"(af[8 * qg + 1]), "+v"(af[8 * qg + 2]), "+v"(af[8 * qg + 3]), "+v"(af[8 * qg + 4]), "+v"(af[8 * qg + 5]), "+v"(af[8 * qg + 6]), "+v"(af[8 * qg + 7]) :: "memory"); } }
                E.pre(acc, cur, wr, wc, fr, fq); E(acc, cur, wr, wc, fr, fq);
            }
        } else if (!SK_ENABLE || cur.ns == 1) { E.pre(acc, cur, wr, wc, fr, fq); E(acc, cur, wr, wc, fr, fq); }
        else {
            E.pre(acc, cur, wr, wc, fr, fq);
            f32x4* af = &acc[0][0][0][0];
            const float* s0 = SK.slab + ((size_t)(cur.rid * cur.ns) * 8 + wid) * 8192;
            int voff = lane * 16; asm volatile("" : "+v"(voff));
            { uintptr_t sb = (uintptr_t)(s0 + (size_t)cur.sl * 8 * 8192); const unsigned lo = __builtin_amdgcn_readfirstlane((unsigned)sb), hi = __builtin_amdgcn_readfirstlane((unsigned)(sb >> 32));
              const __amdgpu_buffer_rsrc_t rs = __builtin_amdgcn_make_buffer_rsrc((void*)(((uintptr_t)hi << 32) | lo), 0, 32768, 0x00020000);
#pragma unroll
              for (int q = 0; q < 32; ++q) __builtin_amdgcn_raw_buffer_store_b128(__builtin_bit_cast(u32x4, af[q]), rs, voff, q * 1024, 16); }
            asm volatile("s_waitcnt vmcnt(0)" ::: "memory");
            unsigned old = 0; if (lane == 0) old = __hip_atomic_fetch_add(SK.cnt + cur.rid * 16 + wid, 1u, __ATOMIC_RELAXED, __HIP_MEMORY_SCOPE_AGENT);
            old = __builtin_amdgcn_readfirstlane(old);
            if (old == (unsigned)(cur.ns - 1)) {
                __builtin_amdgcn_fence(__ATOMIC_ACQUIRE, "agent"); asm volatile("s_waitcnt vmcnt(0)" ::: "memory");
#pragma unroll
                for (int q = 0; q < 32; ++q) af[q] = (f32x4){0.f, 0.f, 0.f, 0.f};
                for (int sl = 0; sl < cur.ns; ++sl) {
                    uintptr_t sb = (uintptr_t)(s0 + (size_t)sl * 8 * 8192); const unsigned lo = __builtin_amdgcn_readfirstlane((unsigned)sb), hi = __builtin_amdgcn_readfirstlane((unsigned)(sb >> 32));
                    const __amdgpu_buffer_rsrc_t rs = __builtin_amdgcn_make_buffer_rsrc((void*)(((uintptr_t)hi << 32) | lo), 0, 32768, 0x00020000);
#pragma unroll
                    for (int qg = 0; qg < 4; ++qg) {
#pragma unroll
                        for (int q = 8 * qg; q < 8 * qg + 8; ++q) af[q] += __builtin_bit_cast(f32x4, __builtin_amdgcn_raw_buffer_load_b128(rs, voff, q * 1024, 0));
                        asm volatile("" : "+v"(af[8 * qg]), "+v"(af[8 * qg + 1]), "+v"(af[8 * qg + 2]), "+v"(af[8 * qg + 3]), "+v"(af[8 * qg + 4]), "+v"(af[8 * qg + 5]), "+v"(af[8 * qg + 6]), "+v"(af[8 * qg + 7]) :: "memory"); } }
                E(acc, cur, wr, wc, fr, fq);
            }
        }
        if (!has_next) break;
#pragma unroll
        for (int a = 0; a < 2; ++a)
#pragma unroll
            for (int b = 0; b < 2; ++b)
#pragma unroll
                for (int m = 0; m < 4; ++m)
#pragma unroll
                    for (int n = 0; n < 2; ++n) acc[a][b][m][n] = (f32x4){0.f, 0.f, 0.f, 0.f};
        cur = nxt; cA = nA; cB = nB; ++ui;
        if constexpr (ALIGN_EPI) { if (wr == 1) PG8_BAR; }
    }
    PG8_WAIT_V(0);
    if constexpr (!ALIGN_EPI) { if (wr == 0) PG8_BAR; }
    PG8_BAR;
#undef PG8_SA
#undef PG8_SB
#undef PG8_STAGE
#undef PG8_LDA
#undef PG8_LDB
#undef PG8_MMA
#undef PG8_WAIT_V
#undef PG8_WAIT_L
#undef PG8_BAR
#undef PG8_SCHED
}
}

#define XB_TMO      128
#define XB_XCNT(j)  (256  + 64 * (j))
#define XB_XSUB(j)  (1280 + 64 * (j))
#define XB_XGEN(j)  (2304 + 64 * (j))
#define XB_TOP      3328
#define XB_TOPGEN   3392
#define XCD_BAR_WORDS 3456
#define XB_SPIN_CAP (1u << 22)
__device__ __forceinline__ unsigned xb_ld(unsigned* p)              { return __hip_atomic_load(p, __ATOMIC_RELAXED, __HIP_MEMORY_SCOPE_AGENT); }
__device__ __forceinline__ unsigned xb_add(unsigned* p, unsigned v) { return __hip_atomic_fetch_add(p, v, __ATOMIC_RELAXED, __HIP_MEMORY_SCOPE_AGENT); }
__device__ __forceinline__ unsigned xb_xcc_id() { return (unsigned)__builtin_amdgcn_s_getreg((3 << 11) | 20) & 0xFu; }
#define XB_SPIN(cond, bar) do { unsigned _sp = 0; while (cond) { __builtin_amdgcn_s_sleep(1); \
    if ((++_sp & 255u) == 0u) { if (xb_ld(&(bar)[XB_TMO])) break; if (_sp > XB_SPIN_CAP) { atomicAdd(&(bar)[XB_TMO], 1u); break; } } } } while (0)
struct XcdBarrier { unsigned* bar; unsigned x; volatile LAS unsigned* st; };
__device__ __forceinline__ XcdBarrier xcd_barrier_post(unsigned* bar, volatile LAS unsigned* st, int tid0) {
    XcdBarrier b; b.bar = bar; b.x = xb_xcc_id(); b.st = st;
    if (tid0 == 0) (void)xb_add(&bar[XB_XCNT(b.x)], 1u);
    return b;
}
__device__ __forceinline__ void xcd_barrier_complete(unsigned* bar, unsigned x, unsigned& nloc, unsigned& nx) {
    const unsigned G = gridDim.x * gridDim.y * gridDim.z;
    unsigned sum, cnt, mine, sp = 0u;
    for (;;) {
        sum = 0u; cnt = 0u; mine = 0u;
#pragma unroll
        for (unsigned j = 0; j < 16; ++j) { const unsigned c = xb_ld(&bar[XB_XCNT(j)]); sum += c; cnt += (c > 0u) ? 1u : 0u; mine = (j == x) ? c : mine; }
        if (sum == G) break;
        __builtin_amdgcn_s_sleep(1);
        if ((++sp & 255u) == 0u) { if (xb_ld(&bar[XB_TMO])) break; if (sp > XB_SPIN_CAP) { atomicAdd(&bar[XB_TMO], 1u); break; } }
    }
    nloc = mine > 0u ? mine : 1u; nx = cnt > 0u ? cnt : 1u;
}
__device__ __forceinline__ void xcd_barrier(const XcdBarrier& b, const int wave0) {
    asm volatile("s_waitcnt vmcnt(0)" ::: "memory");
    __syncthreads();
    int t0_ = tid_of(wave0); asm volatile("" : "+v"(t0_));
    if (t0_ == 0) {
        unsigned* bar = b.bar;
        __builtin_amdgcn_s_waitcnt(0);
        unsigned nloc = b.st[0], nx = b.st[1];
        if (nloc == 0u) { unsigned xl = b.x; asm volatile("" : "+s"(xl)); xcd_barrier_complete(bar, xl, nloc, nx); b.st[0] = nloc; b.st[1] = nx; }
        const unsigned old = xb_add(&bar[XB_XSUB(b.x)], 1u);
        const unsigned gen = old / nloc;
        if (old + 1u == (gen + 1u) * nloc) {
            __builtin_amdgcn_fence(__ATOMIC_RELEASE, "agent");
            asm volatile("s_waitcnt vmcnt(0)" ::: "memory");
            const unsigned og = xb_add(&bar[XB_TOP], 1u);
            const unsigned tg = og / nx;
            if (og + 1u == (tg + 1u) * nx) xb_add(&bar[XB_TOPGEN], 1u);
            else XB_SPIN(xb_ld(&bar[XB_TOPGEN]) == tg, bar);
            __builtin_amdgcn_fence(__ATOMIC_ACQUIRE, "agent");
            xb_add(&bar[XB_XGEN(b.x)], 1u);
            asm volatile("s_waitcnt vmcnt(0)" ::: "memory");
        } else {
            XB_SPIN(xb_ld(&bar[XB_XGEN(b.x)]) == gen, bar);
            __builtin_amdgcn_fence(__ATOMIC_ACQUIRE, "agent");
            asm volatile("s_waitcnt vmcnt(0)" ::: "memory");
        }
    }
    __syncthreads();
}

__device__ __forceinline__ void rope_table(f32x2* tab, int tid) {
    for (int e = tid; e < 64 * 32; e += 512) {
        const int pos = e >> 5, i = e & 31;
        double invf = 1.0; for (int j = 0; j < i; ++j) invf *= 0.74989420933245582730;
        const float ang = (float)pos * (float)invf;
        const double xd = (double)ang;
        const double kq = __builtin_rint(xd * 0.63661977236758134308);
        const double r = (xd - kq * 1.5707963267948966192) - kq * 6.123233995736766e-17;
        const double r2 = r * r;
        double sn = r * (1.0 + r2 * (-1.0 / 6 + r2 * (1.0 / 120 + r2 * (-1.0 / 5040 + r2 * (1.0 / 362880 + r2 * (-1.0 / 39916800 + r2 * (1.0 / 6227020800.0 + r2 * (-1.0 / 1307674368000.0))))))));
        double cs = 1.0 + r2 * (-0.5 + r2 * (1.0 / 24 + r2 * (-1.0 / 720 + r2 * (1.0 / 40320 + r2 * (-1.0 / 3628800 + r2 * (1.0 / 479001600 + r2 * (-1.0 / 87178291200.0)))))));
        const int q = ((int)kq) & 3;
        double c2, s2;
        if (q == 0) { c2 = cs; s2 = sn; } else if (q == 1) { c2 = -sn; s2 = cs; } else if (q == 2) { c2 = -cs; s2 = -sn; } else { c2 = sn; s2 = -cs; }
        tab[e] = (f32x2){(float)c2, (float)s2};
    }
}
__device__ __forceinline__ void ph_modgemv(const Args& a, LAS unsigned char* lds, int tid, int lane, int wave, int first, int last_item, int stride) {
    LAS float* sv = (LAS float*)lds;
    LAS float* red = (LAS float*)(lds + 49152);
    float* MOD = (float*)(a.ws + WS_MOD);
    for (int i = tid; i < 3 * DM; i += 512) { const int r = i >> 12, k = i & 4095; const float c = r < 2 ? a.c[r * DM + k] : a.c_ctx[k]; sv[i] = c * sigmoidf_(c); }
    __syncthreads();
    for (int item = first; item < last_item; item += stride) {
        const int l = item >> 7, cb = item & 127;
        f32x4 acc0 = {0.f, 0.f, 0.f, 0.f}, acc1 = acc0, acc2 = acc0;
        if (lane < 48) {
            const float* wp = a.w_mod + (size_t)l * DM * NMOD + (size_t)(wave * 512) * NMOD + cb * 192 + lane * 4;
            const LAS float* s0 = sv + wave * 512;
            for (int k = 0; k < 512; k += 16) {
                f32x4 v[16];
#pragma unroll
                for (int j = 0; j < 16; ++j) v[j] = *(const f32x4*)(wp + (size_t)(k + j) * NMOD);
#pragma unroll
                for (int j = 0; j < 16; ++j) { acc0 += v[j] * s0[k + j]; acc1 += v[j] * s0[DM + k + j]; acc2 += v[j] * s0[2 * DM + k + j]; }
            }
            *(LAS f32x4*)(red + (wave * 3 + 0) * 192 + lane * 4) = acc0; *(LAS f32x4*)(red + (wave * 3 + 1) * 192 + lane * 4) = acc1; *(LAS f32x4*)(red + (wave * 3 + 2) * 192 + lane * 4) = acc2;
        }
        __syncthreads();
        for (int i = tid; i < 3 * 192; i += 512) { const int r = i / 192, n = i % 192; float s = 0.f;
#pragma unroll
            for (int w = 0; w < 8; ++w) s += red[(w * 3 + r) * 192 + n];
            MOD[(size_t)(l * 3 + r) * NMOD + cb * 192 + n] = s + a.b_mod[l * NMOD + cb * 192 + n]; }
        __syncthreads();
    }
}
__device__ __forceinline__ void cvt_item(const float* W, int K, int N, f16* WT, int ldk, LAS unsigned char* tile, int idx, int lane, bool pair_up = false, bool qk_perm = false) {
    const int nblk = N >> 6, kb = idx / nblk, nb = idx - kb * nblk, k0 = kb * 64, n0 = nb * 64;
    const int d0 = !pair_up ? n0 : (n0 < DFF ? (n0 >> 7) * 256 + (n0 & 127) : ((n0 - DFF) >> 7) * 256 + 128 + ((n0 - DFF) & 127));
    const int g = lane >> 4, q = lane & 15;
    const float* src = W + (size_t)(k0 + 2 * g) * N + n0 + 4 * q;
    f32x4 va[8], vb[8];
#pragma unroll
    for (int i = 0; i < 8; ++i) { va[i] = *(const f32x4*)(src + (size_t)(8 * i) * N); vb[i] = *(const f32x4*)(src + (size_t)(8 * i + 1) * N); }
    LAS unsigned* T32 = (LAS unsigned*)tile;
#pragma unroll
    for (int i = 0; i < 8; ++i)
#pragma unroll
        for (int j = 0; j < 4; ++j) T32[(4 * q + j) * 36 + 4 * i + g] = pkh(va[i][j], vb[i][j]);
    LDS_WAIT();
    const int c = lane & 7;
#pragma unroll
    for (int jj = 0; jj < 8; ++jj) { const int n = (lane >> 3) + 8 * jj; const u32x4 o = *(const LAS u32x4*)(tile + n * 144 + 16 * c);
        int dr = d0 + n;
        if (qk_perm) { const int cc = n0 + n; if (cc < 1280 || (cc >= 1536 && cc < 2816) || (cc >= 3072 && cc < 5120)) { const int d = cc & 127;
                dr = (cc & ~127) + 32 * (2 * (d >> 6) + ((d >> 4) & 1)) + 8 * ((d >> 2) & 3) + 4 * ((d >> 5) & 1) + (d & 3); } }
        *(u32x4*)(WT + (size_t)dr * ldk + k0 + 8 * c) = o; }
    LDS_WAIT();
}
constexpr int I_IN = 64 * 304, I_BR = 16 * 64, I_O = 64 * 64, I_UP = 64 * 344, I_DN = 172 * 64;
constexpr int QT_BR0 = 3 * I_BR, QT_O0 = QT_BR0 + I_O, QT_UP0 = QT_O0 + I_UP, QT_DN0 = QT_UP0 + I_DN, QT_IN1 = QT_DN0 + I_IN,
              QT_BR1 = QT_IN1 + 3 * I_BR, QT_O1 = QT_BR1 + I_O, QT_UP1 = QT_O1 + I_UP, QT_DN1 = QT_UP1 + I_DN, QTOT = QT_DN1;
__device__ __forceinline__ void ph_convert0(const Args& a, LAS unsigned char* lds, int lane, int wave, int wg, int nwgs) {
    LAS unsigned char* tile = lds + wave * 9216;
    for (int it = wg * 8 + wave; it < I_IN; it += nwgs * 8) cvt_item(a.w_in, DM, INW, (f16*)(a.ws + WS_WIN), DM, tile, it, lane, false, true);
}
__device__ __forceinline__ void cvt_queue_item(const Args& a, int q, LAS unsigned char* tile, int lane) {
    int l = 0, r = q;
    if (q >= QT_DN0) { r = q - QT_DN0; if (r < I_IN) { cvt_item(a.w_in + (size_t)DM * INW, DM, INW, (f16*)(a.ws + WS_WIN + SZ_WIN), DM, tile, r, lane, false, true); return; } r -= I_IN; l = 1; }
    if (r < 3 * I_BR) { const int br = r / I_BR; r -= br * I_BR; cvt_item(a.w_branch + (size_t)(l * 3 + br) * 1024 * DM, 1024, DM, (f16*)(a.ws + WS_WBR + l * SZ_WBR) + br * 1024, 3072, tile, r, lane); return; } r -= 3 * I_BR;
    if (r < I_O) { cvt_item(a.w_o + (size_t)l * DM * DM, DM, DM, (f16*)(a.ws + WS_WO + l * SZ_WO), DM, tile, r, lane); return; } r -= I_O;
    if (r < I_UP) { cvt_item(a.w_up + (size_t)l * DM * 2 * DFF, DM, 2 * DFF, (f16*)(a.ws + WS_WUP + l * SZ_WUP), DM, tile, r, lane, true); return; } r -= I_UP;
    cvt_item(a.w_down + (size_t)l * DFF * DM, DFF, DM, (f16*)(a.ws + WS_WDN + l * SZ_WDN), DFF, tile, r, lane);
}
__device__ __forceinline__ int q_need(int p) {
    return p < 6 ? 0 : p < 7 ? QT_BR0 : p < 8 ? QT_O0 : p < 11 ? QT_UP0 : p < 12 ? QT_DN0 : p < 18 ? QT_IN1 : p < 19 ? QT_BR1 : p < 20 ? QT_O1 : p < 23 ? QT_UP1 : QT_DN1;
}
__device__ __forceinline__ bool q_gemm_phase(int p) { const int j = (p - 2) % 12; return p >= 2 && (j == 0 || j == 5 || j == 6 || j == 8 || j == 10); }
__device__ __forceinline__ void bg_convert(const Args& a, LAS unsigned char* lds, volatile LAS unsigned* MISC, int p, int G, const int wave0) {
    unsigned* ctl = (unsigned*)(a.ws + WS_CTL);
    int tid = tid_of(wave0); asm volatile("" : "+v"(tid));
    const int lane = tid & 63, wave = __builtin_amdgcn_readfirstlane(tid >> 6);
    const bool opp = q_gemm_phase(p); const int need = q_need(p);
    if (opp && tid == 0) __hip_atomic_fetch_add(ctl + CW_QD + 64 * p, 1u, __ATOMIC_RELAXED, __HIP_MEMORY_SCOPE_AGENT);
    if (p == 10 && G >= 256 && (int)blockIdx.x >= 128) ph_modgemv(a, lds, tid, lane, wave, 128 + (int)blockIdx.x - 128, 256, 128);
    const int skip = G > 64 ? 32 : 0;
    if ((int)blockIdx.x < skip) return;
    const int NW = (G - skip) * 8, w = ((int)blockIdx.x - skip) * 8 + wave;
    LAS unsigned char* tile = lds + wave * 9216;
    int k = (int)MISC[16 + wave];
    for (;;) {
        const int q = w + k * NW;
        if (q >= QTOT) { if (wave == 0 && lane == 0) MISC[31] = (unsigned)(p + 1); break; }
        if (q >= need) {
            if (!opp) break;
            if (wave == 0) { if ((unsigned)__builtin_amdgcn_readfirstlane((int)__hip_atomic_load(ctl + CW_QD + 64 * p, __ATOMIC_RELAXED, __HIP_MEMORY_SCOPE_AGENT)) >= (unsigned)G) { if (lane == 0) MISC[31] = (unsigned)(p + 1); break; } }
            else if (MISC[31] == (unsigned)(p + 1)) break;
        }
        cvt_queue_item(a, q, tile, lane);
        ++k;
    }
    if (lane == 0) MISC[16 + wave] = (unsigned)k;
}
__device__ __forceinline__ void ph_modulate0(const Args& a, int lane, int wave) {
    const float* MOD = (const float*)(a.ws + WS_MOD);
    f16* H = (f16*)(a.ws + WS_H);
    for (int row = blockIdx.x * 8 + wave; row < MTOT; row += gridDim.x * 8) {
        const int mr = row < SEQ ? 0 : (row < NLAT ? 1 : 2);
        const f32x4* src = (const f32x4*)(row < NLAT ? a.x + (size_t)row * DM : a.ctx + (size_t)(row - NLAT) * DM) + lane;
        const f32x4* sh = (const f32x4*)(MOD + (size_t)mr * NMOD) + lane; const f32x4* sc = (const f32x4*)(MOD + (size_t)mr * NMOD + DM) + lane;
        u32x2* o = (u32x2*)(H + (size_t)row * DM) + lane;
#pragma unroll 4
        for (int j = 0; j < 16; ++j) { const f32x4 v = src[64 * j], s = sc[64 * j], t = sh[64 * j]; const f32x4 y = v * (s + 1.0f) + t;
            o[64 * j] = (u32x2){pkh(y[0], y[1]), pkh(y[2], y[3])}; }
    }
}

__device__ __forceinline__ void ph_post(const Args& a, int l, int lane, int wave) {
    f16* P = (f16*)(a.ws + WS_P);
    const f32x2* rope = (const f32x2*)(a.ws + WS_ROPE);
    const float* qg = a.q_norm_g + l * HD; const float* kg = a.k_norm_g + l * HD;
    const int gsub = lane >> 3, s = lane & 7;
    const int e0 = (s & 3) * 8 + (s >> 2) * 64;
    const int nitems = MTOT * 36;
    for (int it = (blockIdx.x * 8 + wave) * 8 + gsub; it < nitems; it += gridDim.x * 64) {
        const int row = it / 36, hv = it - row * 36;
        int col, kind;
        if (hv < 8) { col = QA_OFF + hv * HD; kind = 0; } else if (hv < 10) { col = KA_OFF + (hv - 8) * HD; kind = 0; }
        else if (hv < 18) { col = QB_OFF + (hv - 10) * HD; kind = 1; } else if (hv < 20) { col = KB_OFF + (hv - 18) * HD; kind = 2; }
        else if (hv < 28) { col = QR_OFF + (hv - 20) * HD; kind = 0; } else { col = KR_OFF + (hv - 28) * HD; kind = 3; }
        const bool lat = row < NLAT;
        if (!lat && kind == 0) continue;
        f16* p = P + (size_t)row * INW + col + e0;
        const h8 x1 = *(const h8*)p, x2 = *(const h8*)(p + 32);
        float f1[8], f2[8];
#pragma unroll
        for (int j = 0; j < 8; ++j) { f1[j] = (float)x1[j]; f2[j] = (float)x2[j]; }
        if (kind == 1 || kind == 2) {
            float ss = 0.f;
#pragma unroll
            for (int j = 0; j < 8; ++j) ss += f1[j] * f1[j] + f2[j] * f2[j];
            ss += __shfl_xor(ss, 1); ss += __shfl_xor(ss, 2); ss += __shfl_xor(ss, 4);
            const float rs = 1.0f / sqrtf(ss * (1.0f / HD) + RMS_EPS);
            const float* g = (kind == 1 ? qg : kg) + e0;
#pragma unroll
            for (int j = 0; j < 8; ++j) { f1[j] = f1[j] * rs * g[j]; f2[j] = f2[j] * rs * g[32 + j]; }
        }
        if (lat) {
            const int t = row & (SEQ - 1); const int pos = (s < 4) ? (t >> 6) : (t & 63);
            const f32x2* cs = rope + pos * 32 + (s & 3) * 8;
#pragma unroll
            for (int j = 0; j < 8; ++j) { const f32x2 w = cs[j]; const float o1 = f1[j] * w.x - f2[j] * w.y, o2 = f2[j] * w.x + f1[j] * w.y; f1[j] = o1; f2[j] = o2; }
        }
        if (kind == 3) {
#pragma unroll
            for (int j = 0; j < 8; ++j) { f1[j] *= ATT_SCALE; f2[j] *= ATT_SCALE; }
        }
        u32x4 w1, w2; w1.x = pkh(f1[0], f1[1]); w1.y = pkh(f1[2], f1[3]); w1.z = pkh(f1[4], f1[5]); w1.w = pkh(f1[6], f1[7]);
        w2.x = pkh(f2[0], f2[1]); w2.y = pkh(f2[2], f2[3]); w2.z = pkh(f2[4], f2[5]); w2.w = pkh(f2[6], f2[7]);
        *(u32x4*)p = w1; *(u32x4*)(p + 32) = w2;
    }
}
__device__ __forceinline__ void ph_ln(const Args& a, const float* g, const float* b, const float* msh, const float* msc, bool writeH, bool writeOut, int Mrows, int lane, int wave) {
    const f16* Z = (const f16*)(a.ws + WS_Z); f16* LAT = (f16*)(a.ws + WS_LAT); f16* H = (f16*)(a.ws + WS_H);
    for (int row = blockIdx.x * 8 + wave; row < Mrows; row += gridDim.x * 8) {
        const h8* zr = (const h8*)(Z + (size_t)row * DM) + lane;
        f32x4 v[8][2]; float s = 0.f;
#pragma unroll
        for (int j = 0; j < 8; ++j) { const h8 t = zr[64 * j]; v[j][0] = (f32x4){(float)t[0], (float)t[1], (float)t[2], (float)t[3]}; v[j][1] = (f32x4){(float)t[4], (float)t[5], (float)t[6], (float)t[7]};
            s += ((v[j][0][0] + v[j][0][1]) + (v[j][0][2] + v[j][0][3])) + ((v[j][1][0] + v[j][1][1]) + (v[j][1][2] + v[j][1][3])); }
        const float mean = wave_sum(s) * (1.0f / DM); float s2 = 0.f;
#pragma unroll
        for (int j = 0; j < 8; ++j)
#pragma unroll
            for (int hh = 0; hh < 2; ++hh) { v[j][hh] = v[j][hh] - mean; s2 += (v[j][hh][0] * v[j][hh][0] + v[j][hh][1] * v[j][hh][1]) + (v[j][hh][2] * v[j][hh][2] + v[j][hh][3] * v[j][hh][3]); }
        const float rstd = 1.0f / sqrtf(wave_sum(s2) * (1.0f / DM) + LN_EPS);
        const int mr = row < SEQ ? 0 : (row < NLAT ? 1 : 2);
        u32x4* lo = (u32x4*)(LAT + (size_t)row * DM) + lane;
        u32x4* ho = (u32x4*)(H + (size_t)row * DM) + lane;
        float* oo = a.out + (size_t)row * DM + lane * 8;
        const float* gg = g + lane * 8; const float* bb = b + lane * 8;
        const float* sh = msh + (size_t)mr * NMOD + lane * 8; const float* sc = msc + (size_t)mr * NMOD + lane * 8;
#pragma unroll
        for (int j = 0; j < 8; ++j) {
            const f32x4 y0 = v[j][0] * rstd * *(const f32x4*)(gg + 512 * j) + *(const f32x4*)(bb + 512 * j), y1 = v[j][1] * rstd * *(const f32x4*)(gg + 512 * j + 4) + *(const f32x4*)(bb + 512 * j + 4);
            if (writeOut) { if (row < NLAT) { *(f32x4*)(oo + 512 * j) = y0; *(f32x4*)(oo + 512 * j + 4) = y1; } }
            else lo[64 * j] = (u32x4){pkh(y0[0], y0[1]), pkh(y0[2], y0[3]), pkh(y1[0], y1[1]), pkh(y1[2], y1[3])};
            if (writeH) { const f32x4 h0 = y0 * (*(const f32x4*)(sc + 512 * j) + 1.0f) + *(const f32x4*)(sh + 512 * j), h1 = y1 * (*(const f32x4*)(sc + 512 * j + 4) + 1.0f) + *(const f32x4*)(sh + 512 * j + 4);
                ho[64 * j] = (u32x4){pkh(h0[0], h0[1]), pkh(h0[2], h0[3]), pkh(h1[0], h1[1]), pkh(h1[2], h1[3])}; } }
    }
}
__device__ __forceinline__ void ph_convfix(const Args& a, int l, int Mrows, int tid) {
    const float* GE = (const float*)(a.ws + WS_SLAB); const float* XP = GE + (size_t)34 * 2 * DFF; const float* UPE = XP + (size_t)34 * 2 * DFF;
    f16* ACT = (f16*)(a.ws + WS_ACT);
    const float* cw = a.conv_w + (size_t)l * 3 * DFF;
    constexpr int NF4 = DFF / 4;
    const int nitems = (Mrows / 256) * 2 * NF4;
    for (int it = blockIdx.x * 512 + tid; it < nitems; it += gridDim.x * 512) {
        const int pe = it / NF4, f = (it - pe * NF4) * 4, pm = pe >> 1, e = pe & 1;
        f32x4 x = *(const f32x4*)(XP + (size_t)pe * DFF + f); const f32x4 up = *(const f32x4*)(UPE + (size_t)pe * DFF + f);
        const bool has = e == 0 ? !(pm >= 32 || (pm & 15) == 0) : !(pm >= 32 || (pm & 15) == 15);
        if (has) { const f32x4 ge = *(const f32x4*)(GE + (size_t)((e ? pm + 1 : pm - 1) * 2 + (e ? 0 : 1)) * DFF + f); const f32x4 w = *(const f32x4*)(cw + (e ? 2 : 0) * DFF + f); x += w * ge; }
        float o[4];
#pragma unroll
        for (int j = 0; j < 4; ++j) o[j] = x[j] * sigmoidf_(x[j]) * up[j];
        *(u32x2*)(ACT + (size_t)(pm * 256 + 255 * e) * DFF + f) = (u32x2){pkh(o[0], o[1]), pkh(o[2], o[3])};
    }
}

namespace att {
constexpr int D = 128, NW = 8, QBLK = 32, KVBLK = 64;
constexpr float SCALE = ATT_SCALE;
constexpr float THR = 8.f;
constexpr int LDQ = INW, LDK = INW, LDO = 3072;
constexpr size_t SHM_V = KVBLK * D * 2, SHM_K = KVBLK * D * 2, SHM_ATTN = 2 * SHM_V + 2 * SHM_K + NW * 64 * 4;
#define KSWZ(row, colB) ((row) * 256 + ((colB) ^ (((row) & 7) << 4)))
#define SBAR() __builtin_amdgcn_sched_barrier(0)
__device__ __forceinline__ int crow(int r, int hi) { return (r & 3) + 8 * (r >> 2) + 4 * hi; }
struct Unit { const f16* Q; const f16* Kc; const f16* Vc; const f16* Kl; const f16* Vl; f16* O; int NT; int qpos0; int kpos0; float sink; int has_sink; };
template <bool MASK>
__device__ __forceinline__ void partialSM(f32x16& p0, f32x16& p1, float& m_reg, float& mn, float& alpha, int dq, bool domask) {
    constexpr float C = SCALE * 1.4426950408889634f;
    if (MASK) { if (domask) {
#pragma unroll
        for (int r = 0; r < 16; ++r) { const int k0 = (r & 3) + 8 * (r >> 2); const int d0 = dq - k0, d1 = dq - 32 - k0;
            p0[r] = (d0 > 128 || d0 < -128) ? -1e30f : p0[r]; p1[r] = (d1 > 128 || d1 < -128) ? -1e30f : p1[r]; } } }
    float pmax = p0[0];
#pragma unroll
    for (int r = 1; r < 16; ++r) pmax = fmaxf(pmax, p0[r]);
#pragma unroll
    for (int r = 0; r < 16; ++r) pmax = fmaxf(pmax, p1[r]);
    { auto rr = __builtin_amdgcn_permlane32_swap(__float_as_uint(pmax), __float_as_uint(pmax), false, false);
      pmax = fmaxf(__uint_as_float(rr[0]), __uint_as_float(rr[1])); }
    if (__builtin_expect(__all(pmax - m_reg <= THR / SCALE), 1)) { mn = m_reg; alpha = 1.f; }
    else { mn = fmaxf(m_reg, pmax); alpha = __builtin_amdgcn_exp2f((m_reg - mn) * C); m_reg = mn; }
    const float mnC = -mn * C;
#pragma unroll
    for (int r = 0; r < 16; ++r) p0[r] = fmaf(p0[r], C, mnC);
#pragma unroll
    for (int r = 0; r < 16; ++r) p1[r] = fmaf(p1[r], C, mnC);
#pragma unroll
    for (int r = 0; r < 16; ++r) p0[r] = __builtin_amdgcn_exp2f(p0[r]);
}
__device__ __forceinline__ void finishSM(f32x16& p0, f32x16& p1, float alpha, float& l_reg, h8& pa0, h8& pa1, h8& pa2, h8& pa3) {
#pragma unroll
    for (int r = 0; r < 16; ++r) p1[r] = __builtin_amdgcn_exp2f(p1[r]);
    float ps = 0;
#pragma unroll
    for (int r = 0; r < 16; ++r) ps += p0[r];
#pragma unroll
    for (int r = 0; r < 16; ++r) ps += p1[r];
    { auto rr = __builtin_amdgcn_permlane32_swap(__float_as_uint(ps), __float_as_uint(ps), false, false);
      ps = __uint_as_float(rr[0]) + __uint_as_float(rr[1]); }
    l_reg = l_reg * alpha + ps;
#define PK4(P, BASE, OUT) do { unsigned a0 = pkh(P[BASE + 0], P[BASE + 1]), a1 = pkh(P[BASE + 2], P[BASE + 3]);   \
    unsigned b0 = pkh(P[BASE + 4], P[BASE + 5]), b1 = pkh(P[BASE + 6], P[BASE + 7]);                              \
    auto r0 = __builtin_amdgcn_permlane32_swap(a0, b0, false, false); auto r1 = __builtin_amdgcn_permlane32_swap(a1, b1, false, false); \
    u32x4 w = {r0[0], r1[0], r0[1], r1[1]}; OUT = __builtin_bit_cast(h8, w); } while (0)
    PK4(p0, 0, pa0); PK4(p0, 8, pa1); PK4(p1, 0, pa2); PK4(p1, 8, pa3);
#undef PK4
}
__device__ __forceinline__ void qkt(f32x16& p0, f32x16& p1, const char* Ks, const h8* qr, int r32, int hi) {
    p0 = f32x16{}; p1 = f32x16{};
#pragma unroll
    for (int d0 = 0; d0 < 8; ++d0) { const int cb = (d0 * 16 + hi * 8) * 2;
        const h8 b0 = *reinterpret_cast<const h8*>(Ks + KSWZ(r32, cb));
        const h8 b1 = *reinterpret_cast<const h8*>(Ks + KSWZ(32 + r32, cb));
        p0 = __builtin_amdgcn_mfma_f32_32x32x16_f16(b0, qr[d0], p0, 0, 0, 0);
        p1 = __builtin_amdgcn_mfma_f32_32x32x16_f16(b1, qr[d0], p1, 0, 0, 0); }
}
__device__ __forceinline__ int v_st(int k, int c) { const int kk = (k & ~0xC) | ((k & 4) << 1) | ((k & 8) >> 1); return ((kk >> 3) * 4 + (c >> 5)) * 512 + ((kk & 7) * 32 + (c & 31)) * 2; }
__device__ __forceinline__ int v_rd_base(int lane) { return ((lane & 3) << 3) | (((lane >> 2) & 3) << 6) | (((lane >> 4) & 1) << 5) | (((lane >> 5) & 1) << 8); }
constexpr int v_rd_off(int d0, int ks, int half) { return d0 * 512 + ks * 4096 + half * 2048; }
template <int OFF> __device__ __forceinline__ s16x4 tr_read(int vb) {
    s16x4 r; asm volatile("ds_read_b64_tr_b16 %0, %1 offset:%2" : "=&v"(r) : "v"(vb), "i"(OFF) : "memory"); return r;
}
template <int D0> __device__ __forceinline__ void pv_one(f32x16& od, int vb, h8 pa0, h8 pa1, h8 pa2, h8 pa3) {
    const s16x4 l0 = tr_read<v_rd_off(D0, 0, 0)>(vb), h0 = tr_read<v_rd_off(D0, 0, 1)>(vb), l1 = tr_read<v_rd_off(D0, 1, 0)>(vb), h1 = tr_read<v_rd_off(D0, 1, 1)>(vb);
    const s16x4 l2 = tr_read<v_rd_off(D0, 2, 0)>(vb), h2_ = tr_read<v_rd_off(D0, 2, 1)>(vb), l3 = tr_read<v_rd_off(D0, 3, 0)>(vb), h3 = tr_read<v_rd_off(D0, 3, 1)>(vb);
    asm volatile("s_waitcnt lgkmcnt(0)" ::: "memory"); SBAR();
#define PK(L, H) __builtin_bit_cast(h8, (__attribute__((ext_vector_type(8))) short){L[0], L[1], L[2], L[3], H[0], H[1], H[2], H[3]})
    od = __builtin_amdgcn_mfma_f32_32x32x16_f16(pa0, PK(l0, h0), od, 0, 0, 0);
    od = __builtin_amdgcn_mfma_f32_32x32x16_f16(pa1, PK(l1, h1), od, 0, 0, 0);
    od = __builtin_amdgcn_mfma_f32_32x32x16_f16(pa2, PK(l2, h2_), od, 0, 0, 0);
    od = __builtin_amdgcn_mfma_f32_32x32x16_f16(pa3, PK(l3, h3), od, 0, 0, 0);
#undef PK
}
__device__ __forceinline__ void pv_d0(f32x16* o, int vb, h8 pa0, h8 pa1, h8 pa2, h8 pa3) {
    pv_one<0>(o[0], vb, pa0, pa1, pa2, pa3); pv_one<1>(o[1], vb, pa0, pa1, pa2, pa3); pv_one<2>(o[2], vb, pa0, pa1, pa2, pa3); pv_one<3>(o[3], vb, pa0, pa1, pa2, pa3);
}
template <bool MASK>
__device__ __forceinline__ void attn_unit(const Unit& u, char* lds, const int wave0) {
    int tid = tid_of(wave0); asm volatile("" : "+v"(tid));
    const int wid = tid >> 6, lane = tid & 63, r32 = lane & 31, hi = lane >> 5;
    char* V_lds = lds; char* K_lds = lds + 2 * SHM_V;
    float* ws = (float*)(lds + 2 * SHM_V + 2 * SHM_K) + wid * 64; float* li_l = ws; float* al_l = ws + 32;
    float m_reg = u.has_sink ? u.sink * (1.0f / SCALE) : -1e30f, l_reg = u.has_sink ? 1.0f : 0.0f; f32x16 o[4] = {}; h8 qr[8];
    const f16* Qw = u.Q + (long)(wid * QBLK + r32) * LDQ + hi * 8;
#pragma unroll
    for (int d0 = 0; d0 < 8; ++d0) qr[d0] = *reinterpret_cast<const h8*>(Qw + d0 * 16);
    const int sr = tid >> 4, sc = (tid & 15) * 8, vst0 = v_st(sr, sc), vst1 = v_st(32 + sr, sc);
    const int vb0 = (int)(uintptr_t)V_lds + v_rd_base(lane);
    struct { h8 vs0, vs1, ks0, ks1; } sr_[2];
    const int qposw = u.qpos0 + wid * QBLK + r32;
#define TILEK(j) ((j) < 4 ? u.Kc + (long)(j) * KVBLK * LDK : u.Kl + (long)((j) - 4) * KVBLK * LDK)
#define TILEV(j) ((j) < 4 ? u.Vc + (long)(j) * KVBLK * LDK : u.Vl + (long)((j) - 4) * KVBLK * LDK)
#define SLOAD(i, j) do { const f16* kp_ = TILEK(j); const f16* vp_ = TILEV(j); sr_[i].vs0 = *(const h8*)(vp_ + (long)sr * LDK + sc); sr_[i].vs1 = *(const h8*)(vp_ + (long)(32 + sr) * LDK + sc); \
    sr_[i].ks0 = *(const h8*)(kp_ + (long)sr * LDK + sc); sr_[i].ks1 = *(const h8*)(kp_ + (long)(32 + sr) * LDK + sc); } while (0)
#define SWRITE(b, i) do { *(h8*)(V_lds + (b) * SHM_V + vst0) = sr_[i].vs0;          \
    *(h8*)(V_lds + (b) * SHM_V + vst1) = sr_[i].vs1; const int kc = sc * 2;               \
    *(h8*)(K_lds + (b) * SHM_K + KSWZ(sr, kc)) = sr_[i].ks0;                       \
    *(h8*)(K_lds + (b) * SHM_K + KSWZ(32 + sr, kc)) = sr_[i].ks1; } while (0)
#define SWAIT() asm volatile("s_waitcnt vmcnt(4)" ::: "memory")
#define RESC(a) do { if (__any((a) < 1.f)) { if (hi == 0) al_l[r32] = (a); asm volatile("s_waitcnt lgkmcnt(0)" ::: "memory"); \
    _Pragma("unroll") for (int d = 0; d < 4; ++d) _Pragma("unroll") for (int r = 0; r < 16; ++r) o[d][r] *= al_l[crow(r, hi)]; } } while (0)
#define DQ(j) (qposw - (u.kpos0 + ((j) - 4) * KVBLK) - 4 * hi)
    f32x16 pA0, pA1, pB0, pB1; float mnA, mnB, alA, alB; h8 pa0, pa1, pa2, pa3; const int NT = u.NT;
    constexpr int SE = 0, SO = 1;
    SLOAD(SE, 0); asm volatile("s_waitcnt vmcnt(0)" ::: "memory"); SWRITE(0, SE); __syncthreads();
    qkt(pA0, pA1, K_lds, qr, r32, hi); partialSM<MASK>(pA0, pA1, m_reg, mnA, alA, 0, false);
    SLOAD(SO, 1); if (2 < NT) SLOAD(SE, 2);
    SWAIT(); SWRITE(1, SO); __syncthreads();
    for (int j = 1; j + 1 < NT; j += 2) {
        SBAR(); qkt(pB0, pB1, K_lds + SHM_K, qr, r32, hi);
        finishSM(pA0, pA1, alA, l_reg, pa0, pa1, pa2, pa3); SBAR();
        SLOAD(SO, j + 2); SBAR();
        pv_d0(o, vb0, pa0, pa1, pa2, pa3); partialSM<MASK>(pB0, pB1, m_reg, mnB, alB, DQ(j), j >= 4);
        __syncthreads(); SWAIT(); SWRITE(0, SE);
        RESC(alB); __syncthreads();
        SBAR(); qkt(pA0, pA1, K_lds, qr, r32, hi);
        finishSM(pB0, pB1, alB, l_reg, pa0, pa1, pa2, pa3); SBAR();
        if (j + 3 < NT) SLOAD(SE, j + 3); SBAR();
        pv_d0(o, vb0 + (int)SHM_V, pa0, pa1, pa2, pa3); partialSM<MASK>(pA0, pA1, m_reg, mnA, alA, DQ(j + 1), j + 1 >= 4);
        __syncthreads(); SWAIT(); SWRITE(1, SO);
        RESC(alA); __syncthreads();
    }
    SBAR(); qkt(pB0, pB1, K_lds + SHM_K, qr, r32, hi);
    finishSM(pA0, pA1, alA, l_reg, pa0, pa1, pa2, pa3); SBAR();
    pv_d0(o, vb0, pa0, pa1, pa2, pa3); partialSM<MASK>(pB0, pB1, m_reg, mnB, alB, DQ(NT - 1), NT - 1 >= 4);
    __syncthreads(); RESC(alB);
    finishSM(pB0, pB1, alB, l_reg, pa0, pa1, pa2, pa3); SBAR();
    pv_d0(o, vb0 + (int)SHM_V, pa0, pa1, pa2, pa3);
    if (hi == 0) li_l[r32] = l_reg; asm volatile("s_waitcnt lgkmcnt(0)" ::: "memory");
    float rli[16];
#pragma unroll
    for (int r = 0; r < 16; ++r) rli[r] = __builtin_amdgcn_rcpf(li_l[crow(r, hi)]);
    f16* Ow = u.O + (long)(wid * QBLK) * LDO;
#pragma unroll
    for (int r = 0; r < 16; ++r) { const int orow = crow(r, hi);
#pragma unroll
        for (int d0 = 0; d0 < 4; ++d0) Ow[(long)orow * LDO + d0 * 32 + r32] = (f16)(o[d0][r] * rli[r]); }
    __syncthreads();
#undef TILEK
#undef TILEV
#undef SLOAD
#undef SWRITE
#undef SWAIT
#undef RESC
#undef DQ
}
}

__device__ __forceinline__ int chunk_row0(int cidx) { const int b = cidx / 34, cid = cidx - b * 34; return cid < 2 ? NLAT + b * CTXL + cid * 128 : b * SEQ + (cid - 2) * 128; }
constexpr int RS = 136;
template <int NOUT>
__device__ __forceinline__ void load_transposed(const f16* src, LAS f16* T0, LAS f16* T1, float lg0, float lg1, int tid) {
#pragma unroll
    for (int it = 0; it < 4; ++it) { const int idx = tid + it * 512, g = idx >> 7, t = idx & 127;
        const h8 x = *(const h8*)(src + (size_t)t * INW + g * 8);
        if (NOUT == 1) {
#pragma unroll
            for (int i = 0; i < 8; ++i) T0[(g * 8 + i) * RS + t] = x[i];
        } else {
            const float wf = __builtin_amdgcn_exp2f(lg0 * (float)(127 - t)), wb = __builtin_amdgcn_exp2f(lg1 * (float)t);
#pragma unroll
            for (int i = 0; i < 8; ++i) { T0[(g * 8 + i) * RS + t] = (f16)((float)x[i] * wf); T1[(g * 8 + i) * RS + t] = (f16)((float)x[i] * wb); }
        } }
}
__device__ __forceinline__ void load_rows(const f16* src, size_t ld, LAS f16* T, int tid) {
#pragma unroll
    for (int it = 0; it < 4; ++it) { const int idx = tid + it * 512, r = idx >> 4, c = (idx & 15) * 8;
        *(LAS h8*)(T + r * RS + c) = *(const h8*)(src + (size_t)r * ld + c); }
}
__device__ __forceinline__ void ret_c1_unit(const Args& a, int l, int cidx, int h, LAS unsigned char* lds, const int wave0) {
    int tid = tid_of(wave0); asm volatile("" : "+v"(tid));
    const int lane = tid & 63, wave = __builtin_amdgcn_readfirstlane(tid >> 6);
    const f16* P = (const f16*)(a.ws + WS_P);
    float* UT = (float*)(a.ws + WS_UT);
    LAS f16* VT = (LAS f16*)lds; LAS f16* KTf = VT + 128 * RS; LAS f16* KTb = KTf + 128 * RS;
    const float lgf = -__expf(a.ret_decay[(l * 2 + 0) * 8 + h]) * 1.4426950408889634f, lgb = -__expf(a.ret_decay[(l * 2 + 1) * 8 + h]) * 1.4426950408889634f;
    const int row0 = chunk_row0(cidx);
    load_transposed<1>(P + (size_t)row0 * INW + VR_OFF + h * HD, VT, VT, 0.f, 0.f, tid);
    load_transposed<2>(P + (size_t)row0 * INW + KR_OFF + h * HD, KTf, KTb, lgf, lgb, tid);
    __syncthreads();
    const int fr = lane & 15, fq = lane >> 4;
    f32x4 af[8], ab[8];
#pragma unroll
    for (int n = 0; n < 8; ++n) { af[n] = (f32x4){0.f, 0.f, 0.f, 0.f}; ab[n] = af[n]; }
#pragma unroll
    for (int ks = 0; ks < 4; ++ks) {
        const h8 A = *(const LAS h8*)(VT + (16 * wave + fr) * RS + 32 * ks + 8 * fq);
#pragma unroll
        for (int n = 0; n < 8; ++n) {
            const h8 Bf = *(const LAS h8*)(KTf + (16 * n + fr) * RS + 32 * ks + 8 * fq);
            const h8 Bb = *(const LAS h8*)(KTb + (16 * n + fr) * RS + 32 * ks + 8 * fq);
            af[n] = __builtin_amdgcn_mfma_f32_16x16x32_f16(Bf, A, af[n], 0, 0, 0);
            ab[n] = __builtin_amdgcn_mfma_f32_16x16x32_f16(Bb, A, ab[n], 0, 0, 0);
        }
    }
    float* uf = UT + ((size_t)(cidx * 8 + h) * 2 + 0) * 16384 + (16 * wave + fr) * 128 + 4 * fq; float* ub = uf + 16384;
#pragma unroll
    for (int n = 0; n < 8; ++n) { *(f32x4*)(uf + 16 * n) = af[n]; *(f32x4*)(ub + 16 * n) = ab[n]; }
    __syncthreads();
}
__device__ __forceinline__ void ph_scan(const Args& a, int l, int tid) {
    const float* UT = (const float*)(a.ws + WS_UT); f16* ST = (f16*)(a.ws + WS_ST);
    for (int it = blockIdx.x * 512 + tid; it < NBATCH * 8 * 2 * 4096; it += gridDim.x * 512) {
        const int e4 = it & 4095, dir = (it >> 12) & 1, h = (it >> 13) & 7, b = it >> 16;
        const float decay = __expf(-__expf(a.ret_decay[(l * 2 + dir) * 8 + h]) * 128.0f);
        f32x4 s = {0.f, 0.f, 0.f, 0.f};
#pragma unroll 17
        for (int i = 0; i < 34; ++i) {
            const int cid = dir == 0 ? i : (i < 2 ? 1 - i : 35 - i);
            const size_t off = ((size_t)((b * 34 + cid) * 8 + h) * 2 + dir) * 16384 + (size_t)e4 * 4;
            const f32x4 uv = *(const f32x4*)(UT + off);
            *(u32x2*)(ST + off) = (u32x2){pkh(s[0], s[1]), pkh(s[2], s[3])};
            s = s * decay + uv;
        }
    }
}
__device__ __forceinline__ void ret_c3_unit(const Args& a, int l, int cidx, int h, LAS unsigned char* lds, const int wave0) {
    int tid = tid_of(wave0); asm volatile("" : "+v"(tid));
    const int lane = tid & 63, wave = __builtin_amdgcn_readfirstlane(tid >> 6);
    unsigned char* wsl = a.ws; asm volatile("" : "+s"(wsl));
    const f16* P = (const f16*)(wsl + WS_P);
    const f16* ST = (const f16*)(wsl + WS_ST);
    f16* Yc = (f16*)(wsl + WS_Y) + 2048;
    LAS f16* KS = (LAS f16*)lds; LAS f16* VT = KS + 128 * RS; LAS f16* ATT = VT + 128 * RS + wave * 16 * RS;
    const float lgf = -__expf(a.ret_decay[(l * 2 + 0) * 8 + h]) * 1.4426950408889634f, lgb = -__expf(a.ret_decay[(l * 2 + 1) * 8 + h]) * 1.4426950408889634f;
    const int row0 = chunk_row0(cidx);
    const int fr = lane & 15, fq = lane >> 4;
    const int pc = 16 * wave + fr;
    const f16* STf = ST + ((size_t)(cidx * 8 + h) * 2 + 0) * 16384; const f16* STb = STf + 16384;
    h8 kr[4], vr[4], sf[4], sb[4], qf[4]; h4 grv[8]; f32x4 gnv[8];
#pragma unroll
    for (int it = 0; it < 4; ++it) { const int idx = tid + it * 512, r = idx >> 4, c = (idx & 15) * 8, g = idx >> 7, t = idx & 127;
        kr[it] = *(const h8*)(P + (size_t)(row0 + r) * INW + KR_OFF + h * HD + c);
        vr[it] = *(const h8*)(P + (size_t)(row0 + t) * INW + VR_OFF + h * HD + g * 8); }
#pragma unroll
    for (int ks = 0; ks < 4; ++ks) qf[ks] = *(const h8*)(P + (size_t)(row0 + pc) * INW + QR_OFF + h * HD + 32 * ks + 8 * fq);
#pragma unroll
    for (int it = 0; it < 4; ++it) { const int idx = tid + it * 512, r = idx >> 4, c = (idx & 15) * 8; sf[it] = *(const h8*)(STf + r * 128 + c); }
    const float* gn = a.ret_gn_g + l * 1024 + h * HD;
#pragma unroll
    for (int it = 0; it < 4; ++it) { const int idx = tid + it * 512, r = idx >> 4, c = (idx & 15) * 8, g = idx >> 7, t = idx & 127;
        *(LAS h8*)(KS + r * RS + c) = kr[it];
#pragma unroll
        for (int i = 0; i < 8; ++i) VT[(g * 8 + i) * RS + t] = vr[it][i]; }
    __syncthreads();
#pragma unroll
    for (int it = 0; it < 4; ++it) { const int idx = tid + it * 512, r = idx >> 4, c = (idx & 15) * 8; sb[it] = *(const h8*)(STb + r * 128 + c); }
#pragma unroll
    for (int n = 0; n < 8; ++n) grv[n] = *(const h4*)(P + (size_t)(row0 + pc) * INW + GR_OFF + h * HD + 16 * n + 4 * fq);
    f32x4 acc[8];
#pragma unroll
    for (int n = 0; n < 8; ++n) acc[n] = (f32x4){0.f, 0.f, 0.f, 0.f};
#pragma unroll
    for (int ks = 0; ks < 4; ++ks)
#pragma unroll
        for (int n = 0; n < 8; ++n) acc[n] = __builtin_amdgcn_mfma_f32_16x16x32_f16(*(const LAS h8*)(KS + (16 * n + fr) * RS + 32 * ks + 8 * fq), qf[ks], acc[n], 0, 0, 0);
#pragma unroll
    for (int n = 0; n < 8; ++n) { h4 w;
#pragma unroll
        for (int r = 0; r < 4; ++r) { const int m = 16 * n + 4 * fq + r, dl = pc - m;
            const float wgt = dl >= 0 ? __builtin_amdgcn_exp2f(lgf * (float)dl) : __builtin_amdgcn_exp2f(lgb * (float)(-dl));
            w[r] = (f16)(acc[n][r] * wgt); }
        *(LAS h4*)(ATT + fr * RS + 16 * n + 4 * fq) = w; }
    __syncthreads();
#pragma unroll
    for (int it = 0; it < 4; ++it) { const int idx = tid + it * 512, r = idx >> 4, c = (idx & 15) * 8; *(LAS h8*)(KS + r * RS + c) = sf[it]; }
    f32x4 o[8];
#pragma unroll
    for (int n = 0; n < 8; ++n) o[n] = (f32x4){0.f, 0.f, 0.f, 0.f};
#pragma unroll
    for (int ks = 0; ks < 4; ++ks) { const h8 B = *(const LAS h8*)(ATT + fr * RS + 32 * ks + 8 * fq);
#pragma unroll
        for (int n = 0; n < 8; ++n) o[n] = __builtin_amdgcn_mfma_f32_16x16x32_f16(*(const LAS h8*)(VT + (16 * n + fr) * RS + 32 * ks + 8 * fq), B, o[n], 0, 0, 0); }
    __syncthreads();
#pragma unroll
    for (int it = 0; it < 4; ++it) { const int idx = tid + it * 512, r = idx >> 4, c = (idx & 15) * 8; *(LAS h8*)(VT + r * RS + c) = sb[it]; }
#pragma unroll
    for (int n = 0; n < 8; ++n) acc[n] = (f32x4){0.f, 0.f, 0.f, 0.f};
#pragma unroll
    for (int ks = 0; ks < 4; ++ks)
#pragma unroll
        for (int n = 0; n < 8; ++n) acc[n] = __builtin_amdgcn_mfma_f32_16x16x32_f16(*(const LAS h8*)(KS + (16 * n + fr) * RS + 32 * ks + 8 * fq), qf[ks], acc[n], 0, 0, 0);
    { const float dq = __builtin_amdgcn_exp2f(lgf * (float)(pc + 1));
#pragma unroll
      for (int n = 0; n < 8; ++n) o[n] += dq * acc[n]; }
    __syncthreads();
#pragma unroll
    for (int n = 0; n < 8; ++n) gnv[n] = *(const f32x4*)(gn + 16 * n + 4 * fq);
#pragma unroll
    for (int n = 0; n < 8; ++n) acc[n] = (f32x4){0.f, 0.f, 0.f, 0.f};
#pragma unroll
    for (int ks = 0; ks < 4; ++ks)
#pragma unroll
        for (int n = 0; n < 8; ++n) acc[n] = __builtin_amdgcn_mfma_f32_16x16x32_f16(*(const LAS h8*)(VT + (16 * n + fr) * RS + 32 * ks + 8 * fq), qf[ks], acc[n], 0, 0, 0);
    { const float dq = __builtin_amdgcn_exp2f(lgb * (float)(128 - pc));
#pragma unroll
      for (int n = 0; n < 8; ++n) o[n] += dq * acc[n]; }
    float s = 0.f;
#pragma unroll
    for (int n = 0; n < 8; ++n) s += (o[n][0] + o[n][1]) + (o[n][2] + o[n][3]);
    s += __shfl_xor(s, 16); s += __shfl_xor(s, 32);
    const float mean = s * (1.0f / 128.0f); float q = 0.f;
#pragma unroll
    for (int n = 0; n < 8; ++n) { const f32x4 d = o[n] - mean; q += (d[0] * d[0] + d[1] * d[1]) + (d[2] * d[2] + d[3] * d[3]); }
    q += __shfl_xor(q, 16); q += __shfl_xor(q, 32);
    const float rstd = 1.0f / sqrtf(q * (1.0f / 128.0f) + GN_EPS);
    f16* yrow = Yc + (size_t)(row0 + pc) * 3072 + h * HD + 4 * fq;
#pragma unroll
    for (int n = 0; n < 8; ++n) { h4 w;
#pragma unroll
        for (int r = 0; r < 4; ++r) { const float gr = (float)grv[n][r]; w[r] = (f16)(gr * sigmoidf_(gr) * ((o[n][r] - mean) * rstd * gnv[n][r])); }
        *(h4*)(yrow + 16 * n) = w; }
    __syncthreads();
}

constexpr int N_PHASES = 26;
__global__ void __launch_bounds__(512, 2) mixer_fwd(Args a) {
    extern __shared__ __attribute__((aligned(16))) unsigned char lds_raw[];
    LAS unsigned char* lds = (LAS unsigned char*)lds_raw;
    const int tid = threadIdx.x, lane = tid & 63, wave = __builtin_amdgcn_readfirstlane(tid >> 6);
    const int wave0 = wave;
    const int G = gridDim.x;
    volatile LAS unsigned* MISC = (volatile LAS unsigned*)(lds + MISC_OFF);
    for (int u = tid; u < (LDS_BYTES - RING_BYTES) / 4; u += 512) ((LAS unsigned*)(lds + RING_BYTES))[u] = 0u;
    __syncthreads();
    unsigned* ctl = (unsigned*)(a.ws + WS_CTL);
    XcdBarrier bar; bar.bar = ctl + CW_BAR; bar.x = 0; bar.st = nullptr;
    if (!MK_PER_PHASE) bar = xcd_barrier_post(ctl + CW_BAR, MISC + 8, tid);
    const int lo = a.ph_lo, hi = a.ph_hi;
#ifndef PH_MASK
#define PH_MASK 0xFFFFFFFFu
#endif
#define PH_ON(b) (((PH_MASK) >> (b)) & 1u)
#ifndef RPT_MASK
#define RPT_MASK 0u
#endif
#define NREP(b) ((((RPT_MASK) >> (b)) & 1u) ? 2 : 1)
#define REPBAR(b, rep) do { if (NREP(b) == 2 && (rep) == 0) xcd_barrier(bar, wave0); } while (0)
#define IN(k) (lo <= (k) && (k) < hi)
#define SEAM(k) do { if (IN(k)) { if ((k) >= 2) bg_convert(a, lds, MISC, (k), G, wave0); if (IN((k) + 1)) xcd_barrier(bar, wave0); } } while (0)
#define TL() int tid = tid_of(wave0); asm volatile("" : "+v"(tid)); const int lane = tid & 63, wave = __builtin_amdgcn_readfirstlane(tid >> 6); (void)lane; (void)wave;
#define WSP() unsigned char* ws_ = a.ws; asm volatile("" : "+s"(ws_)); \
    float* MOD = (float*)(ws_ + WS_MOD); f16* H = (f16*)(ws_ + WS_H); f16* P = (f16*)(ws_ + WS_P); f16* Y = (f16*)(ws_ + WS_Y); f16* MH = (f16*)(ws_ + WS_MH); \
    f16* Z = (f16*)(ws_ + WS_Z); f16* LAT = (f16*)(ws_ + WS_LAT); f16* ACT = (f16*)(ws_ + WS_ACT); float* slab = (float*)(ws_ + WS_SLAB); unsigned* ctl_ = (unsigned*)(ws_ + WS_CTL); \
    const float* modl = MOD + (size_t)l * 3 * NMOD; (void)H; (void)P; (void)Y; (void)MH; (void)Z; (void)LAT; (void)ACT; (void)slab; (void)ctl_; (void)modl;
    if (PH_ON(0) && IN(0)) _Pragma("unroll") for (int rep_ = 0; rep_ < NREP(0); ++rep_) { {
        if (blockIdx.x == 0) rope_table((f32x2*)(a.ws + WS_ROPE), tid);
        if (G >= 256) {
            if ((int)blockIdx.x < 128) ph_modgemv(a, lds, tid, lane, wave, (int)blockIdx.x, 128, 128);
            else ph_convert0(a, lds, lane, wave, (int)blockIdx.x - 128, G - 128);
        } else { ph_modgemv(a, lds, tid, lane, wave, (int)blockIdx.x, 256, G); ph_convert0(a, lds, lane, wave, (int)blockIdx.x, G); }
    } REPBAR(0, rep_); }
    SEAM(0);
    if (PH_ON(1) && IN(1)) _Pragma("unroll") for (int rep_ = 0; rep_ < NREP(1); ++rep_) { { ph_modulate0(a, lane, wave); } REPBAR(1, rep_); }
    SEAM(1);

#pragma unroll 1
    for (int l = 0; l < 2; ++l) {
        const int pb = 2 + 12 * l;
        const bool last = (l == 1);
        const int Mrows = last ? NLAT : MTOT;
        if (PH_ON(2) && IN(pb + 0)) _Pragma("unroll") for (int rep_ = 0; rep_ < NREP(2); ++rep_) { { WSP();
            pg8::Gemm g{H, (const f16*)(a.ws + WS_WIN + l * SZ_WIN), MTOT, INW, DM}; pg8::SKOrder S; S.init(last ? NLAT : MTOT, INW, DM, G, (int)blockIdx.x, last ? 24 : 0);
            pg8::EpiIn E{P, (const f32x2*)(ws_ + WS_ROPE), a.q_norm_g + l * HD, a.k_norm_g + l * HD, (LAS float*)(lds + RING_BYTES + 1024), (f16*)(ws_ + WS_GLT), a.b_gate + l * 3 * DM};
            pg8::gemm_phase<pg8::EpiIn, pg8::SKOrder>(lds, g, S, E, pg8::SKCtx{slab, ctl_ + CW_SK + (l * 5 + 0) * SK_BANK}, wave0);
        } REPBAR(2, rep_); }
        do { if (IN(pb + 0)) { bg_convert(a, lds, MISC, pb + 0, G, wave0); if (IN(pb + 1) || IN(pb + 2)) xcd_barrier(bar, wave0); } } while (0);
        if (PH_ON(4) && IN(pb + 2)) _Pragma("unroll") for (int rep_ = 0; rep_ < NREP(4); ++rep_) { { WSP();
            for (int ui = blockIdx.x; ui < 256; ui += G) {
                const int b = ui >> 7, h = (ui >> 4) & 7, qb = ui & 15, g = h >> 2;
                const int kl0 = qb == 0 ? 0 : qb * 256 - 128, kend = qb == 15 ? SEQ : qb * 256 + 384;
                att::Unit u;
                u.Q = P + (size_t)(b * SEQ + qb * 256) * INW + QA_OFF + h * HD;
                u.Kc = P + (size_t)(NLAT + b * CTXL) * INW + KA_OFF + g * HD; u.Vc = P + (size_t)(NLAT + b * CTXL) * INW + VA_OFF + g * HD;
                u.Kl = P + (size_t)(b * SEQ + kl0) * INW + KA_OFF + g * HD; u.Vl = P + (size_t)(b * SEQ + kl0) * INW + VA_OFF + g * HD;
                u.O = Y + (size_t)(b * SEQ + qb * 256) * 3072 + h * HD; u.NT = 4 + (kend - kl0) / 64; u.qpos0 = qb * 256; u.kpos0 = kl0;
                u.sink = a.attn_sink[l * 8 + h]; u.has_sink = 1;
                att::attn_unit<true>(u, (char*)lds_raw, wave0);
            }
            if (!last) {
                for (int v = blockIdx.x; v < 32; v += G) {
                    const int isB = v >> 4, b = (v >> 3) & 1, h = v & 7, g = h >> 2;
                    att::Unit u;
                    const size_t r0 = (size_t)(NLAT + b * CTXL);
                    u.Q = P + r0 * INW + (isB ? QB_OFF : QA_OFF) + h * HD;
                    u.Kc = P + r0 * INW + (isB ? KB_OFF : KA_OFF) + g * HD; u.Vc = P + r0 * INW + (isB ? VB_OFF : VA_OFF) + g * HD;
                    u.Kl = u.Kc; u.Vl = u.Vc; u.O = Y + r0 * 3072 + (isB ? 1024 : 0) + h * HD; u.NT = 4; u.qpos0 = 0; u.kpos0 = 0;
                    u.sink = a.attn_sink[l * 8 + h]; u.has_sink = isB ? 0 : 1;
                    att::attn_unit<false>(u, (char*)lds_raw, wave0);
                }
            }
            for (int v = G - 1 - (int)blockIdx.x; v < NCHUNK * 8; v += G) ret_c1_unit(a, l, v >> 3, v & 7, lds, wave0);
        } REPBAR(4, rep_); }
        SEAM(pb + 2);
        if (PH_ON(5) && IN(pb + 3)) _Pragma("unroll") for (int rep_ = 0; rep_ < NREP(5); ++rep_) { { TL(); ph_scan(a, l, tid); } REPBAR(5, rep_); }
        SEAM(pb + 3);
        if (PH_ON(6) && IN(pb + 4)) _Pragma("unroll") for (int rep_ = 0; rep_ < NREP(6); ++rep_) { { WSP();
            for (int ui = blockIdx.x; ui < 256; ui += G) {
                const int b = ui >> 7, h = (ui >> 4) & 7, qb = ui & 15, g = h >> 2;
                att::Unit u;
                u.Q = P + (size_t)(b * SEQ + qb * 256) * INW + QB_OFF + h * HD;
                u.Kc = P + (size_t)(NLAT + b * CTXL) * INW + KB_OFF + g * HD; u.Vc = P + (size_t)(NLAT + b * CTXL) * INW + VB_OFF + g * HD;
                u.Kl = P + (size_t)(b * SEQ) * INW + KB_OFF + g * HD; u.Vl = P + (size_t)(b * SEQ) * INW + VB_OFF + g * HD;
                u.O = Y + (size_t)(b * SEQ + qb * 256) * 3072 + 1024 + h * HD; u.NT = 4 + SEQ / 64; u.qpos0 = 0; u.kpos0 = 0; u.sink = 0.f; u.has_sink = 0;
                att::attn_unit<false>(u, (char*)lds_raw, wave0);
            }
            for (int v = G - 1 - (int)blockIdx.x; v < NCHUNK * 8; v += G) {
                if (last && (v >> 3) % 34 < 2) continue;
                ret_c3_unit(a, l, v >> 3, v & 7, lds, wave0);
            }
        } REPBAR(6, rep_); }
        SEAM(pb + 4);
        if (PH_ON(7) && IN(pb + 5)) _Pragma("unroll") for (int rep_ = 0; rep_ < NREP(7); ++rep_) { { WSP();
            pg8::Gemm g{Y, (const f16*)(a.ws + WS_WBR + l * SZ_WBR), Mrows, DM, 3072}; pg8::SKOrder S; S.init(Mrows, DM, 3072, G, (int)blockIdx.x);
            pg8::EpiGateK E{(const f16*)(ws_ + WS_GLT), MH};
            pg8::gemm_phase<pg8::EpiGateK, pg8::SKOrder>(lds, g, S, E, pg8::SKCtx{slab, ctl_ + CW_SK + (l * 5 + 1) * SK_BANK}, wave0);
        } REPBAR(7, rep_); }
        SEAM(pb + 5);
        if (PH_ON(8) && IN(pb + 6)) _Pragma("unroll") for (int rep_ = 0; rep_ < NREP(8); ++rep_) { { WSP();
            pg8::Gemm g{MH, (const f16*)(a.ws + WS_WO + l * SZ_WO), Mrows, DM, DM}; pg8::SKOrder S; S.init(Mrows, DM, DM, G, (int)blockIdx.x, 0, 1);
            pg8::EpiResLN E{l == 0 ? (const void*)a.x : (const void*)LAT, l == 0 ? (const void*)a.ctx : (const void*)(LAT + (size_t)NLAT * DM), modl + 2 * DM, l == 0 ? 0 : 1,
                            a.ln1_g + l * DM, a.ln1_b + l * DM, modl + 3 * DM, modl + 4 * DM, LAT, H, a.out, 0,
                            (unsigned long long*)(slab + (size_t)4 * 1024 * 1024), ctl_ + CW_LN + (l * 2 + 0) * LN_BANK, lds + RING_BYTES + 1024};
            pg8::gemm_phase<pg8::EpiResLN, pg8::SKOrder>(lds, g, S, E, pg8::SKCtx{slab, ctl_ + CW_SK + (l * 5 + 2) * SK_BANK}, wave0);
        } REPBAR(8, rep_); }
        do { if (IN(pb + 6)) { bg_convert(a, lds, MISC, pb + 6, G, wave0); if (IN(pb + 7) || IN(pb + 8)) xcd_barrier(bar, wave0); } } while (0);
        if (PH_ON(10) && IN(pb + 8)) _Pragma("unroll") for (int rep_ = 0; rep_ < NREP(10); ++rep_) { { WSP();
            pg8::Gemm g{H, (const f16*)(a.ws + WS_WUP + l * SZ_WUP), Mrows, 2 * DFF, DM}; pg8::SKOrder S; S.init(Mrows, 2 * DFF, DM, G, (int)blockIdx.x);
            pg8::EpiConv E{a.conv_w + (size_t)l * 3 * DFF, a.conv_b + (size_t)l * DFF, ACT, slab, slab + (size_t)34 * 2 * DFF, slab + (size_t)2 * 34 * 2 * DFF, (LAS float*)(lds + RING_BYTES + 1024)};
            pg8::gemm_phase<pg8::EpiConv, pg8::SKOrder>(lds, g, S, E, pg8::SKCtx{slab, ctl_ + CW_SK + (l * 5 + 3) * SK_BANK}, wave0);
        } REPBAR(10, rep_); }
        SEAM(pb + 8);
        if (PH_ON(11) && IN(pb + 9)) _Pragma("unroll") for (int rep_ = 0; rep_ < NREP(11); ++rep_) { { TL(); ph_convfix(a, l, Mrows, tid); } REPBAR(11, rep_); }
        SEAM(pb + 9);
        if (PH_ON(12) && IN(pb + 10)) _Pragma("unroll") for (int rep_ = 0; rep_ < NREP(12); ++rep_) { { WSP();
            const float* modn = MOD + (size_t)(l + 1) * 3 * NMOD;
            int Gs_ = G; asm volatile("" : "+s"(Gs_));
            const bool sk8 = SK8_DN && l == 0 && Gs_ == 256;
            pg8::Gemm g{ACT, (const f16*)(a.ws + WS_WDN + l * SZ_WDN), Mrows, DM, DFF}; pg8::SKOrder S; S.init(sk8 ? NLAT : Mrows, DM, DFF, G, (int)blockIdx.x, 0, 1);
            pg8::EpiResLN E{(const void*)LAT, (const void*)(LAT + (size_t)NLAT * DM), modl + 5 * DM, 1,
                            a.ln2_g + l * DM, a.ln2_b + l * DM, last ? modl : modn, last ? modl : modn + DM, LAT, H, a.out, last ? 1 : 0,
                            (unsigned long long*)(slab + (size_t)4 * 1024 * 1024), ctl_ + CW_LN + (l * 2 + 1) * LN_BANK, lds + RING_BYTES + 1024};
            pg8::gemm_phase<pg8::EpiResLN, pg8::SKOrder>(lds, g, S, E, pg8::SKCtx{slab, ctl_ + CW_SK + (l * 5 + 4) * SK_BANK}, wave0);
            if (sk8) { pg8::SK8Order S8; S8.init(DFF, (int)blockIdx.x);
                pg8::gemm_phase<pg8::EpiResLN, pg8::SK8Order, true, true, true>(lds, g, S8, E, pg8::SKCtx{(float*)(ws_ + WS_MF), ctl_ + CW_SK + (l * 5 + 4) * SK_BANK}, wave0); }
        } REPBAR(12, rep_); }
        if (!last) do { if (IN(pb + 10)) { bg_convert(a, lds, MISC, pb + 10, G, wave0); if (IN(pb + 11) || IN(pb + 12)) xcd_barrier(bar, wave0); } } while (0);
    }
#undef IN
#undef SEAM
}

extern "C" void kernel_launch(void* const* d_in, const int* in_sizes, int n_in, void* d_out, int out_size, void* d_ws, size_t ws_size, hipStream_t stream) {
    static int grid = 0;
    if (grid == 0) {
        if (n_in != 23 || out_size != NLAT * DM || ws_size < WS_END) { fprintf(stderr, "kernel_launch: unexpected shapes (n_in %d out %d ws %zu, need %zu)\n", n_in, out_size, ws_size, (size_t)WS_END); grid = -1; return; }
        int dev = 0, cus = 0, per_cu = 0;
        if (hipGetDevice(&dev) != hipSuccess || hipDeviceGetAttribute(&cus, hipDeviceAttributeMultiprocessorCount, dev) != hipSuccess) { grid = -1; return; }
        if (hipFuncSetAttribute((const void*)mixer_fwd, hipFuncAttributeMaxDynamicSharedMemorySize, LDS_BYTES) != hipSuccess) { fprintf(stderr, "kernel_launch: hipFuncSetAttribute failed\n"); grid = -1; return; }
        if (hipOccupancyMaxActiveBlocksPerMultiprocessor(&per_cu, (const void*)mixer_fwd, 512, LDS_BYTES) != hipSuccess || per_cu < 1)
            fprintf(stderr, "kernel_launch: occupancy query reports %d workgroups per CU\n", per_cu);
        (void)hipGetLastError();
        grid = cus;
    }
    if (grid < 0) return;
    if (hipMemsetAsync((char*)d_ws + WS_CTL, 0, CTL_ZERO_BYTES, stream) != hipSuccess) return;
    Args a{};
    const float** ap = (const float**)&a;
    for (int i = 0; i < 23; ++i) ap[i] = (const float*)d_in[i];
    a.out = (float*)d_out; a.ws = (unsigned char*)d_ws; a.li = 0; a.pad = 0;
#if MK_PER_PHASE
    for (int p = 0; p < N_PHASES; ++p) { a.ph_lo = p; a.ph_hi = p + 1; hipLaunchKernelGGL(mixer_fwd, dim3(grid), dim3(512), LDS_BYTES, stream, a); }
#else
    a.ph_lo = 0; a.ph_hi = N_PHASES;
    hipLaunchKernelGGL(mixer_fwd, dim3(grid), dim3(512), LDS_BYTES, stream, a);
#endif
    const hipError_t le = hipPeekAtLastError();
    if (le != hipSuccess) fprintf(stderr, "kernel_launch: launch failed: %s\n", hipGetErrorName(le));
}
```

```cpp
#include <hip/hip_runtime.h>
#include <cstdio>
#include <cstdint>

#ifndef MK_PER_PHASE
#define MK_PER_PHASE 0
#endif
#ifndef XORDER
#define XORDER 1
#endif
#ifndef SK8_DN
#define SK8_DN 1
#endif
#ifndef SK8_WO
#define SK8_WO 0
#endif
#ifndef SK_ENABLE
#define SK_ENABLE 0
#endif

#define LAS __attribute__((address_space(3)))
#define GAS __attribute__((address_space(1)))
typedef _Float16 f16;
typedef _Float16 h8 __attribute__((ext_vector_type(8)));
typedef _Float16 h4 __attribute__((ext_vector_type(4)));
typedef _Float16 h2 __attribute__((ext_vector_type(2)));
typedef short s16x4 __attribute__((ext_vector_type(4)));
typedef float f32x2 __attribute__((ext_vector_type(2)));
typedef float f32x4 __attribute__((ext_vector_type(4)));
typedef float f32x16 __attribute__((ext_vector_type(16)));
typedef unsigned u32x2 __attribute__((ext_vector_type(2)));
typedef unsigned u32x4 __attribute__((ext_vector_type(4)));

constexpr int DM = 4096, NBATCH = 2, SEQ = 4096, CTXL = 256, NLAT = NBATCH * SEQ, NCTX = NBATCH * CTXL, MTOT = NLAT + NCTX;
constexpr int HD = 128, INW = 19456, DFF = 11008, NMOD = 6 * DM;
constexpr int QA_OFF = 0, KA_OFF = 1024, VA_OFF = 1280, QB_OFF = 1536, KB_OFF = 2560, VB_OFF = 2816, QR_OFF = 3072, KR_OFF = 4096, VR_OFF = 5120, GR_OFF = 6144, GL_OFF = 7168;
constexpr float LN_EPS = 1e-5f, RMS_EPS = 1e-6f, GN_EPS = 1e-5f;
constexpr float DN_ALPHA = 1.4142135623730951f;
constexpr float ATT_SCALE = 0.088388347648318440f;
constexpr int NCHUNK = 68;

constexpr size_t MiB = 1u << 20;
constexpr size_t WS_CTL = 0, CTL_ZERO_BYTES = 1 * MiB;
constexpr size_t WS_MOD = 1 * MiB;
constexpr size_t WS_ROPE = 2 * MiB;
constexpr size_t WS_WIN = 4 * MiB, SZ_WIN = 152 * MiB;
constexpr size_t WS_WBR = 308 * MiB, SZ_WBR = 24 * MiB;
constexpr size_t WS_WO = 356 * MiB, SZ_WO = 32 * MiB;
constexpr size_t WS_WUP = 420 * MiB, SZ_WUP = 172 * MiB;
constexpr size_t WS_WDN = 764 * MiB, SZ_WDN = 86 * MiB;
constexpr size_t WS_H = 936 * MiB;
constexpr size_t WS_P = 1004 * MiB;
constexpr size_t WS_Y = 1370 * MiB, SZ_Y1 = 17 * MiB;
constexpr size_t WS_MF = 1421 * MiB;
constexpr size_t WS_MH = 1557 * MiB;
constexpr size_t WS_Z = 1625 * MiB;
constexpr size_t WS_LAT = 1761 * MiB;
constexpr size_t WS_ACT = 1897 * MiB;
constexpr size_t WS_UT = 2080 * MiB;
constexpr size_t WS_ST = 2148 * MiB;
constexpr size_t WS_SLAB = 2182 * MiB;
constexpr size_t WS_GLT = 2246 * MiB;
constexpr size_t WS_END = 2450 * MiB;
static_assert(WS_WIN + 2 * SZ_WIN <= WS_WBR && WS_WBR + 2 * SZ_WBR <= WS_WO && WS_WO + 2 * SZ_WO <= WS_WUP && WS_WUP + 2 * SZ_WUP <= WS_WDN && WS_WDN + 2 * SZ_WDN <= WS_H, "ws map");
static_assert(WS_P + (size_t)MTOT * 22016 * 2 <= WS_Y && WS_ACT + (size_t)MTOT * DFF * 2 <= WS_UT, "ws map");
constexpr int CW_Q = 512, CW_QD = 1024;
constexpr int CW_BAR = 4096;
constexpr int CW_LN = 60000, LN_BANK = 64 * 34;
constexpr int CW_SK = 16384, SK_BANK = 4096;
static_assert((CW_SK + 10 * SK_BANK) * 4 <= (int)CTL_ZERO_BYTES && CW_SK + 10 * SK_BANK <= CW_LN && (CW_LN + 4 * LN_BANK) * 4 <= (int)CTL_ZERO_BYTES, "ctl");

constexpr int RING_BYTES = 131072, MISC_OFF = RING_BYTES + 320, LDS_BYTES = 147456;

__device__ __forceinline__ unsigned pkh(float lo, float hi) { h2 v = __builtin_convertvector((f32x2){lo, hi}, h2); return __builtin_bit_cast(unsigned, v); }
__device__ __forceinline__ float wave_sum(float v) {
#pragma unroll
    for (int o = 1; o < 64; o <<= 1) v += __shfl_xor(v, o);
    return v;
}
__device__ __forceinline__ float sigmoidf_(float x) { return __builtin_amdgcn_rcpf(1.0f + __expf(-x)); }
__device__ __forceinline__ int tid_of(int wave0) { return (wave0 << 6) | (int)__builtin_amdgcn_mbcnt_hi(~0u, __builtin_amdgcn_mbcnt_lo(~0u, 0u)); }
#define LDS_WAIT() asm volatile("s_waitcnt lgkmcnt(0)" ::: "memory")
#define VM_WAIT() asm volatile("s_waitcnt vmcnt(0)" ::: "memory")

struct Args {
    const float *x, *c, *ctx, *c_ctx, *w_mod, *b_mod, *w_in, *b_gate, *w_branch, *w_o, *attn_sink, *q_norm_g, *k_norm_g, *ret_decay, *ret_gn_g, *ln1_g, *ln1_b, *w_up, *conv_w, *conv_b, *w_down, *ln2_g, *ln2_b;
    float* out; unsigned char* ws; int ph_lo, ph_hi, li, pad;
};

namespace pg8 {
constexpr int BM = 256, BK = 64, HALF = 128, HTB = HALF * BK * 2, STAGE_BYTES = 8 * HTB, NXCD = 8, WGM = 4;
__host__ __device__ __forceinline__ int lds_byte(int r, int c) { const int st = (r >> 4) * 2 + (c >> 5), rr = r & 15, cc = c & 31, ob = rr * 64 + cc * 2; return st * 1024 + (ob ^ (((ob >> 9) & 1) << 5)); }
__host__ __device__ __forceinline__ void stage_rc(int b, int& R, int& C) { const int st = b / 1024, sb = b % 1024, swz = sb ^ (((sb >> 9) & 1) << 5); R = (st >> 1) * 16 + swz / 64; C = (st & 1) * 32 + (swz % 64) / 2; }
__host__ __device__ __forceinline__ int perm32(int rho) { const int n = rho >> 4, i = rho & 15; return 8 * (i >> 2) + 4 * n + (i & 3); }
struct Unit { int pm, pn, k0, nt, sl, ns, rid; };
struct Gemm { const f16* A; const f16* Bt; int M, N, K; };
struct SKCtx { float* slab; unsigned* cnt; };
struct SKOrder {
    int nM, nN, nwg, G, c, nfull, R, ns, npairs, nextra, lnord, sk8;
    __device__ __forceinline__ void init(int M, int N, int K, int G_, int c_, int nextra_ = 0, int lnord_ = 0, int sk8_ = 0) { lnord = lnord_; sk8 = sk8_; nM = M / BM; nN = N / BM; nwg = nM * nN; G = G_; asm volatile("" : "+s"(G)); c = c_; nextra = nextra_; nfull = (nwg / G) * G; R = nwg - nfull; npairs = K / 128;
        ns = 1; if (R > 0 && SK_ENABLE && nextra == 0) { ns = G / R; const int cap = npairs / 2; if (ns > cap) ns = cap; if (ns > 16) ns = 16; if (ns < 1) ns = 1; } }
    __device__ __forceinline__ bool next_x(int i, Unit& u) const {
        const int x = c & 7, w = c >> 3, nfullc = nN >> 3, remc = nN & 7;
        const int nrest = (nM - 32) * nN + nextra;
        const bool mainu = i < nfullc || (i == nfullc && (w >> 2) < remc);
        int r = 0;
        if (!mainu) { if (remc > 0) r = (i == nfullc) ? x * (4 * (8 - remc)) + (w - 4 * remc) : 32 * (8 - remc) + (i - nfullc - 1) * 256 + c; else r = (i - nfullc) * 256 + c; }
        const int t = (r >> 1) % 12;
        const int rpn = nextra > 0 ? (t < 2 ? 4 + t : (t < 4 ? 8 + t : 12 + t)) : (r >> 1);
        u.pm = mainu ? 4 * x + (w & 3) : 32 + (r & 1); u.pn = mainu ? 8 * i + (w >> 2) : rpn;
        if (lnord && mainu) { u.pm = 8 * (x >> 1) + 4 * i + (w & 3); u.pn = 8 * (x & 1) + (w >> 2); }
        u.k0 = 0; u.nt = 2 * npairs; u.sl = 0; u.ns = 1; u.rid = 0;
        return mainu || r < nrest;
    }
    __device__ __forceinline__ bool next(int i, Unit& u) const {
        if (XORDER && G == 256 && nM >= 32 && nM <= 34 && !SK_ENABLE) return next_x(i, u);
        const long L = (long)i * G + c;
        const bool ok = L < (long)(nwg + nextra);
        const bool ext = L >= nwg;
        int wgid = ok && !ext ? (int)L : 0;
        int sl = 0, nsl = 1, rid = 0, k0 = 0, ntl = 2 * npairs;
#if SK_ENABLE
        if (ok && !ext && L >= nfull && ns > 1) { const int j = (int)(L - nfull); const int r = j / ns; sl = j - r * ns; wgid = nfull + r; nsl = ns; rid = r;
            const int p0 = (int)((long)sl * npairs / ns), p1 = (int)((long)(sl + 1) * npairs / ns); k0 = p0 * 128; ntl = 2 * (p1 - p0); }
#endif
        { const int q = nwg / NXCD, r = nwg % NXCD, xcd = wgid % NXCD, off = wgid / NXCD; wgid = (xcd < r ? xcd * (q + 1) : r * (q + 1) + (xcd - r) * q) + off; }
        const int nig = WGM * nN, gid = wgid / nig, fm = gid * WGM, gsz = (nM - fm) < WGM ? (nM - fm) : WGM;
        int pm = fm + ((wgid % nig) % gsz), pn = (wgid % nig) / gsz;
        const int e = ext ? (int)(L - nwg) : 0, t = e % 12;
        if (ext) { pm = 32 + e / 12; pn = t < 2 ? 4 + t : (t < 4 ? 8 + t : 12 + t); }
        u.pm = pm; u.pn = pn; u.k0 = k0; u.nt = ntl; u.sl = sl; u.ns = nsl; u.rid = rid;
        return ok;
    }
};
struct SK8Order {
    int c, npairs;
    __device__ __forceinline__ void init(int K, int c_) { c = c_; npairs = K / 128; }
    __device__ __forceinline__ bool next(int i, Unit& u) const {
        const int rr = c >> 3, sl = c & 7, p0 = sl * npairs / 8, p1 = (sl + 1) * npairs / 8;
        u.pm = 32 + (rr & 1); u.pn = rr >> 1; u.k0 = p0 * 128; u.nt = 2 * (p1 - p0); u.sl = sl; u.ns = 8; u.rid = rr;
        return i == 0;
    }
};
struct EpiF16 {
    static constexpr bool PERM = true, HOOK = false, SK = false;
    f16* O; int ldc;
    __device__ __forceinline__ void pre(f32x4 (&)[2][2][4][2], const Unit&, int, int, int, int) const {}
    __device__ __forceinline__ void operator()(const f32x4 (&acc)[2][2][4][2], const Unit& u, int wr, int wc, int fr, int fq) const {
        const int row0 = u.pm * BM + wr * 64 + fr, col0 = u.pn * BM + wc * 32 + 8 * fq;
#pragma unroll
        for (int ai = 0; ai < 2; ++ai)
#pragma unroll
            for (int m = 0; m < 4; ++m) { f16* rowp = O + (size_t)(row0 + ai * HALF + m * 16) * ldc + col0;
#pragma unroll
                for (int bj = 0; bj < 2; ++bj) { const f32x4 v0 = acc[ai][bj][m][0], v1 = acc[ai][bj][m][1];
                    u32x4 w; w.x = pkh(v0[0], v0[1]); w.y = pkh(v0[2], v0[3]); w.z = pkh(v1[0], v1[1]); w.w = pkh(v1[2], v1[3]);
                    *(u32x4*)(rowp + bj * HALF) = w; } }
    }
};
struct EpiIn {
    static constexpr bool PERM = true, HOOK = false, SK = false;
    f16* O; const f32x2* rope; const float* qg; const float* kg; LAS float* red; f16* GLT; const float* bgate;
    __device__ __forceinline__ void pre(f32x4 (&)[2][2][4][2], const Unit&, int, int, int, int) const {}
    __device__ __forceinline__ void operator()(const f32x4 (&acc)[2][2][4][2], const Unit& u, int wr, int wc, int fr, int fq) const {
        const int pn = u.pn; const bool lat = u.pm < 32;
        if (pn >= 28) {
            const int gi = pn - 28, br = gi >> 4, pnn = gi & 15;
            int lo = fq * 16 + fr; asm volatile("" : "+v"(lo));
            f16* tp = GLT + ((size_t)((br * 34 + u.pm) * 16 + pnn) * 8 + (wr * 4 + wc)) * 8192 + lo * 8;
            const float* bp = bgate + gi * 256 + wc * 32 + 8 * (lo >> 4);
#pragma unroll
            for (int bj = 0; bj < 2; ++bj) { const f32x4 b0 = *(const f32x4*)(bp + bj * HALF), b1 = *(const f32x4*)(bp + bj * HALF + 4);
#pragma unroll
                for (int ai = 0; ai < 2; ++ai)
#pragma unroll
                    for (int m = 0; m < 4; ++m) { f32x4 v0 = acc[ai][bj][m][0] + b0, v1 = acc[ai][bj][m][1] + b1;
#pragma unroll
                        for (int j = 0; j < 4; ++j) { v0[j] = fminf(fmaxf(v0[j], -20.f), 20.f) * -1.4426950408889634f; v1[j] = fminf(fmaxf(v1[j], -20.f), 20.f) * -1.4426950408889634f; }
                        u32x4 w; w.x = pkh(v0[0], v0[1]); w.y = pkh(v0[2], v0[3]); w.z = pkh(v1[0], v1[1]); w.w = pkh(v1[2], v1[3]);
                        *(u32x4*)(tp + ((ai * 4 + m) * 2 + bj) * 512) = w; } }
            return;
        }
        int kind = 0;
        if (pn < 5) kind = 1; else if (pn >= 6 && pn < 10) kind = 2; else if (pn == 10) kind = 3; else if (pn >= 12 && pn < 16) kind = 1; else if (pn >= 16 && pn < 20) kind = 4;
        const int row0 = u.pm * BM + wr * 64 + fr, col0 = pn * BM + wc * 32 + 8 * fq;
        if (kind == 0 || (kind == 1 && !lat)) {
#pragma unroll
            for (int ai = 0; ai < 2; ++ai)
#pragma unroll
                for (int m = 0; m < 4; ++m) { f16* rowp = O + (size_t)(row0 + ai * HALF + m * 16) * INW + col0;
#pragma unroll
                    for (int bj = 0; bj < 2; ++bj) { const f32x4 v0 = acc[ai][bj][m][0], v1 = acc[ai][bj][m][1];
                        u32x4 w; w.x = pkh(v0[0], v0[1]); w.y = pkh(v0[2], v0[3]); w.z = pkh(v1[0], v1[1]); w.w = pkh(v1[2], v1[3]);
                        *(u32x4*)(rowp + bj * HALF) = w; } }
            return;
        }
        const bool rms = (kind == 2 || kind == 3);
        float rsv[2][2][4];
        if (rms) {
#pragma unroll
            for (int bj = 0; bj < 2; ++bj)
#pragma unroll
                for (int ai = 0; ai < 2; ++ai)
#pragma unroll
                    for (int m = 0; m < 4; ++m) { const f32x4 a0 = acc[ai][bj][m][0], a1 = acc[ai][bj][m][1];
                        float ss = (a0[0] * a0[0] + a0[1] * a0[1]) + (a0[2] * a0[2] + a0[3] * a0[3]) + (a1[0] * a1[0] + a1[1] * a1[1]) + (a1[2] * a1[2] + a1[3] * a1[3]);
                        ss += __shfl_xor(ss, 16); ss += __shfl_xor(ss, 32);
                        if (fq == 0) red[(bj * 256 + ai * HALF + wr * 64 + m * 16 + fr) * 4 + wc] = ss; }
            asm volatile("s_waitcnt lgkmcnt(0)" ::: "memory"); __builtin_amdgcn_s_barrier(); asm volatile("" ::: "memory");
#pragma unroll
            for (int bj = 0; bj < 2; ++bj)
#pragma unroll
                for (int ai = 0; ai < 2; ++ai)
#pragma unroll
                    for (int m = 0; m < 4; ++m) { const f32x4 t = *(const LAS f32x4*)(red + (bj * 256 + ai * HALF + wr * 64 + m * 16 + fr) * 4);
                        rsv[bj][ai][m] = 1.0f / sqrtf(((t[0] + t[1]) + (t[2] + t[3])) * (1.0f / HD) + RMS_EPS); }
        }
        const int dbase = 64 * (wc >> 1) + 16 * (wc & 1) + 4 * fq;
        f32x4 g0 = {1.f, 1.f, 1.f, 1.f}, g1 = g0;
        if (rms) { const float* g = (kind == 2 ? qg : kg) + dbase; g0 = *(const f32x4*)g; g1 = *(const f32x4*)(g + 32); }
        const float ksc = kind == 4 ? ATT_SCALE : 1.0f;
#pragma unroll
        for (int ai = 0; ai < 2; ++ai)
#pragma unroll
            for (int m = 0; m < 4; ++m) { const int row = row0 + ai * HALF + m * 16; const int t = row & (SEQ - 1); const int pos = (wc >> 1) ? (t & 63) : (t >> 6);
                f32x4 cv = {1.f, 1.f, 1.f, 1.f}, sv = {0.f, 0.f, 0.f, 0.f};
                if (lat) { const f32x4* cs = (const f32x4*)(rope + pos * 32 + 16 * (wc & 1) + 4 * fq); const f32x4 c01 = cs[0], c23 = cs[1]; cv = (f32x4){c01[0], c01[2], c23[0], c23[2]}; sv = (f32x4){c01[1], c01[3], c23[1], c23[3]}; }
                f16* rowp = O + (size_t)row * INW + col0;
#pragma unroll
                for (int bj = 0; bj < 2; ++bj) { f32x4 x1 = acc[ai][bj][m][0], x2 = acc[ai][bj][m][1];
                    if (rms) { x1 = x1 * rsv[bj][ai][m] * g0; x2 = x2 * rsv[bj][ai][m] * g1; }
                    const f32x4 o1 = (x1 * cv - x2 * sv) * ksc, o2 = (x2 * cv + x1 * sv) * ksc;
                    u32x4 w; w.x = pkh(o1[0], o1[1]); w.y = pkh(o1[2], o1[3]); w.z = pkh(o2[0], o2[1]); w.w = pkh(o2[2], o2[3]);
                    *(u32x4*)(rowp + bj * HALF) = w; } }
    }
};
struct EpiConv {
    static constexpr bool PERM = true, HOOK = false, SK = false;
    const float* cw; const float* cb; f16* ACT; float* GE; float* XP; float* UPE; LAS float* halo;
    __device__ __forceinline__ void pre(f32x4 (&)[2][2][4][2], const Unit&, int, int, int, int) const {}
    template <int CTRL> static __device__ __forceinline__ float dppf(float old, float src) {
        return __builtin_bit_cast(float, __builtin_amdgcn_update_dpp(__builtin_bit_cast(int, old), __builtin_bit_cast(int, src), CTRL, 0xf, 0xf, false)); }
    __device__ __forceinline__ void operator()(const f32x4 (&acc)[2][2][4][2], const Unit& u, int wr, int wc, int fr, int fq) const {
        const int f0 = u.pn * 128 + wc * 32 + 8 * fq;
        f32x4 w0[2], w1[2], w2[2], bb[2];
#pragma unroll
        for (int n = 0; n < 2; ++n) { w0[n] = *(const f32x4*)(cw + f0 + 4 * n); w1[n] = *(const f32x4*)(cw + DFF + f0 + 4 * n); w2[n] = *(const f32x4*)(cw + 2 * DFF + f0 + 4 * n); bb[n] = *(const f32x4*)(cb + f0 + 4 * n); }
        const int hcol = wc * 32 + 8 * fq;
#pragma unroll
        for (int ai = 0; ai < 2; ++ai) {
            if (fr == 0)  { *(LAS f32x4*)(halo + ((ai * 2 + wr) * 2 + 0) * 128 + hcol) = acc[ai][0][0][0]; *(LAS f32x4*)(halo + ((ai * 2 + wr) * 2 + 0) * 128 + hcol + 4) = acc[ai][0][0][1]; }
            if (fr == 15) { *(LAS f32x4*)(halo + ((ai * 2 + wr) * 2 + 1) * 128 + hcol) = acc[ai][0][3][0]; *(LAS f32x4*)(halo + ((ai * 2 + wr) * 2 + 1) * 128 + hcol + 4) = acc[ai][0][3][1]; }
        }
        if (wr == 0 && fr == 0)  { float* g = GE + (size_t)(u.pm * 2 + 0) * DFF + f0; *(f32x4*)g = acc[0][0][0][0]; *(f32x4*)(g + 4) = acc[0][0][0][1]; }
        if (wr == 1 && fr == 15) { float* g = GE + (size_t)(u.pm * 2 + 1) * DFF + f0; *(f32x4*)g = acc[1][0][3][0]; *(f32x4*)(g + 4) = acc[1][0][3][1]; }
        asm volatile("s_waitcnt lgkmcnt(0)" ::: "memory"); __builtin_amdgcn_s_barrier(); asm volatile("" ::: "memory");
#pragma unroll
        for (int ai = 0; ai < 2; ++ai) {
            f32x4 hp[2] = {{0.f, 0.f, 0.f, 0.f}, {0.f, 0.f, 0.f, 0.f}}, hn[2] = {{0.f, 0.f, 0.f, 0.f}, {0.f, 0.f, 0.f, 0.f}};
            if (wr == 1)      { hp[0] = *(const LAS f32x4*)(halo + ((ai * 2 + 0) * 2 + 1) * 128 + hcol); hp[1] = *(const LAS f32x4*)(halo + ((ai * 2 + 0) * 2 + 1) * 128 + hcol + 4); }
            else if (ai == 1) { hp[0] = *(const LAS f32x4*)(halo + ((0 * 2 + 1) * 2 + 1) * 128 + hcol);  hp[1] = *(const LAS f32x4*)(halo + ((0 * 2 + 1) * 2 + 1) * 128 + hcol + 4); }
            if (wr == 0)      { hn[0] = *(const LAS f32x4*)(halo + ((ai * 2 + 1) * 2 + 0) * 128 + hcol); hn[1] = *(const LAS f32x4*)(halo + ((ai * 2 + 1) * 2 + 0) * 128 + hcol + 4); }
            else if (ai == 0) { hn[0] = *(const LAS f32x4*)(halo + ((1 * 2 + 0) * 2 + 0) * 128 + hcol);  hn[1] = *(const LAS f32x4*)(halo + ((1 * 2 + 0) * 2 + 0) * 128 + hcol + 4); }
#pragma unroll
            for (int m = 0; m < 4; ++m) {
                float o[8], xs[8];
#pragma unroll
                for (int n = 0; n < 2; ++n)
#pragma unroll
                    for (int j = 0; j < 4; ++j) {
                        const float g = acc[ai][0][m][n][j];
                        const float oldp = m > 0 ? dppf<0x121>(0.f, acc[ai][0][m > 0 ? m - 1 : 0][n][j]) : hp[n][j];
                        const float pv = dppf<0x111>(oldp, g);
                        const float oldn = m < 3 ? dppf<0x12f>(0.f, acc[ai][0][m < 3 ? m + 1 : 3][n][j]) : hn[n][j];
                        const float nv = dppf<0x101>(oldn, g);
                        const float x = bb[n][j] + w0[n][j] * pv + w1[n][j] * g + w2[n][j] * nv;
                        xs[4 * n + j] = x; o[4 * n + j] = x * sigmoidf_(x) * acc[ai][1][m][n][j];
                    }
                const int row = u.pm * BM + ai * HALF + wr * 64 + m * 16 + fr;
                u32x4 w; w.x = pkh(o[0], o[1]); w.y = pkh(o[2], o[3]); w.z = pkh(o[4], o[5]); w.w = pkh(o[6], o[7]);
                *(u32x4*)(ACT + (size_t)row * DFF + f0) = w;
                if ((ai == 0 && m == 0 && wr == 0 && fr == 0) || (ai == 1 && m == 3 && wr == 1 && fr == 15)) {
                    const size_t eo = (size_t)(u.pm * 2 + ai) * DFF + f0;
                    *(f32x4*)(XP + eo) = (f32x4){xs[0], xs[1], xs[2], xs[3]}; *(f32x4*)(XP + eo + 4) = (f32x4){xs[4], xs[5], xs[6], xs[7]};
                    *(f32x4*)(UPE + eo) = acc[ai][1][m][0]; *(f32x4*)(UPE + eo + 4) = acc[ai][1][m][1];
                }
            }
        }
    }
};
struct EpiGateK {
    static constexpr bool PERM = true, HOOK = true, SK = false;
    const f16* GLT; f16* Mh;
    template <int MODE>
    __device__ __forceinline__ void scale(f32x4 (&acc)[2][2][4][2], const Unit& u, int sa, int sb, int wr, int wc, int fr, int fq) const {
        int lo = (fq * 16 + fr) * 8; asm volatile("" : "+v"(lo));
        const f16* ta = GLT + ((size_t)((sa * 34 + u.pm) * 16 + u.pn) * 8 + (wr * 4 + wc)) * 8192 + lo;
        const f16* tb = GLT + ((size_t)((sb * 34 + u.pm) * 16 + u.pn) * 8 + (wr * 4 + wc)) * 8192 + lo;
        h8 ca[4], cb[4];
#pragma unroll
        for (int m = 0; m < 4; ++m) { const int q = (m * 2) * 512; ca[m] = *(const h8*)(ta + q); cb[m] = ca[m]; if (MODE == 0) cb[m] = *(const h8*)(tb + q); }
#pragma unroll
        for (int G = 0; G < 4; ++G) { const int bj = G >> 1, ai = G & 1;
            h8 na[4], nb[4];
            if (G < 3) { const int bj2 = (G + 1) >> 1, ai2 = (G + 1) & 1;
#pragma unroll
                for (int m = 0; m < 4; ++m) { const int q = ((ai2 * 4 + m) * 2 + bj2) * 512; na[m] = *(const h8*)(ta + q); nb[m] = na[m]; if (MODE == 0) nb[m] = *(const h8*)(tb + q); } }
            __builtin_amdgcn_sched_barrier(0);
#pragma unroll
            for (int m = 0; m < 4; ++m) {
#pragma unroll
                for (int j = 0; j < 8; ++j) {
                    float f = __builtin_amdgcn_rcpf(1.0f + __builtin_amdgcn_exp2f((float)ca[m][j]));
                    if (MODE == 0) f *= (1.0f + __builtin_amdgcn_exp2f((float)cb[m][j]));
                    acc[ai][bj][m][j >> 2][j & 3] *= f; } }
            asm volatile("" : "+v"(acc[ai][bj][0][0]), "+v"(acc[ai][bj][0][1]), "+v"(acc[ai][bj][1][0]), "+v"(acc[ai][bj][1][1]), "+v"(acc[ai][bj][2][0]), "+v"(acc[ai][bj][2][1]), "+v"(acc[ai][bj][3][0]), "+v"(acc[ai][bj][3][1]) :: "memory");
            if (G < 3) {
#pragma unroll
                for (int m = 0; m < 4; ++m) { ca[m] = na[m]; cb[m] = nb[m]; } } }
    }
    __device__ __forceinline__ void hook(f32x4 (&acc)[2][2][4][2], const Unit& u, int gt, int wr, int wc, int fr, int fq) const { const int seg = gt >> 4; scale<0>(acc, u, seg - 1, seg, wr, wc, fr, fq); }
    __device__ __forceinline__ void pre(f32x4 (&acc)[2][2][4][2], const Unit& u, int wr, int wc, int fr, int fq) const { const int seg = SK_ENABLE ? (((u.k0 >> 6) + u.nt - 1) >> 4) : 2; scale<1>(acc, u, seg, seg, wr, wc, fr, fq); }
    __device__ __forceinline__ void operator()(const f32x4 (&acc)[2][2][4][2], const Unit& u, int wr, int wc, int fr, int fq) const {
        const int row0 = u.pm * BM + wr * 64 + fr, col0 = u.pn * BM + wc * 32 + 8 * fq;
#pragma unroll
        for (int ai = 0; ai < 2; ++ai)
#pragma unroll
            for (int m = 0; m < 4; ++m) { f16* rowp = Mh + (size_t)(row0 + ai * HALF + m * 16) * DM + col0;
#pragma unroll
                for (int bj = 0; bj < 2; ++bj) { const f32x4 v0 = acc[ai][bj][m][0], v1 = acc[ai][bj][m][1];
                    u32x4 w; w.x = pkh(v0[0], v0[1]); w.y = pkh(v0[2], v0[3]); w.z = pkh(v1[0], v1[1]); w.w = pkh(v1[2], v1[3]);
                    *(u32x4*)(rowp + bj * HALF) = w; } }
    }
};
struct EpiRes {
    static constexpr bool PERM = true, HOOK = false, SK = false;
    __device__ __forceinline__ void pre(f32x4 (&)[2][2][4][2], const Unit&, int, int, int, int) const {}
    const void* latA; const void* latB; const float* gv; f16* Z; int lat16;
    __device__ __forceinline__ void operator()(const f32x4 (&acc)[2][2][4][2], const Unit& u, int wr, int wc, int fr, int fq) const {
        const int row0 = u.pm * BM + wr * 64 + fr, col0 = u.pn * BM + wc * 32 + 8 * fq;
        const int mr = u.pm < 16 ? 0 : (u.pm < 32 ? 1 : 2);
        const size_t rbase = u.pm < 32 ? 0 : (size_t)NLAT * DM;
        const void* lat = u.pm < 32 ? latA : latB;
        const float* g = gv + (size_t)mr * NMOD;
#pragma unroll
        for (int bj = 0; bj < 2; ++bj) { const int col = col0 + bj * HALF;
            const f32x4 g0 = *(const f32x4*)(g + col), g1 = *(const f32x4*)(g + col + 4);
#pragma unroll
            for (int ai = 0; ai < 2; ++ai)
#pragma unroll
                for (int m = 0; m < 4; ++m) { const size_t off = (size_t)(row0 + ai * HALF + m * 16) * DM + col;
                    f32x4 l0, l1;
                    if (lat16) { const h8 t = *(const h8*)((const f16*)lat + (off - rbase)); l0 = (f32x4){(float)t[0], (float)t[1], (float)t[2], (float)t[3]}; l1 = (f32x4){(float)t[4], (float)t[5], (float)t[6], (float)t[7]}; }
                    else { l0 = *(const f32x4*)((const float*)lat + (off - rbase)); l1 = *(const f32x4*)((const float*)lat + (off - rbase) + 4); }
                    const f32x4 z0 = l0 * DN_ALPHA + g0 * acc[ai][bj][m][0], z1 = l1 * DN_ALPHA + g1 * acc[ai][bj][m][1];
                    u32x4 w; w.x = pkh(z0[0], z0[1]); w.y = pkh(z0[2], z0[3]); w.z = pkh(z1[0], z1[1]); w.w = pkh(z1[2], z1[3]); *(u32x4*)(Z + off) = w; } }
    }
};

struct EpiResLN {
    static constexpr bool PERM = true, HOOK = false, SK = true;
    const void* latA; const void* latB; const float* gv; int lat16;
    const float* lng; const float* lnb; const float* msh; const float* msc;
    f16* LAT; f16* H; float* out; int writeOut;
    unsigned long long* xslot; unsigned* cnt; LAS unsigned char* lx;
    __device__ __forceinline__ void pre(f32x4 (&acc)[2][2][4][2], const Unit& u, int wr, int wc, int fr, int fq) const {
        int row0 = u.pm * BM + wr * 64 + fr, col0 = u.pn * BM + wc * 32 + 8 * fq;
        asm volatile("" : "+v"(row0), "+v"(col0));
        const int mr = u.pm < 16 ? 0 : (u.pm < 32 ? 1 : 2);
        const size_t rbase = u.pm < 32 ? 0 : (size_t)NLAT * DM;
        const void* lat = u.pm < 32 ? latA : latB;
        const float* g = gv + (size_t)mr * NMOD;
#pragma unroll
        for (int bj = 0; bj < 2; ++bj) { const int col = col0 + bj * HALF;
            const f32x4 g0 = *(const f32x4*)(g + col), g1 = *(const f32x4*)(g + col + 4);
#pragma unroll
            for (int ai = 0; ai < 2; ++ai) {
#pragma unroll
                for (int m = 0; m < 4; ++m) { const size_t off = (size_t)(row0 + ai * HALF + m * 16) * DM + col - rbase;
                    f32x4 l0, l1;
                    if (lat16) { const h8 t = *(const h8*)((const f16*)lat + off); l0 = (f32x4){(float)t[0], (float)t[1], (float)t[2], (float)t[3]}; l1 = (f32x4){(float)t[4], (float)t[5], (float)t[6], (float)t[7]}; }
                    else { l0 = *(const f32x4*)((const float*)lat + off); l1 = *(const f32x4*)((const float*)lat + off + 4); }
                    acc[ai][bj][m][0] = l0 * DN_ALPHA + g0 * acc[ai][bj][m][0]; acc[ai][bj][m][1] = l1 * DN_ALPHA + g1 * acc[ai][bj][m][1]; }
                asm volatile("" : "+v"(acc[ai][bj][0][0]), "+v"(acc[ai][bj][0][1]), "+v"(acc[ai][bj][1][0]), "+v"(acc[ai][bj][1][1]), "+v"(acc[ai][bj][2][0]), "+v"(acc[ai][bj][2][1]), "+v"(acc[ai][bj][3][0]), "+v"(acc[ai][bj][3][1]) :: "memory"); } }
    }
    __device__ __forceinline__ void operator()(const f32x4 (&acc)[2][2][4][2], const Unit& u, int wr, int wc, int fr, int fq) const {
        LAS f32x2* P = (LAS f32x2*)lx; LAS f32x2* S = (LAS f32x2*)(lx + 8192); volatile LAS unsigned* flag = (volatile LAS unsigned*)(lx + 10240);
        const int wid = wr * 4 + wc, lane = fq * 16 + fr;
#pragma unroll
        for (int ai = 0; ai < 2; ++ai)
#pragma unroll
            for (int m = 0; m < 4; ++m) {
                float sm = 0.f;
#pragma unroll
                for (int bj = 0; bj < 2; ++bj)
#pragma unroll
                    for (int n = 0; n < 2; ++n) { const f32x4 xv = acc[ai][bj][m][n]; sm += (xv[0] + xv[1]) + (xv[2] + xv[3]); }
                sm += __shfl_xor(sm, 16); sm += __shfl_xor(sm, 32);
                const float mw = sm * (1.0f / 64.0f); float q = 0.f;
#pragma unroll
                for (int bj = 0; bj < 2; ++bj)
#pragma unroll
                    for (int n = 0; n < 2; ++n) { const f32x4 d = acc[ai][bj][m][n] - mw; q += (d[0] * d[0] + d[1] * d[1]) + (d[2] * d[2] + d[3] * d[3]); }
                q += __shfl_xor(q, 16); q += __shfl_xor(q, 32);
                if (fq == 0) P[(ai * HALF + wr * 64 + m * 16 + fr) * 4 + wc] = (f32x2){mw, q};
            }
        asm volatile("s_waitcnt lgkmcnt(0)" ::: "memory"); __builtin_amdgcn_s_barrier(); asm volatile("" ::: "memory");
        const int row = wid * 32 + (lane & 31);
        if (lane < 32) {
            const f32x2 pa = P[row * 4 + 0], pb = P[row * 4 + 1], pc = P[row * 4 + 2], pd = P[row * 4 + 3];
            const float mt = ((pa.x + pb.x) + (pc.x + pd.x)) * 0.25f;
            const float da = pa.x - mt, db = pb.x - mt, dc = pc.x - mt, dd = pd.x - mt;
            const float m2 = ((pa.y + pb.y) + (pc.y + pd.y)) + 64.0f * ((da * da + db * db) + (dc * dc + dd * dd));
            __hip_atomic_store(xslot + ((size_t)(u.pm * BM + row) * 16 + u.pn), ((unsigned long long)__float_as_uint(m2) << 32) | __float_as_uint(mt), __ATOMIC_RELAXED, __HIP_MEMORY_SCOPE_AGENT);
        }
        asm volatile("s_waitcnt vmcnt(0)" ::: "memory");
        if (lane == 0) __hip_atomic_fetch_add(cnt + 64 * u.pm, 1u, __ATOMIC_RELAXED, __HIP_MEMORY_SCOPE_AGENT);
        if (wid == 0) {
            unsigned sp = 0;
            while ((unsigned)__builtin_amdgcn_readfirstlane((int)__hip_atomic_load(cnt + 64 * u.pm, __ATOMIC_RELAXED, __HIP_MEMORY_SCOPE_AGENT)) < 128u) { __builtin_amdgcn_s_sleep(1); if (++sp > (1u << 22)) break; }
            __builtin_amdgcn_fence(__ATOMIC_ACQUIRE, "agent");
            if (lane == 0) flag[0] = 1u;
        }
        asm volatile("s_waitcnt vmcnt(0) lgkmcnt(0)" ::: "memory"); __builtin_amdgcn_s_barrier(); asm volatile("" ::: "memory");
        if (lane < 32) {
            const unsigned long long* sl = xslot + (size_t)(u.pm * BM + row) * 16; float mt[16], m2[16]; float ms = 0.f;
#pragma unroll
            for (int t = 0; t < 16; ++t) { const unsigned long long wv = __hip_atomic_load(sl + t, __ATOMIC_RELAXED, __HIP_MEMORY_SCOPE_AGENT); mt[t] = __uint_as_float((unsigned)wv); m2[t] = __uint_as_float((unsigned)(wv >> 32)); ms += mt[t]; }
            const float mean = ms * (1.0f / 16.0f); float q = 0.f;
#pragma unroll
            for (int t = 0; t < 16; ++t) { const float dm = mt[t] - mean; q += m2[t] + 256.0f * dm * dm; }
            S[row] = (f32x2){mean, 1.0f / sqrtf(q * (1.0f / DM) + LN_EPS)};
        }
        asm volatile("s_waitcnt lgkmcnt(0)" ::: "memory"); __builtin_amdgcn_s_barrier(); asm volatile("" ::: "memory");
        const int row0 = u.pm * BM + wr * 64 + fr, col0 = u.pn * BM + wc * 32 + 8 * fq;
        const int mr = u.pm < 16 ? 0 : (u.pm < 32 ? 1 : 2);
#pragma unroll
        for (int bj = 0; bj < 2; ++bj) { const int col = col0 + bj * HALF;
            const f32x4 g0 = *(const f32x4*)(lng + col), g1 = *(const f32x4*)(lng + col + 4), b0 = *(const f32x4*)(lnb + col), b1 = *(const f32x4*)(lnb + col + 4);
            f32x4 c0 = {0.f, 0.f, 0.f, 0.f}, c1 = c0, h0 = c0, h1 = c0;
            if (!writeOut) { const float* sc = msc + (size_t)mr * NMOD + col; const float* sh = msh + (size_t)mr * NMOD + col; c0 = *(const f32x4*)sc + 1.0f; c1 = *(const f32x4*)(sc + 4) + 1.0f; h0 = *(const f32x4*)sh; h1 = *(const f32x4*)(sh + 4); }
#pragma unroll
            for (int ai = 0; ai < 2; ++ai)
#pragma unroll
                for (int m = 0; m < 4; ++m) { const int rl = ai * HALF + wr * 64 + m * 16 + fr; const f32x2 st = S[rl]; const size_t off = (size_t)(row0 + ai * HALF + m * 16) * DM + col;
                    const f32x4 y0 = (acc[ai][bj][m][0] - st.x) * st.y * g0 + b0, y1 = (acc[ai][bj][m][1] - st.x) * st.y * g1 + b1;
                    if (writeOut) { if (u.pm < 32) { *(f32x4*)(out + off) = y0; *(f32x4*)(out + off + 4) = y1; } }
                    else { u32x4 w; w.x = pkh(y0[0], y0[1]); w.y = pkh(y0[2], y0[3]); w.z = pkh(y1[0], y1[1]); w.w = pkh(y1[2], y1[3]); *(u32x4*)(LAT + off) = w;
                        const f32x4 v0 = y0 * c0 + h0, v1 = y1 * c1 + h1; u32x4 w2; w2.x = pkh(v0[0], v0[1]); w2.y = pkh(v0[2], v0[3]); w2.z = pkh(v1[0], v1[1]); w2.w = pkh(v1[2], v1[3]); *(u32x4*)(H + off) = w2; } } }
    }
};

template <class Epi, class Sched, bool ALIGN_EPI = true, bool SP2 = true, bool SKW = false>
__device__ __forceinline__ void gemm_phase(LAS unsigned char* lds, const Gemm g, const Sched& S, const Epi& E, const SKCtx SK, const int wave0) {
    int tid = tid_of(wave0); asm volatile("" : "+v"(tid));
    const int wid = __builtin_amdgcn_readfirstlane(tid >> 6), lane = tid & 63, wr = wid >> 2, wc = wid & 3, fr = lane & 15, fq = lane >> 4;
    const int K = g.K;
    unsigned voffA[2], voffB[2];
#pragma unroll
    for (int i = 0; i < 2; ++i) { int R, C; stage_rc(tid * 16 + i * 8192, R, C); const int Rb = Epi::PERM ? ((R & ~31) + perm32(R & 31)) : R;
        voffA[i] = (unsigned)(R * K + C) * 2u; voffB[i] = (unsigned)(Rb * K + C) * 2u; }
    const size_t kstep = (size_t)(BK * 2);
    const size_t hstep = (size_t)HALF * K * 2;
    const size_t tstep = 2 * hstep;
    const unsigned ldsw = (unsigned)wid * 1024u;
    const int aoff = lds_byte(wr * 64 + fr, fq * 8), boff = lds_byte(wc * 32 + fr, fq * 8);
#define PG8_SA(b, h) (((b) * 2 + (h)) * HTB)
#define PG8_SB(b, h) ((4 + (b) * 2 + (h)) * HTB)
#define PG8_STAGE(bufoff, gbase, voff) do { _Pragma("unroll") for (int _i = 0; _i < 2; ++_i) \
        __builtin_amdgcn_global_load_lds((const unsigned*)((const char*)(gbase) + (voff)[_i]), (LAS unsigned*)(lds + (bufoff) + ldsw + _i * 8192), 16, 0, 0); } while (0)
#define PG8_LDA(dst, b, h) do { _Pragma("unroll") for (int m = 0; m < 4; ++m) _Pragma("unroll") for (int k = 0; k < 2; ++k) dst[m][k] = *(const LAS h8*)(lds + PG8_SA(b, h) + aoff + m * 2048 + k * 1024); } while (0)
#define PG8_LDB(dst, b, h) do { _Pragma("unroll") for (int n = 0; n < 2; ++n) _Pragma("unroll") for (int k = 0; k < 2; ++k) dst[n][k] = *(const LAS h8*)(lds + PG8_SB(b, h) + boff + n * 2048 + k * 1024); } while (0)
#define PG8_MMA(ai, bj, At, Bt) do { __builtin_amdgcn_s_setprio(1); _Pragma("unroll") for (int m = 0; m < 4; ++m) _Pragma("unroll") for (int n = 0; n < 2; ++n) _Pragma("unroll") for (int k = 0; k < 2; ++k) \
        acc[ai][bj][m][n] = __builtin_amdgcn_mfma_f32_16x16x32_f16(Bt[n][k], At[m][k], acc[ai][bj][m][n], 0, 0, 0); __builtin_amdgcn_s_setprio(0); } while (0)
#define PG8_WAIT_V(n) asm volatile("s_waitcnt vmcnt(" #n ")" ::: "memory")
#define PG8_WAIT_L(n) asm volatile("s_waitcnt lgkmcnt(" #n ")" ::: "memory")
#define PG8_BAR __builtin_amdgcn_s_barrier()
#define PG8_SCHED __builtin_amdgcn_sched_barrier(0)
    Unit cur, nxt; int ui = 0;
    if (!S.next(0, cur)) return;
    f32x4 acc[2][2][4][2];
#pragma unroll
    for (int a = 0; a < 2; ++a)
#pragma unroll
        for (int b = 0; b < 2; ++b)
#pragma unroll
            for (int m = 0; m < 4; ++m)
#pragma unroll
                for (int n = 0; n < 2; ++n) acc[a][b][m][n] = (f32x4){0.f, 0.f, 0.f, 0.f};
    h8 At[4][2], B0[2][2], B1[2][2];
    constexpr bool SKP = SK_ENABLE || SKW;
    const char* cA = (const char*)g.A + (size_t)cur.pm * tstep + (SKP ? (size_t)cur.k0 * 2 : 0); const char* cB = (const char*)g.Bt + (size_t)cur.pn * tstep + (SKP ? (size_t)cur.k0 * 2 : 0);
    if constexpr (SP2) {
        PG8_STAGE(PG8_SB(0, 0), cB, voffB); PG8_STAGE(PG8_SB(0, 1), cB + hstep, voffB); PG8_STAGE(PG8_SA(0, 0), cA, voffA); PG8_STAGE(PG8_SA(0, 1), cA + hstep, voffA);
        if (wr == 1) PG8_BAR;
        PG8_WAIT_V(2); PG8_BAR;
        PG8_STAGE(PG8_SB(1, 0), cB + kstep, voffB); PG8_STAGE(PG8_SA(1, 0), cA + kstep, voffA); PG8_STAGE(PG8_SB(1, 1), cB + hstep + kstep, voffB);
        PG8_WAIT_V(6); PG8_BAR;
    } else {
        PG8_STAGE(PG8_SB(0, 0), cB, voffB); PG8_STAGE(PG8_SA(0, 0), cA, voffA); PG8_STAGE(PG8_SB(0, 1), cB + hstep, voffB); PG8_STAGE(PG8_SA(0, 1), cA + hstep, voffA);
        if (wr == 1) PG8_BAR;
        PG8_WAIT_V(4); PG8_BAR;
        PG8_STAGE(PG8_SB(1, 0), cB + kstep, voffB); PG8_STAGE(PG8_SA(1, 0), cA + kstep, voffA); PG8_STAGE(PG8_SB(1, 1), cB + hstep + kstep, voffB);
        PG8_WAIT_V(6); PG8_BAR;
    }
    for (;;) {
        const bool has_next = S.next(ui + 1, nxt);
        const char* nA = has_next ? (const char*)g.A + (size_t)nxt.pm * tstep + (SKP ? (size_t)nxt.k0 * 2 : 0) : cA; const char* nB = has_next ? (const char*)g.Bt + (size_t)nxt.pn * tstep + (SKP ? (size_t)nxt.k0 * 2 : 0) : cB;
        const int nt = SKP ? cur.nt : K / BK, kt0 = SKP ? (cur.k0 >> 6) : 0;
        for (int t = 0; t < nt; t += 2) {
            const bool last = (t == nt - 2);
            if constexpr (Epi::HOOK) { const int gt = kt0 + t; if (t > 0 && (gt == 16 || gt == 32)) E.hook(acc, cur, gt, wr, wc, fr, fq); }
            const char* a1 = cA + (size_t)(t + 1) * kstep;
            const char* a2 = last ? nA : cA + (size_t)(t + 2) * kstep; const char* b2 = last ? nB : cB + (size_t)(t + 2) * kstep;
            const char* a3 = a2 + kstep; const char* b3 = b2 + kstep;
            if constexpr (SP2) {
            PG8_LDB(B0, 0, 0); PG8_LDB(B1, 0, 1); PG8_SCHED; PG8_LDA(At, 0, 0); PG8_STAGE(PG8_SA(1, 1), a1 + hstep, voffA);
            PG8_WAIT_V(8); PG8_WAIT_L(0); PG8_BAR; PG8_MMA(0, 0, At, B0); PG8_MMA(0, 1, At, B1); PG8_BAR; PG8_SCHED;
            PG8_LDA(At, 0, 1); PG8_STAGE(PG8_SB(0, 0), b2, voffB); PG8_STAGE(PG8_SB(0, 1), b2 + hstep, voffB); PG8_STAGE(PG8_SA(0, 0), a2, voffA);
            PG8_WAIT_V(8); PG8_WAIT_L(0); PG8_BAR; PG8_MMA(1, 0, At, B0); PG8_MMA(1, 1, At, B1); PG8_BAR; PG8_SCHED;
            PG8_LDB(B0, 1, 0); PG8_LDB(B1, 1, 1); PG8_SCHED; PG8_LDA(At, 1, 0); PG8_STAGE(PG8_SA(0, 1), a2 + hstep, voffA);
            PG8_WAIT_V(8); PG8_WAIT_L(0); PG8_BAR; PG8_MMA(0, 0, At, B0); PG8_MMA(0, 1, At, B1); PG8_BAR; PG8_SCHED;
            PG8_LDA(At, 1, 1); PG8_STAGE(PG8_SB(1, 0), b3, voffB); PG8_STAGE(PG8_SB(1, 1), b3 + hstep, voffB); PG8_STAGE(PG8_SA(1, 0), a3, voffA);
            PG8_WAIT_V(8); PG8_WAIT_L(0); PG8_BAR; PG8_MMA(1, 0, At, B0); PG8_MMA(1, 1, At, B1); PG8_BAR; PG8_SCHED;
            } else {
            PG8_LDB(B0, 0, 0); PG8_SCHED; PG8_LDA(At, 0, 0); PG8_STAGE(PG8_SA(1, 1), a1 + hstep, voffA);
            PG8_WAIT_L(8); PG8_BAR; PG8_WAIT_L(0); PG8_MMA(0, 0, At, B0); PG8_BAR; PG8_SCHED;
            PG8_LDB(B1, 0, 1); PG8_STAGE(PG8_SB(0, 0), b2, voffB);
            PG8_BAR; PG8_WAIT_L(0); PG8_MMA(0, 1, At, B1); PG8_BAR;
            PG8_LDA(At, 0, 1); PG8_STAGE(PG8_SA(0, 0), a2, voffA);
            PG8_BAR; PG8_WAIT_L(0); PG8_MMA(1, 0, At, B0); PG8_BAR; PG8_SCHED;
            PG8_STAGE(PG8_SB(0, 1), b2 + hstep, voffB);
            PG8_WAIT_V(6); PG8_BAR; PG8_MMA(1, 1, At, B1); PG8_BAR;
            PG8_LDB(B0, 1, 0); PG8_SCHED; PG8_LDA(At, 1, 0); PG8_STAGE(PG8_SA(0, 1), a2 + hstep, voffA);
            PG8_WAIT_L(8); PG8_BAR; PG8_WAIT_L(0); PG8_MMA(0, 0, At, B0); PG8_BAR; PG8_SCHED;
            PG8_LDB(B1, 1, 1); PG8_STAGE(PG8_SB(1, 0), b3, voffB);
            PG8_BAR; PG8_WAIT_L(0); PG8_MMA(0, 1, At, B1); PG8_BAR;
            PG8_LDA(At, 1, 1); PG8_STAGE(PG8_SA(1, 0), a3, voffA);
            PG8_BAR; PG8_WAIT_L(0); PG8_MMA(1, 0, At, B0); PG8_BAR; PG8_SCHED;
            PG8_STAGE(PG8_SB(1, 1), b3 + hstep, voffB);
            PG8_WAIT_V(6); PG8_BAR; PG8_MMA(1, 1, At, B1); PG8_BAR;
            }
        }
        if constexpr (ALIGN_EPI) { if (wr == 0) PG8_BAR; }
        if constexpr (SKW) {
            f32x4* af = &acc[0][0][0][0];
            const float* s0 = SK.slab + ((size_t)(cur.rid * cur.ns) * 8 + wid) * 8192;
            int voff = lane * 16; asm volatile("" : "+v"(voff));
            { uintptr_t sb = (uintptr_t)(s0 + (size_t)cur.sl * 8 * 8192); const unsigned lo = __builtin_amdgcn_readfirstlane((unsigned)sb), hi = __builtin_amdgcn_readfirstlane((unsigned)(sb >> 32));
              const __amdgpu_buffer_rsrc_t rs = __builtin_amdgcn_make_buffer_rsrc((void*)(((uintptr_t)hi << 32) | lo), 0, 32768, 0x00020000);
#pragma unroll
              for (int q = 0; q < 32; ++q) __builtin_amdgcn_raw_buffer_store_b128(__builtin_bit_cast(u32x4, af[q]), rs, voff, q * 1024, 16); }
            asm volatile("s_waitcnt vmcnt(0)" ::: "memory"); PG8_BAR;
            volatile LAS unsigned* mk = (volatile LAS unsigned*)(lds + MISC_OFF);
            if (wid == 0) { unsigned old = 0; if (voff == 0) old = __hip_atomic_fetch_add(SK.cnt + cur.rid * 16, 1u, __ATOMIC_RELAXED, __HIP_MEMORY_SCOPE_AGENT);
                old = __builtin_amdgcn_readfirstlane(old); if (voff == 0) mk[30] = old; }
            asm volatile("s_waitcnt vmcnt(0) lgkmcnt(0)" ::: "memory"); PG8_BAR;
            if ((unsigned)__builtin_amdgcn_readfirstlane((int)mk[30]) == (unsigned)(cur.ns - 1)) {
                __builtin_amdgcn_fence(__ATOMIC_ACQUIRE, "agent"); asm volatile("s_waitcnt vmcnt(0)" ::: "memory");
#pragma unroll
                for (int q = 0; q < 32; ++q) af[q] = (f32x4){0.f, 0.f, 0.f, 0.f};
                for (int sl = 0; sl < cur.ns; ++sl) {
                    uintptr_t sb = (uintptr_t)(s0 + (size_t)sl * 8 * 8192); const unsigned lo = __builtin_amdgcn_readfirstlane((unsigned)sb), hi = __builtin_amdgcn_readfirstlane((unsigned)(sb >> 32));
                    const __amdgpu_buffer_rsrc_t rs = __builtin_amdgcn_make_buffer_rsrc((void*)(((uintptr_t)hi << 32) | lo), 0, 32768, 0x00020000);
#pragma unroll
                    for (int qg = 0; qg < 4; ++qg) {
#pragma unroll
                        for (int q = 8 * qg; q < 8 * qg + 8; ++q) af[q] += __builtin_bit_cast(f32x4, __builtin_amdgcn_raw_buffer_load_b128(rs, voff, q * 1024, 0));
                        asm volatile("" : "+v"(af[8 * qg]), "+v"(af[8 * qg + 1]), "+v"(af[8 * qg + 2]), "+v"(af[8 * qg + 3]), "+v"(af[8 * qg + 4]), "+v"(af[8 * qg + 5]), "+v"(af[8 * qg + 6]), "+v"(af[8 * qg + 7]) :: "memory"); } }
                E.pre(acc, cur, wr, wc, fr, fq); E(acc, cur, wr, wc, fr, fq);
            }
        } else if (!SK_ENABLE || cur.ns == 1) { E.pre(acc, cur, wr, wc, fr, fq); E(acc, cur, wr, wc, fr, fq); }
        else {
            E.pre(acc, cur, wr, wc, fr, fq);
            f32x4* af = &acc[0][0][0][0];
            const float* s0 = SK.slab + ((size_t)(cur.rid * cur.ns) * 8 + wid) * 8192;
            int voff = lane * 16; asm volatile("" : "+v"(voff));
            { uintptr_t sb = (uintptr_t)(s0 + (size_t)cur.sl * 8 * 8192); const unsigned lo = __builtin_amdgcn_readfirstlane((unsigned)sb), hi = __builtin_amdgcn_readfirstlane((unsigned)(sb >> 32));
              const __amdgpu_buffer_rsrc_t rs = __builtin_amdgcn_make_buffer_rsrc((void*)(((uintptr_t)hi << 32) | lo), 0, 32768, 0x00020000);
#pragma unroll
              for (int q = 0; q < 32; ++q) __builtin_amdgcn_raw_buffer_store_b128(__builtin_bit_cast(u32x4, af[q]), rs, voff, q * 1024, 16); }
            asm volatile("s_waitcnt vmcnt(0)" ::: "memory");
            unsigned old = 0; if (lane == 0) old = __hip_atomic_fetch_add(SK.cnt + cur.rid * 16 + wid, 1u, __ATOMIC_RELAXED, __HIP_MEMORY_SCOPE_AGENT);
            old = __builtin_amdgcn_readfirstlane(old);
            if (old == (unsigned)(cur.ns - 1)) {
                __builtin_amdgcn_fence(__ATOMIC_ACQUIRE, "agent"); asm volatile("s_waitcnt vmcnt(0)" ::: "memory");
#pragma unroll
                for (int q = 0; q < 32; ++q) af[q] = (f32x4){0.f, 0.f, 0.f, 0.f};
                for (int sl = 0; sl < cur.ns; ++sl) {
                    uintptr_t sb = (uintptr_t)(s0 + (size_t)sl * 8 * 8192); const unsigned lo = __builtin_amdgcn_readfirstlane((unsigned)sb), hi = __builtin_amdgcn_readfirstlane((unsigned)(sb >> 32));
                    const __amdgpu_buffer_rsrc_t rs = __builtin_amdgcn_make_buffer_rsrc((void*)(((uintptr_t)hi << 32) | lo), 0, 32768, 0x00020000);
#pragma unroll
                    for (int qg = 0; qg < 4; ++qg) {
#pragma unroll
                        for (int q = 8 * qg; q < 8 * qg + 8; ++q) af[q] += __builtin_bit_cast(f32x4, __builtin_amdgcn_raw_buffer_load_b128(rs, voff, q * 1024, 0));
                        asm volatile("" : "+v"(af[8 * qg]), "+v"(af[8 * qg + 1]), "+v"(af[8 * qg + 2]), "+v"(af[8 * qg + 3]), "+v"(af[8 * qg + 4]), "+v"(af[8 * qg + 5]), "+v"(af[8 * qg + 6]), "+v"(af[8 * qg + 7]) :: "memory"); } }
                E(acc, cur, wr, wc, fr, fq);
            }
        }
        if (!has_next) break;
#pragma unroll
        for (int a = 0; a < 2; ++a)
#pragma unroll
            for (int b = 0; b < 2; ++b)
#pragma unroll
                for (int m = 0; m < 4; ++m)
#pragma unroll
                    for (int n = 0; n < 2; ++n) acc[a][b][m][n] = (f32x4){0.f, 0.f, 0.f, 0.f};
        cur = nxt; cA = nA; cB = nB; ++ui;
        if constexpr (ALIGN_EPI) { if (wr == 1) PG8_BAR; }
    }
    PG8_WAIT_V(0);
    if constexpr (!ALIGN_EPI) { if (wr == 0) PG8_BAR; }
    PG8_BAR;
#undef PG8_SA
#undef PG8_SB
#undef PG8_STAGE
#undef PG8_LDA
#undef PG8_LDB
#undef PG8_MMA
#undef PG8_WAIT_V
#undef PG8_WAIT_L
#undef PG8_BAR
#undef PG8_SCHED
}
}

#define XB_TMO      128
#define XB_XCNT(j)  (256  + 64 * (j))
#define XB_XSUB(j)  (1280 + 64 * (j))
#define XB_XGEN(j)  (2304 + 64 * (j))
#define XB_TOP      3328
#define XB_TOPGEN   3392
#define XCD_BAR_WORDS 3456
#define XB_SPIN_CAP (1u << 22)
__device__ __forceinline__ unsigned xb_ld(unsigned* p)              { return __hip_atomic_load(p, __ATOMIC_RELAXED, __HIP_MEMORY_SCOPE_AGENT); }
__device__ __forceinline__ unsigned xb_add(unsigned* p, unsigned v) { return __hip_atomic_fetch_add(p, v, __ATOMIC_RELAXED, __HIP_MEMORY_SCOPE_AGENT); }
__device__ __forceinline__ unsigned xb_xcc_id() { return (unsigned)__builtin_amdgcn_s_getreg((3 << 11) | 20) & 0xFu; }
#define XB_SPIN(cond, bar) do { unsigned _sp = 0; while (cond) { __builtin_amdgcn_s_sleep(1); \
    if ((++_sp & 255u) == 0u) { if (xb_ld(&(bar)[XB_TMO])) break; if (_sp > XB_SPIN_CAP) { atomicAdd(&(bar)[XB_TMO], 1u); break; } } } } while (0)
struct XcdBarrier { unsigned* bar; unsigned x; volatile LAS unsigned* st; };
__device__ __forceinline__ XcdBarrier xcd_barrier_post(unsigned* bar, volatile LAS unsigned* st, int tid0) {
    XcdBarrier b; b.bar = bar; b.x = xb_xcc_id(); b.st = st;
    if (tid0 == 0) (void)xb_add(&bar[XB_XCNT(b.x)], 1u);
    return b;
}
__device__ __forceinline__ void xcd_barrier_complete(unsigned* bar, unsigned x, unsigned& nloc, unsigned& nx) {
    const unsigned G = gridDim.x * gridDim.y * gridDim.z;
    unsigned sum, cnt, mine, sp = 0u;
    for (;;) {
        sum = 0u; cnt = 0u; mine = 0u;
#pragma unroll
        for (unsigned j = 0; j < 16; ++j) { const unsigned c = xb_ld(&bar[XB_XCNT(j)]); sum += c; cnt += (c > 0u) ? 1u : 0u; mine = (j == x) ? c : mine; }
        if (sum == G) break;
        __builtin_amdgcn_s_sleep(1);
        if ((++sp & 255u) == 0u) { if (xb_ld(&bar[XB_TMO])) break; if (sp > XB_SPIN_CAP) { atomicAdd(&bar[XB_TMO], 1u); break; } }
    }
    nloc = mine > 0u ? mine : 1u; nx = cnt > 0u ? cnt : 1u;
}
__device__ __forceinline__ void xcd_barrier(const XcdBarrier& b, const int wave0) {
    asm volatile("s_waitcnt vmcnt(0)" ::: "memory");
    __syncthreads();
    int t0_ = tid_of(wave0); asm volatile("" : "+v"(t0_));
    if (t0_ == 0) {
        unsigned* bar = b.bar;
        __builtin_amdgcn_s_waitcnt(0);
        unsigned nloc = b.st[0], nx = b.st[1];
        if (nloc == 0u) { unsigned xl = b.x; asm volatile("" : "+s"(xl)); xcd_barrier_complete(bar, xl, nloc, nx); b.st[0] = nloc; b.st[1] = nx; }
        const unsigned old = xb_add(&bar[XB_XSUB(b.x)], 1u);
        const unsigned gen = old / nloc;
        if (old + 1u == (gen + 1u) * nloc) {
            __builtin_amdgcn_fence(__ATOMIC_RELEASE, "agent");
            asm volatile("s_waitcnt vmcnt(0)" ::: "memory");
            const unsigned og = xb_add(&bar[XB_TOP], 1u);
            const unsigned tg = og / nx;
            if (og + 1u == (tg + 1u) * nx) xb_add(&bar[XB_TOPGEN], 1u);
            else XB_SPIN(xb_ld(&bar[XB_TOPGEN]) == tg, bar);
            __builtin_amdgcn_fence(__ATOMIC_ACQUIRE, "agent");
            xb_add(&bar[XB_XGEN(b.x)], 1u);
            asm volatile("s_waitcnt vmcnt(0)" ::: "memory");
        } else {
            XB_SPIN(xb_ld(&bar[XB_XGEN(b.x)]) == gen, bar);
            __builtin_amdgcn_fence(__ATOMIC_ACQUIRE, "agent");
            asm volatile("s_waitcnt vmcnt(0)" ::: "memory");
        }
    }
    __syncthreads();
}

__device__ __forceinline__ void rope_table(f32x2* tab, int tid) {
    for (int e = tid; e < 64 * 32; e += 512) {
        const int pos = e >> 5, i = e & 31;
        double invf = 1.0; for (int j = 0; j < i; ++j) invf *= 0.74989420933245582730;
        const float ang = (float)pos * (float)invf;
        const double xd = (double)ang;
        const double kq = __builtin_rint(xd * 0.63661977236758134308);
        const double r = (xd - kq * 1.5707963267948966192) - kq * 6.123233995736766e-17;
        const double r2 = r * r;
        double sn = r * (1.0 + r2 * (-1.0 / 6 + r2 * (1.0 / 120 + r2 * (-1.0 / 5040 + r2 * (1.0 / 362880 + r2 * (-1.0 / 39916800 + r2 * (1.0 / 6227020800.0 + r2 * (-1.0 / 1307674368000.0))))))));
        double cs = 1.0 + r2 * (-0.5 + r2 * (1.0 / 24 + r2 * (-1.0 / 720 + r2 * (1.0 / 40320 + r2 * (-1.0 / 3628800 + r2 * (1.0 / 479001600 + r2 * (-1.0 / 87178291200.0)))))));
        const int q = ((int)kq) & 3;
        double c2, s2;
        if (q == 0) { c2 = cs; s2 = sn; } else if (q == 1) { c2 = -sn; s2 = cs; } else if (q == 2) { c2 = -cs; s2 = -sn; } else { c2 = sn; s2 = -cs; }
        tab[e] = (f32x2){(float)c2, (float)s2};
    }
}
__device__ __forceinline__ void ph_modgemv(const Args& a, LAS unsigned char* lds, int tid, int lane, int wave, int first, int last_item, int stride) {
    LAS float* sv = (LAS float*)lds;
    LAS float* red = (LAS float*)(lds + 49152);
    float* MOD = (float*)(a.ws + WS_MOD);
    for (int i = tid; i < 3 * DM; i += 512) { const int r = i >> 12, k = i & 4095; const float c = r < 2 ? a.c[r * DM + k] : a.c_ctx[k]; sv[i] = c * sigmoidf_(c); }
    __syncthreads();
    for (int item = first; item < last_item; item += stride) {
        const int l = item >> 7, cb = item & 127;
        f32x4 acc0 = {0.f, 0.f, 0.f, 0.f}, acc1 = acc0, acc2 = acc0;
        if (lane < 48) {
            const float* wp = a.w_mod + (size_t)l * DM * NMOD + (size_t)(wave * 512) * NMOD + cb * 192 + lane * 4;
            const LAS float* s0 = sv + wave * 512;
            for (int k = 0; k < 512; k += 16) {
                f32x4 v[16];
#pragma unroll
                for (int j = 0; j < 16; ++j) v[j] = *(const f32x4*)(wp + (size_t)(k + j) * NMOD);
#pragma unroll
                for (int j = 0; j < 16; ++j) { acc0 += v[j] * s0[k + j]; acc1 += v[j] * s0[DM + k + j]; acc2 += v[j] * s0[2 * DM + k + j]; }
            }
            *(LAS f32x4*)(red + (wave * 3 + 0) * 192 + lane * 4) = acc0; *(LAS f32x4*)(red + (wave * 3 + 1) * 192 + lane * 4) = acc1; *(LAS f32x4*)(red + (wave * 3 + 2) * 192 + lane * 4) = acc2;
        }
        __syncthreads();
        for (int i = tid; i < 3 * 192; i += 512) { const int r = i / 192, n = i % 192; float s = 0.f;
#pragma unroll
            for (int w = 0; w < 8; ++w) s += red[(w * 3 + r) * 192 + n];
            MOD[(size_t)(l * 3 + r) * NMOD + cb * 192 + n] = s + a.b_mod[l * NMOD + cb * 192 + n]; }
        __syncthreads();
    }
}
__device__ __forceinline__ void cvt_item(const float* W, int K, int N, f16* WT, int ldk, LAS unsigned char* tile, int idx, int lane, bool pair_up = false, bool qk_perm = false) {
    const int nblk = N >> 6, kb = idx / nblk, nb = idx - kb * nblk, k0 = kb * 64, n0 = nb * 64;
    const int d0 = !pair_up ? n0 : (n0 < DFF ? (n0 >> 7) * 256 + (n0 & 127) : ((n0 - DFF) >> 7) * 256 + 128 + ((n0 - DFF) & 127));
    const int g = lane >> 4, q = lane & 15;
    const float* src = W + (size_t)(k0 + 2 * g) * N + n0 + 4 * q;
    f32x4 va[8], vb[8];
#pragma unroll
    for (int i = 0; i < 8; ++i) { va[i] = *(const f32x4*)(src + (size_t)(8 * i) * N); vb[i] = *(const f32x4*)(src + (size_t)(8 * i + 1) * N); }
    LAS unsigned* T32 = (LAS unsigned*)tile;
#pragma unroll
    for (int i = 0; i < 8; ++i)
#pragma unroll
        for (int j = 0; j < 4; ++j) T32[(4 * q + j) * 36 + 4 * i + g] = pkh(va[i][j], vb[i][j]);
    LDS_WAIT();
    const int c = lane & 7;
#pragma unroll
    for (int jj = 0; jj < 8; ++jj) { const int n = (lane >> 3) + 8 * jj; const u32x4 o = *(const LAS u32x4*)(tile + n * 144 + 16 * c);
        int dr = d0 + n;
        if (qk_perm) { const int cc = n0 + n; if (cc < 1280 || (cc >= 1536 && cc < 2816) || (cc >= 3072 && cc < 5120)) { const int d = cc & 127;
                dr = (cc & ~127) + 32 * (2 * (d >> 6) + ((d >> 4) & 1)) + 8 * ((d >> 2) & 3) + 4 * ((d >> 5) & 1) + (d & 3); } }
        *(u32x4*)(WT + (size_t)dr * ldk + k0 + 8 * c) = o; }
    LDS_WAIT();
}
constexpr int I_IN = 64 * 304, I_BR = 16 * 64, I_O = 64 * 64, I_UP = 64 * 344, I_DN = 172 * 64;
constexpr int QT_BR0 = 3 * I_BR, QT_O0 = QT_BR0 + I_O, QT_UP0 = QT_O0 + I_UP, QT_DN0 = QT_UP0 + I_DN, QT_IN1 = QT_DN0 + I_IN,
              QT_BR1 = QT_IN1 + 3 * I_BR, QT_O1 = QT_BR1 + I_O, QT_UP1 = QT_O1 + I_UP, QT_DN1 = QT_UP1 + I_DN, QTOT = QT_DN1;
__device__ __forceinline__ void ph_convert0(const Args& a, LAS unsigned char* lds, int lane, int wave, int wg, int nwgs) {
    LAS unsigned char* tile = lds + wave * 9216;
    for (int it = wg * 8 + wave; it < I_IN; it += nwgs * 8) cvt_item(a.w_in, DM, INW, (f16*)(a.ws + WS_WIN), DM, tile, it, lane, false, true);
}
__device__ __forceinline__ void cvt_queue_item(const Args& a, int q, LAS unsigned char* tile, int lane) {
    int l = 0, r = q;
    if (q >= QT_DN0) { r = q - QT_DN0; if (r < I_IN) { cvt_item(a.w_in + (size_t)DM * INW, DM, INW, (f16*)(a.ws + WS_WIN + SZ_WIN), DM, tile, r, lane, false, true); return; } r -= I_IN; l = 1; }
    if (r < 3 * I_BR) { const int br = r / I_BR; r -= br * I_BR; cvt_item(a.w_branch + (size_t)(l * 3 + br) * 1024 * DM, 1024, DM, (f16*)(a.ws + WS_WBR + l * SZ_WBR) + br * 1024, 3072, tile, r, lane); return; } r -= 3 * I_BR;
    if (r < I_O) { cvt_item(a.w_o + (size_t)l * DM * DM, DM, DM, (f16*)(a.ws + WS_WO + l * SZ_WO), DM, tile, r, lane); return; } r -= I_O;
    if (r < I_UP) { cvt_item(a.w_up + (size_t)l * DM * 2 * DFF, DM, 2 * DFF, (f16*)(a.ws + WS_WUP + l * SZ_WUP), DM, tile, r, lane, true); return; } r -= I_UP;
    cvt_item(a.w_down + (size_t)l * DFF * DM, DFF, DM, (f16*)(a.ws + WS_WDN + l * SZ_WDN), DFF, tile, r, lane);
}
__device__ __forceinline__ int q_need(int p) {
    return p < 6 ? 0 : p < 7 ? QT_BR0 : p < 8 ? QT_O0 : p < 11 ? QT_UP0 : p < 12 ? QT_DN0 : p < 18 ? QT_IN1 : p < 19 ? QT_BR1 : p < 20 ? QT_O1 : p < 23 ? QT_UP1 : QT_DN1;
}
__device__ __forceinline__ bool q_gemm_phase(int p) { const int j = (p - 2) % 12; return p >= 2 && (j == 0 || j == 5 || j == 6 || j == 8 || j == 10); }
__device__ __forceinline__ void bg_convert(const Args& a, LAS unsigned char* lds, volatile LAS unsigned* MISC, int p, int G, const int wave0) {
    unsigned* ctl = (unsigned*)(a.ws + WS_CTL);
    int tid = tid_of(wave0); asm volatile("" : "+v"(tid));
    const int lane = tid & 63, wave = __builtin_amdgcn_readfirstlane(tid >> 6);
    const bool opp = q_gemm_phase(p); const int need = q_need(p);
    if (opp && tid == 0) __hip_atomic_fetch_add(ctl + CW_QD + 64 * p, 1u, __ATOMIC_RELAXED, __HIP_MEMORY_SCOPE_AGENT);
    if (p == 10 && G >= 256 && (int)blockIdx.x >= 128) ph_modgemv(a, lds, tid, lane, wave, 128 + (int)blockIdx.x - 128, 256, 128);
    const int skip = G > 64 ? 32 : 0;
    if ((int)blockIdx.x < skip) return;
    const int NW = (G - skip) * 8, w = ((int)blockIdx.x - skip) * 8 + wave;
    LAS unsigned char* tile = lds + wave * 9216;
    int k = (int)MISC[16 + wave];
    for (;;) {
        const int q = w + k * NW;
        if (q >= QTOT) { if (wave == 0 && lane == 0) MISC[31] = (unsigned)(p + 1); break; }
        if (q >= need) {
            if (!opp) break;
            if (wave == 0) { if ((unsigned)__builtin_amdgcn_readfirstlane((int)__hip_atomic_load(ctl + CW_QD + 64 * p, __ATOMIC_RELAXED, __HIP_MEMORY_SCOPE_AGENT)) >= (unsigned)G) { if (lane == 0) MISC[31] = (unsigned)(p + 1); break; } }
            else if (MISC[31] == (unsigned)(p + 1)) break;
        }
        cvt_queue_item(a, q, tile, lane);
        ++k;
    }
    if (lane == 0) MISC[16 + wave] = (unsigned)k;
}
__device__ __forceinline__ void ph_modulate0(const Args& a, int lane, int wave) {
    const float* MOD = (const float*)(a.ws + WS_MOD);
    f16* H = (f16*)(a.ws + WS_H);
    for (int row = blockIdx.x * 8 + wave; row < MTOT; row += gridDim.x * 8) {
        const int mr = row < SEQ ? 0 : (row < NLAT ? 1 : 2);
        const f32x4* src = (const f32x4*)(row < NLAT ? a.x + (size_t)row * DM : a.ctx + (size_t)(row - NLAT) * DM) + lane;
        const f32x4* sh = (const f32x4*)(MOD + (size_t)mr * NMOD) + lane; const f32x4* sc = (const f32x4*)(MOD + (size_t)mr * NMOD + DM) + lane;
        u32x2* o = (u32x2*)(H + (size_t)row * DM) + lane;
#pragma unroll 4
        for (int j = 0; j < 16; ++j) { const f32x4 v = src[64 * j], s = sc[64 * j], t = sh[64 * j]; const f32x4 y = v * (s + 1.0f) + t;
            o[64 * j] = (u32x2){pkh(y[0], y[1]), pkh(y[2], y[3])}; }
    }
}

__device__ __forceinline__ void ph_post(const Args& a, int l, int lane, int wave) {
    f16* P = (f16*)(a.ws + WS_P);
    const f32x2* rope = (const f32x2*)(a.ws + WS_ROPE);
    const float* qg = a.q_norm_g + l * HD; const float* kg = a.k_norm_g + l * HD;
    const int gsub = lane >> 3, s = lane & 7;
    const int e0 = (s & 3) * 8 + (s >> 2) * 64;
    const int nitems = MTOT * 36;
    for (int it = (blockIdx.x * 8 + wave) * 8 + gsub; it < nitems; it += gridDim.x * 64) {
        const int row = it / 36, hv = it - row * 36;
        int col, kind;
        if (hv < 8) { col = QA_OFF + hv * HD; kind = 0; } else if (hv < 10) { col = KA_OFF + (hv - 8) * HD; kind = 0; }
        else if (hv < 18) { col = QB_OFF + (hv - 10) * HD; kind = 1; } else if (hv < 20) { col = KB_OFF + (hv - 18) * HD; kind = 2; }
        else if (hv < 28) { col = QR_OFF + (hv - 20) * HD; kind = 0; } else { col = KR_OFF + (hv - 28) * HD; kind = 3; }
        const bool lat = row < NLAT;
        if (!lat && kind == 0) continue;
        f16* p = P + (size_t)row * INW + col + e0;
        const h8 x1 = *(const h8*)p, x2 = *(const h8*)(p + 32);
        float f1[8], f2[8];
#pragma unroll
        for (int j = 0; j < 8; ++j) { f1[j] = (float)x1[j]; f2[j] = (float)x2[j]; }
        if (kind == 1 || kind == 2) {
            float ss = 0.f;
#pragma unroll
            for (int j = 0; j < 8; ++j) ss += f1[j] * f1[j] + f2[j] * f2[j];
            ss += __shfl_xor(ss, 1); ss += __shfl_xor(ss, 2); ss += __shfl_xor(ss, 4);
            const float rs = 1.0f / sqrtf(ss * (1.0f / HD) + RMS_EPS);
            const float* g = (kind == 1 ? qg : kg) + e0;
#pragma unroll
            for (int j = 0; j < 8; ++j) { f1[j] = f1[j] * rs * g[j]; f2[j] = f2[j] * rs * g[32 + j]; }
        }
        if (lat) {
            const int t = row & (SEQ - 1); const int pos = (s < 4) ? (t >> 6) : (t & 63);
            const f32x2* cs = rope + pos * 32 + (s & 3) * 8;
#pragma unroll
            for (int j = 0; j < 8; ++j) { const f32x2 w = cs[j]; const float o1 = f1[j] * w.x - f2[j] * w.y, o2 = f2[j] * w.x + f1[j] * w.y; f1[j] = o1; f2[j] = o2; }
        }
        if (kind == 3) {
#pragma unroll
            for (int j = 0; j < 8; ++j) { f1[j] *= ATT_SCALE; f2[j] *= ATT_SCALE; }
        }
        u32x4 w1, w2; w1.x = pkh(f1[0], f1[1]); w1.y = pkh(f1[2], f1[3]); w1.z = pkh(f1[4], f1[5]); w1.w = pkh(f1[6], f1[7]);
        w2.x = pkh(f2[0], f2[1]); w2.y = pkh(f2[2], f2[3]); w2.z = pkh(f2[4], f2[5]); w2.w = pkh(f2[6], f2[7]);
        *(u32x4*)p = w1; *(u32x4*)(p + 32) = w2;
    }
}
__device__ __forceinline__ void ph_ln(const Args& a, const float* g, const float* b, const float* msh, const float* msc, bool writeH, bool writeOut, int Mrows, int lane, int wave) {
    const f16* Z = (const f16*)(a.ws + WS_Z); f16* LAT = (f16*)(a.ws + WS_LAT); f16* H = (f16*)(a.ws + WS_H);
    for (int row = blockIdx.x * 8 + wave; row < Mrows; row += gridDim.x * 8) {
        const h8* zr = (const h8*)(Z + (size_t)row * DM) + lane;
        f32x4 v[8][2]; float s = 0.f;
#pragma unroll
        for (int j = 0; j < 8; ++j) { const h8 t = zr[64 * j]; v[j][0] = (f32x4){(float)t[0], (float)t[1], (float)t[2], (float)t[3]}; v[j][1] = (f32x4){(float)t[4], (float)t[5], (float)t[6], (float)t[7]};
            s += ((v[j][0][0] + v[j][0][1]) + (v[j][0][2] + v[j][0][3])) + ((v[j][1][0] + v[j][1][1]) + (v[j][1][2] + v[j][1][3])); }
        const float mean = wave_sum(s) * (1.0f / DM); float s2 = 0.f;
#pragma unroll
        for (int j = 0; j < 8; ++j)
#pragma unroll
            for (int hh = 0; hh < 2; ++hh) { v[j][hh] = v[j][hh] - mean; s2 += (v[j][hh][0] * v[j][hh][0] + v[j][hh][1] * v[j][hh][1]) + (v[j][hh][2] * v[j][hh][2] + v[j][hh][3] * v[j][hh][3]); }
        const float rstd = 1.0f / sqrtf(wave_sum(s2) * (1.0f / DM) + LN_EPS);
        const int mr = row < SEQ ? 0 : (row < NLAT ? 1 : 2);
        u32x4* lo = (u32x4*)(LAT + (size_t)row * DM) + lane;
        u32x4* ho = (u32x4*)(H + (size_t)row * DM) + lane;
        float* oo = a.out + (size_t)row * DM + lane * 8;
        const float* gg = g + lane * 8; const float* bb = b + lane * 8;
        const float* sh = msh + (size_t)mr * NMOD + lane * 8; const float* sc = msc + (size_t)mr * NMOD + lane * 8;
#pragma unroll
        for (int j = 0; j < 8; ++j) {
            const f32x4 y0 = v[j][0] * rstd * *(const f32x4*)(gg + 512 * j) + *(const f32x4*)(bb + 512 * j), y1 = v[j][1] * rstd * *(const f32x4*)(gg + 512 * j + 4) + *(const f32x4*)(bb + 512 * j + 4);
            if (writeOut) { if (row < NLAT) { *(f32x4*)(oo + 512 * j) = y0; *(f32x4*)(oo + 512 * j + 4) = y1; } }
            else lo[64 * j] = (u32x4){pkh(y0[0], y0[1]), pkh(y0[2], y0[3]), pkh(y1[0], y1[1]), pkh(y1[2], y1[3])};
            if (writeH) { const f32x4 h0 = y0 * (*(const f32x4*)(sc + 512 * j) + 1.0f) + *(const f32x4*)(sh + 512 * j), h1 = y1 * (*(const f32x4*)(sc + 512 * j + 4) + 1.0f) + *(const f32x4*)(sh + 512 * j + 4);
                ho[64 * j] = (u32x4){pkh(h0[0], h0[1]), pkh(h0[2], h0[3]), pkh(h1[0], h1[1]), pkh(h1[2], h1[3])}; } }
    }
}
__device__ __forceinline__ void ph_convfix(const Args& a, int l, int Mrows, int tid) {
    const float* GE = (const float*)(a.ws + WS_SLAB); const float* XP = GE + (size_t)34 * 2 * DFF; const float* UPE = XP + (size_t)34 * 2 * DFF;
    f16* ACT = (f16*)(a.ws + WS_ACT);
    const float* cw = a.conv_w + (size_t)l * 3 * DFF;
    constexpr int NF4 = DFF / 4;
    const int nitems = (Mrows / 256) * 2 * NF4;
    for (int it = blockIdx.x * 512 + tid; it < nitems; it += gridDim.x * 512) {
        const int pe = it / NF4, f = (it - pe * NF4) * 4, pm = pe >> 1, e = pe & 1;
        f32x4 x = *(const f32x4*)(XP + (size_t)pe * DFF + f); const f32x4 up = *(const f32x4*)(UPE + (size_t)pe * DFF + f);
        const bool has = e == 0 ? !(pm >= 32 || (pm & 15) == 0) : !(pm >= 32 || (pm & 15) == 15);
        if (has) { const f32x4 ge = *(const f32x4*)(GE + (size_t)((e ? pm + 1 : pm - 1) * 2 + (e ? 0 : 1)) * DFF + f); const f32x4 w = *(const f32x4*)(cw + (e ? 2 : 0) * DFF + f); x += w * ge; }
        float o[4];
#pragma unroll
        for (int j = 0; j < 4; ++j) o[j] = x[j] * sigmoidf_(x[j]) * up[j];
        *(u32x2*)(ACT + (size_t)(pm * 256 + 255 * e) * DFF + f) = (u32x2){pkh(o[0], o[1]), pkh(o[2], o[3])};
    }
}

namespace att {
constexpr int D = 128, NW = 8, QBLK = 32, KVBLK = 64;
constexpr float SCALE = ATT_SCALE;
constexpr float THR = 8.f;
constexpr int LDQ = INW, LDK = INW, LDO = 3072;
constexpr size_t SHM_V = KVBLK * D * 2, SHM_K = KVBLK * D * 2, SHM_ATTN = 2 * SHM_V + 2 * SHM_K + NW * 64 * 4;
#define KSWZ(row, colB) ((row) * 256 + ((colB) ^ (((row) & 7) << 4)))
#define SBAR() __builtin_amdgcn_sched_barrier(0)
__device__ __forceinline__ int crow(int r, int hi) { return (r & 3) + 8 * (r >> 2) + 4 * hi; }
struct Unit { const f16* Q; const f16* Kc; const f16* Vc; const f16* Kl; const f16* Vl; f16* O; int NT; int qpos0; int kpos0; float sink; int has_sink; };
template <bool MASK>
__device__ __forceinline__ void partialSM(f32x16& p0, f32x16& p1, float& m_reg, float& mn, float& alpha, int dq, bool domask) {
    constexpr float C = SCALE * 1.4426950408889634f;
    if (MASK) { if (domask) {
#pragma unroll
        for (int r = 0; r < 16; ++r) { const int k0 = (r & 3) + 8 * (r >> 2); const int d0 = dq - k0, d1 = dq - 32 - k0;
            p0[r] = (d0 > 128 || d0 < -128) ? -1e30f : p0[r]; p1[r] = (d1 > 128 || d1 < -128) ? -1e30f : p1[r]; } } }
    float pmax = p0[0];
#pragma unroll
    for (int r = 1; r < 16; ++r) pmax = fmaxf(pmax, p0[r]);
#pragma unroll
    for (int r = 0; r < 16; ++r) pmax = fmaxf(pmax, p1[r]);
    { auto rr = __builtin_amdgcn_permlane32_swap(__float_as_uint(pmax), __float_as_uint(pmax), false, false);
      pmax = fmaxf(__uint_as_float(rr[0]), __uint_as_float(rr[1])); }
    if (__builtin_expect(__all(pmax - m_reg <= THR / SCALE), 1)) { mn = m_reg; alpha = 1.f; }
    else { mn = fmaxf(m_reg, pmax); alpha = __builtin_amdgcn_exp2f((m_reg - mn) * C); m_reg = mn; }
    const float mnC = -mn * C;
#pragma unroll
    for (int r = 0; r < 16; ++r) p0[r] = fmaf(p0[r], C, mnC);
#pragma unroll
    for (int r = 0; r < 16; ++r) p1[r] = fmaf(p1[r], C, mnC);
#pragma unroll
    for (int r = 0; r < 16; ++r) p0[r] = __builtin_amdgcn_exp2f(p0[r]);
}
__device__ __forceinline__ void finishSM(f32x16& p0, f32x16& p1, float alpha, float& l_reg, h8& pa0, h8& pa1, h8& pa2, h8& pa3) {
#pragma unroll
    for (int r = 0; r < 16; ++r) p1[r] = __builtin_amdgcn_exp2f(p1[r]);
    float ps = 0;
#pragma unroll
    for (int r = 0; r < 16; ++r) ps += p0[r];
#pragma unroll
    for (int r = 0; r < 16; ++r) ps += p1[r];
    { auto rr = __builtin_amdgcn_permlane32_swap(__float_as_uint(ps), __float_as_uint(ps), false, false);
      ps = __uint_as_float(rr[0]) + __uint_as_float(rr[1]); }
    l_reg = l_reg * alpha + ps;
#define PK4(P, BASE, OUT) do { unsigned a0 = pkh(P[BASE + 0], P[BASE + 1]), a1 = pkh(P[BASE + 2], P[BASE + 3]);   \
    unsigned b0 = pkh(P[BASE + 4], P[BASE + 5]), b1 = pkh(P[BASE + 6], P[BASE + 7]);                              \
    auto r0 = __builtin_amdgcn_permlane32_swap(a0, b0, false, false); auto r1 = __builtin_amdgcn_permlane32_swap(a1, b1, false, false); \
    u32x4 w = {r0[0], r1[0], r0[1], r1[1]}; OUT = __builtin_bit_cast(h8, w); } while (0)
    PK4(p0, 0, pa0); PK4(p0, 8, pa1); PK4(p1, 0, pa2); PK4(p1, 8, pa3);
#undef PK4
}
__device__ __forceinline__ void qkt(f32x16& p0, f32x16& p1, const char* Ks, const h8* qr, int r32, int hi) {
    p0 = f32x16{}; p1 = f32x16{};
#pragma unroll
    for (int d0 = 0; d0 < 8; ++d0) { const int cb = (d0 * 16 + hi * 8) * 2;
        const h8 b0 = *reinterpret_cast<const h8*>(Ks + KSWZ(r32, cb));
        const h8 b1 = *reinterpret_cast<const h8*>(Ks + KSWZ(32 + r32, cb));
        p0 = __builtin_amdgcn_mfma_f32_32x32x16_f16(b0, qr[d0], p0, 0, 0, 0);
        p1 = __builtin_amdgcn_mfma_f32_32x32x16_f16(b1, qr[d0], p1, 0, 0, 0); }
}
__device__ __forceinline__ int v_st(int k, int c) { const int kk = (k & ~0xC) | ((k & 4) << 1) | ((k & 8) >> 1); return ((kk >> 3) * 4 + (c >> 5)) * 512 + ((kk & 7) * 32 + (c & 31)) * 2; }
__device__ __forceinline__ int v_rd_base(int lane) { return ((lane & 3) << 3) | (((lane >> 2) & 3) << 6) | (((lane >> 4) & 1) << 5) | (((lane >> 5) & 1) << 8); }
constexpr int v_rd_off(int d0, int ks, int half) { return d0 * 512 + ks * 4096 + half * 2048; }
template <int OFF> __device__ __forceinline__ s16x4 tr_read(int vb) {
    s16x4 r; asm volatile("ds_read_b64_tr_b16 %0, %1 offset:%2" : "=&v"(r) : "v"(vb), "i"(OFF) : "memory"); return r;
}
template <int D0> __device__ __forceinline__ void pv_one(f32x16& od, int vb, h8 pa0, h8 pa1, h8 pa2, h8 pa3) {
    const s16x4 l0 = tr_read<v_rd_off(D0, 0, 0)>(vb), h0 = tr_read<v_rd_off(D0, 0, 1)>(vb), l1 = tr_read<v_rd_off(D0, 1, 0)>(vb), h1 = tr_read<v_rd_off(D0, 1, 1)>(vb);
    const s16x4 l2 = tr_read<v_rd_off(D0, 2, 0)>(vb), h2_ = tr_read<v_rd_off(D0, 2, 1)>(vb), l3 = tr_read<v_rd_off(D0, 3, 0)>(vb), h3 = tr_read<v_rd_off(D0, 3, 1)>(vb);
    asm volatile("s_waitcnt lgkmcnt(0)" ::: "memory"); SBAR();
#define PK(L, H) __builtin_bit_cast(h8, (__attribute__((ext_vector_type(8))) short){L[0], L[1], L[2], L[3], H[0], H[1], H[2], H[3]})
    od = __builtin_amdgcn_mfma_f32_32x32x16_f16(pa0, PK(l0, h0), od, 0, 0, 0);
    od = __builtin_amdgcn_mfma_f32_32x32x16_f16(pa1, PK(l1, h1), od, 0, 0, 0);
    od = __builtin_amdgcn_mfma_f32_32x32x16_f16(pa2, PK(l2, h2_), od, 0, 0, 0);
    od = __builtin_amdgcn_mfma_f32_32x32x16_f16(pa3, PK(l3, h3), od, 0, 0, 0);
#undef PK
}
__device__ __forceinline__ void pv_d0(f32x16* o, int vb, h8 pa0, h8 pa1, h8 pa2, h8 pa3) {
    pv_one<0>(o[0], vb, pa0, pa1, pa2, pa3); pv_one<1>(o[1], vb, pa0, pa1, pa2, pa3); pv_one<2>(o[2], vb, pa0, pa1, pa2, pa3); pv_one<3>(o[3], vb, pa0, pa1, pa2, pa3);
}
template <bool MASK>
__device__ __forceinline__ void attn_unit(const Unit& u, char* lds, const int wave0) {
    int tid = tid_of(wave0); asm volatile("" : "+v"(tid));
    const int wid = tid >> 6, lane = tid & 63, r32 = lane & 31, hi = lane >> 5;
    char* V_lds = lds; char* K_lds = lds + 2 * SHM_V;
    float* ws = (float*)(lds + 2 * SHM_V + 2 * SHM_K) + wid * 64; float* li_l = ws; float* al_l = ws + 32;
    float m_reg = u.has_sink ? u.sink * (1.0f / SCALE) : -1e30f, l_reg = u.has_sink ? 1.0f : 0.0f; f32x16 o[4] = {}; h8 qr[8];
    const f16* Qw = u.Q + (long)(wid * QBLK + r32) * LDQ + hi * 8;
#pragma unroll
    for (int d0 = 0; d0 < 8; ++d0) qr[d0] = *reinterpret_cast<const h8*>(Qw + d0 * 16);
    const int sr = tid >> 4, sc = (tid & 15) * 8, vst0 = v_st(sr, sc), vst1 = v_st(32 + sr, sc);
    const int vb0 = (int)(uintptr_t)V_lds + v_rd_base(lane);
    struct { h8 vs0, vs1, ks0, ks1; } sr_[2];
    const int qposw = u.qpos0 + wid * QBLK + r32;
#define TILEK(j) ((j) < 4 ? u.Kc + (long)(j) * KVBLK * LDK : u.Kl + (long)((j) - 4) * KVBLK * LDK)
#define TILEV(j) ((j) < 4 ? u.Vc + (long)(j) * KVBLK * LDK : u.Vl + (long)((j) - 4) * KVBLK * LDK)
#define SLOAD(i, j) do { const f16* kp_ = TILEK(j); const f16* vp_ = TILEV(j); sr_[i].vs0 = *(const h8*)(vp_ + (long)sr * LDK + sc); sr_[i].vs1 = *(const h8*)(vp_ + (long)(32 + sr) * LDK + sc); \
    sr_[i].ks0 = *(const h8*)(kp_ + (long)sr * LDK + sc); sr_[i].ks1 = *(const h8*)(kp_ + (long)(32 + sr) * LDK + sc); } while (0)
#define SWRITE(b, i) do { *(h8*)(V_lds + (b) * SHM_V + vst0) = sr_[i].vs0;          \
    *(h8*)(V_lds + (b) * SHM_V + vst1) = sr_[i].vs1; const int kc = sc * 2;               \
    *(h8*)(K_lds + (b) * SHM_K + KSWZ(sr, kc)) = sr_[i].ks0;                       \
    *(h8*)(K_lds + (b) * SHM_K + KSWZ(32 + sr, kc)) = sr_[i].ks1; } while (0)
#define SWAIT() asm volatile("s_waitcnt vmcnt(4)" ::: "memory")
#define RESC(a) do { if (__any((a) < 1.f)) { if (hi == 0) al_l[r32] = (a); asm volatile("s_waitcnt lgkmcnt(0)" ::: "memory"); \
    _Pragma("unroll") for (int d = 0; d < 4; ++d) _Pragma("unroll") for (int r = 0; r < 16; ++r) o[d][r] *= al_l[crow(r, hi)]; } } while (0)
#define DQ(j) (qposw - (u.kpos0 + ((j) - 4) * KVBLK) - 4 * hi)
    f32x16 pA0, pA1, pB0, pB1; float mnA, mnB, alA, alB; h8 pa0, pa1, pa2, pa3; const int NT = u.NT;
    constexpr int SE = 0, SO = 1;
    SLOAD(SE, 0); asm volatile("s_waitcnt vmcnt(0)" ::: "memory"); SWRITE(0, SE); __syncthreads();
    qkt(pA0, pA1, K_lds, qr, r32, hi); partialSM<MASK>(pA0, pA1, m_reg, mnA, alA, 0, false);
    SLOAD(SO, 1); if (2 < NT) SLOAD(SE, 2);
    SWAIT(); SWRITE(1, SO); __syncthreads();
    for (int j = 1; j + 1 < NT; j += 2) {
        SBAR(); qkt(pB0, pB1, K_lds + SHM_K, qr, r32, hi);
        finishSM(pA0, pA1, alA, l_reg, pa0, pa1, pa2, pa3); SBAR();
        SLOAD(SO, j + 2); SBAR();
        pv_d0(o, vb0, pa0, pa1, pa2, pa3); partialSM<MASK>(pB0, pB1, m_reg, mnB, alB, DQ(j), j >= 4);
        __syncthreads(); SWAIT(); SWRITE(0, SE);
        RESC(alB); __syncthreads();
        SBAR(); qkt(pA0, pA1, K_lds, qr, r32, hi);
        finishSM(pB0, pB1, alB, l_reg, pa0, pa1, pa2, pa3); SBAR();
        if (j + 3 < NT) SLOAD(SE, j + 3); SBAR();
        pv_d0(o, vb0 + (int)SHM_V, pa0, pa1, pa2, pa3); partialSM<MASK>(pA0, pA1, m_reg, mnA, alA, DQ(j + 1), j + 1 >= 4);
        __syncthreads(); SWAIT(); SWRITE(1, SO);
        RESC(alA); __syncthreads();
    }
    SBAR(); qkt(pB0, pB1, K_lds + SHM_K, qr, r32, hi);
    finishSM(pA0, pA1, alA, l_reg, pa0, pa1, pa2, pa3); SBAR();
    pv_d0(o, vb0, pa0, pa1, pa2, pa3); partialSM<MASK>(pB0, pB1, m_reg, mnB, alB, DQ(NT - 1), NT - 1 >= 4);
    __syncthreads(); RESC(alB);
    finishSM(pB0, pB1, alB, l_reg, pa0, pa1, pa2, pa3); SBAR();
    pv_d0(o, vb0 + (int)SHM_V, pa0, pa1, pa2, pa3);
    if (hi == 0) li_l[r32] = l_reg; asm volatile("s_waitcnt lgkmcnt(0)" ::: "memory");
    float rli[16];
#pragma unroll
    for (int r = 0; r < 16; ++r) rli[r] = __builtin_amdgcn_rcpf(li_l[crow(r, hi)]);
    f16* Ow = u.O + (long)(wid * QBLK) * LDO;
#pragma unroll
    for (int r = 0; r < 16; ++r) { const int orow = crow(r, hi);
#pragma unroll
        for (int d0 = 0; d0 < 4; ++d0) Ow[(long)orow * LDO + d0 * 32 + r32] = (f16)(o[d0][r] * rli[r]); }
    __syncthreads();
#undef TILEK
#undef TILEV
#undef SLOAD
#undef SWRITE
#undef SWAIT
#undef RESC
#undef DQ
}
}

__device__ __forceinline__ int chunk_row0(int cidx) { const int b = cidx / 34, cid = cidx - b * 34; return cid < 2 ? NLAT + b * CTXL + cid * 128 : b * SEQ + (cid - 2) * 128; }
constexpr int RS = 136;
template <int NOUT>
__device__ __forceinline__ void load_transposed(const f16* src, LAS f16* T0, LAS f16* T1, float lg0, float lg1, int tid) {
#pragma unroll
    for (int it = 0; it < 4; ++it) { const int idx = tid + it * 512, g = idx >> 7, t = idx & 127;
        const h8 x = *(const h8*)(src + (size_t)t * INW + g * 8);
        if (NOUT == 1) {
#pragma unroll
            for (int i = 0; i < 8; ++i) T0[(g * 8 + i) * RS + t] = x[i];
        } else {
            const float wf = __builtin_amdgcn_exp2f(lg0 * (float)(127 - t)), wb = __builtin_amdgcn_exp2f(lg1 * (float)t);
#pragma unroll
            for (int i = 0; i < 8; ++i) { T0[(g * 8 + i) * RS + t] = (f16)((float)x[i] * wf); T1[(g * 8 + i) * RS + t] = (f16)((float)x[i] * wb); }
        } }
}
__device__ __forceinline__ void load_rows(const f16* src, size_t ld, LAS f16* T, int tid) {
#pragma unroll
    for (int it = 0; it < 4; ++it) { const int idx = tid + it * 512, r = idx >> 4, c = (idx & 15) * 8;
        *(LAS h8*)(T + r * RS + c) = *(const h8*)(src + (size_t)r * ld + c); }
}
__device__ __forceinline__ void ret_c1_unit(const Args& a, int l, int cidx, int h, LAS unsigned char* lds, const int wave0) {
    int tid = tid_of(wave0); asm volatile("" : "+v"(tid));
    const int lane = tid & 63, wave = __builtin_amdgcn_readfirstlane(tid >> 6);
    const f16* P = (const f16*)(a.ws + WS_P);
    float* UT = (float*)(a.ws + WS_UT);
    LAS f16* VT = (LAS f16*)lds; LAS f16* KTf = VT + 128 * RS; LAS f16* KTb = KTf + 128 * RS;
    const float lgf = -__expf(a.ret_decay[(l * 2 + 0) * 8 + h]) * 1.4426950408889634f, lgb = -__expf(a.ret_decay[(l * 2 + 1) * 8 + h]) * 1.4426950408889634f;
    const int row0 = chunk_row0(cidx);
    load_transposed<1>(P + (size_t)row0 * INW + VR_OFF + h * HD, VT, VT, 0.f, 0.f, tid);
    load_transposed<2>(P + (size_t)row0 * INW + KR_OFF + h * HD, KTf, KTb, lgf, lgb, tid);
    __syncthreads();
    const int fr = lane & 15, fq = lane >> 4;
    f32x4 af[8], ab[8];
#pragma unroll
    for (int n = 0; n < 8; ++n) { af[n] = (f32x4){0.f, 0.f, 0.f, 0.f}; ab[n] = af[n]; }
#pragma unroll
    for (int ks = 0; ks < 4; ++ks) {
        const h8 A = *(const LAS h8*)(VT + (16 * wave + fr) * RS + 32 * ks + 8 * fq);
#pragma unroll
        for (int n = 0; n < 8; ++n) {
            const h8 Bf = *(const LAS h8*)(KTf + (16 * n + fr) * RS + 32 * ks + 8 * fq);
            const h8 Bb = *(const LAS h8*)(KTb + (16 * n + fr) * RS + 32 * ks + 8 * fq);
            af[n] = __builtin_amdgcn_mfma_f32_16x16x32_f16(Bf, A, af[n], 0, 0, 0);
            ab[n] = __builtin_amdgcn_mfma_f32_16x16x32_f16(Bb, A, ab[n], 0, 0, 0);
        }
    }
    float* uf = UT + ((size_t)(cidx * 8 + h) * 2 + 0) * 16384 + (16 * wave + fr) * 128 + 4 * fq; float* ub = uf + 16384;
#pragma unroll
    for (int n = 0; n < 8; ++n) { *(f32x4*)(uf + 16 * n) = af[n]; *(f32x4*)(ub + 16 * n) = ab[n]; }
    __syncthreads();
}
__device__ __forceinline__ void ph_scan(const Args& a, int l, int tid) {
    const float* UT = (const float*)(a.ws + WS_UT); f16* ST = (f16*)(a.ws + WS_ST);
    for (int it = blockIdx.x * 512 + tid; it < NBATCH * 8 * 2 * 4096; it += gridDim.x * 512) {
        const int e4 = it & 4095, dir = (it >> 12) & 1, h = (it >> 13) & 7, b = it >> 16;
        const float decay = __expf(-__expf(a.ret_decay[(l * 2 + dir) * 8 + h]) * 128.0f);
        f32x4 s = {0.f, 0.f, 0.f, 0.f};
#pragma unroll 17
        for (int i = 0; i < 34; ++i) {
            const int cid = dir == 0 ? i : (i < 2 ? 1 - i : 35 - i);
            const size_t off = ((size_t)((b * 34 + cid) * 8 + h) * 2 + dir) * 16384 + (size_t)e4 * 4;
            const f32x4 uv = *(const f32x4*)(UT + off);
            *(u32x2*)(ST + off) = (u32x2){pkh(s[0], s[1]), pkh(s[2], s[3])};
            s = s * decay + uv;
        }
    }
}
__device__ __forceinline__ void ret_c3_unit(const Args& a, int l, int cidx, int h, LAS unsigned char* lds, const int wave0) {
    int tid = tid_of(wave0); asm volatile("" : "+v"(tid));
    const int lane = tid & 63, wave = __builtin_amdgcn_readfirstlane(tid >> 6);
    unsigned char* wsl = a.ws; asm volatile("" : "+s"(wsl));
    const f16* P = (const f16*)(wsl + WS_P);
    const f16* ST = (const f16*)(wsl + WS_ST);
    f16* Yc = (f16*)(wsl + WS_Y) + 2048;
    LAS f16* KS = (LAS f16*)lds; LAS f16* VT = KS + 128 * RS; LAS f16* ATT = VT + 128 * RS + wave * 16 * RS;
    const float lgf = -__expf(a.ret_decay[(l * 2 + 0) * 8 + h]) * 1.4426950408889634f, lgb = -__expf(a.ret_decay[(l * 2 + 1) * 8 + h]) * 1.4426950408889634f;
    const int row0 = chunk_row0(cidx);
    const int fr = lane & 15, fq = lane >> 4;
    const int pc = 16 * wave + fr;
    const f16* STf = ST + ((size_t)(cidx * 8 + h) * 2 + 0) * 16384; const f16* STb = STf + 16384;
    h8 kr[4], vr[4], sf[4], sb[4], qf[4]; h4 grv[8]; f32x4 gnv[8];
#pragma unroll
    for (int it = 0; it < 4; ++it) { const int idx = tid + it * 512, r = idx >> 4, c = (idx & 15) * 8, g = idx >> 7, t = idx & 127;
        kr[it] = *(const h8*)(P + (size_t)(row0 + r) * INW + KR_OFF + h * HD + c);
        vr[it] = *(const h8*)(P + (size_t)(row0 + t) * INW + VR_OFF + h * HD + g * 8); }
#pragma unroll
    for (int ks = 0; ks < 4; ++ks) qf[ks] = *(const h8*)(P + (size_t)(row0 + pc) * INW + QR_OFF + h * HD + 32 * ks + 8 * fq);
#pragma unroll
    for (int it = 0; it < 4; ++it) { const int idx = tid + it * 512, r = idx >> 4, c = (idx & 15) * 8; sf[it] = *(const h8*)(STf + r * 128 + c); }
    const float* gn = a.ret_gn_g + l * 1024 + h * HD;
#pragma unroll
    for (int it = 0; it < 4; ++it) { const int idx = tid + it * 512, r = idx >> 4, c = (idx & 15) * 8, g = idx >> 7, t = idx & 127;
        *(LAS h8*)(KS + r * RS + c) = kr[it];
#pragma unroll
        for (int i = 0; i < 8; ++i) VT[(g * 8 + i) * RS + t] = vr[it][i]; }
    __syncthreads();
#pragma unroll
    for (int it = 0; it < 4; ++it) { const int idx = tid + it * 512, r = idx >> 4, c = (idx & 15) * 8; sb[it] = *(const h8*)(STb + r * 128 + c); }
#pragma unroll
    for (int n = 0; n < 8; ++n) grv[n] = *(const h4*)(P + (size_t)(row0 + pc) * INW + GR_OFF + h * HD + 16 * n + 4 * fq);
    f32x4 acc[8];
#pragma unroll
    for (int n = 0; n < 8; ++n) acc[n] = (f32x4){0.f, 0.f, 0.f, 0.f};
#pragma unroll
    for (int ks = 0; ks < 4; ++ks)
#pragma unroll
        for (int n = 0; n < 8; ++n) acc[n] = __builtin_amdgcn_mfma_f32_16x16x32_f16(*(const LAS h8*)(KS + (16 * n + fr) * RS + 32 * ks + 8 * fq), qf[ks], acc[n], 0, 0, 0);
#pragma unroll
    for (int n = 0; n < 8; ++n) { h4 w;
#pragma unroll
        for (int r = 0; r < 4; ++r) { const int m = 16 * n + 4 * fq + r, dl = pc - m;
            const float wgt = dl >= 0 ? __builtin_amdgcn_exp2f(lgf * (float)dl) : __builtin_amdgcn_exp2f(lgb * (float)(-dl));
            w[r] = (f16)(acc[n][r] * wgt); }
        *(LAS h4*)(ATT + fr * RS + 16 * n + 4 * fq) = w; }
    __syncthreads();
#pragma unroll
    for (int it = 0; it < 4; ++it) { const int idx = tid + it * 512, r = idx >> 4, c = (idx & 15) * 8; *(LAS h8*)(KS + r * RS + c) = sf[it]; }
    f32x4 o[8];
#pragma unroll
    for (int n = 0; n < 8; ++n) o[n] = (f32x4){0.f, 0.f, 0.f, 0.f};
#pragma unroll
    for (int ks = 0; ks < 4; ++ks) { const h8 B = *(const LAS h8*)(ATT + fr * RS + 32 * ks + 8 * fq);
#pragma unroll
        for (int n = 0; n < 8; ++n) o[n] = __builtin_amdgcn_mfma_f32_16x16x32_f16(*(const LAS h8*)(VT + (16 * n + fr) * RS + 32 * ks + 8 * fq), B, o[n], 0, 0, 0); }
    __syncthreads();
#pragma unroll
    for (int it = 0; it < 4; ++it) { const int idx = tid + it * 512, r = idx >> 4, c = (idx & 15) * 8; *(LAS h8*)(VT + r * RS + c) = sb[it]; }
#pragma unroll
    for (int n = 0; n < 8; ++n) acc[n] = (f32x4){0.f, 0.f, 0.f, 0.f};
#pragma unroll
    for (int ks = 0; ks < 4; ++ks)
#pragma unroll
        for (int n = 0; n < 8; ++n) acc[n] = __builtin_amdgcn_mfma_f32_16x16x32_f16(*(const LAS h8*)(KS + (16 * n + fr) * RS + 32 * ks + 8 * fq), qf[ks], acc[n], 0, 0, 0);
    { const float dq = __builtin_amdgcn_exp2f(lgf * (float)(pc + 1));
#pragma unroll
      for (int n = 0; n < 8; ++n) o[n] += dq * acc[n]; }
    __syncthreads();
#pragma unroll
    for (int n = 0; n < 8; ++n) gnv[n] = *(const f32x4*)(gn + 16 * n + 4 * fq);
#pragma unroll
    for (int n = 0; n < 8; ++n) acc[n] = (f32x4){0.f, 0.f, 0.f, 0.f};
#pragma unroll
    for (int ks = 0; ks < 4; ++ks)
#pragma unroll
        for (int n = 0; n < 8; ++n) acc[n] = __builtin_amdgcn_mfma_f32_16x16x32_f16(*(const LAS h8*)(VT + (16 * n + fr) * RS + 32 * ks + 8 * fq), qf[ks], acc[n], 0, 0, 0);
    { const float dq = __builtin_amdgcn_exp2f(lgb * (float)(128 - pc));
#pragma unroll
      for (int n = 0; n < 8; ++n) o[n] += dq * acc[n]; }
    float s = 0.f;
#pragma unroll
    for (int n = 0; n < 8; ++n) s += (o[n][0] + o[n][1]) + (o[n][2] + o[n][3]);
    s += __shfl_xor(s, 16); s += __shfl_xor(s, 32);
    const float mean = s * (1.0f / 128.0f); float q = 0.f;
#pragma unroll
    for (int n = 0; n < 8; ++n) { const f32x4 d = o[n] - mean; q += (d[0] * d[0] + d[1] * d[1]) + (d[2] * d[2] + d[3] * d[3]); }
    q += __shfl_xor(q, 16); q += __shfl_xor(q, 32);
    const float rstd = 1.0f / sqrtf(q * (1.0f / 128.0f) + GN_EPS);
    f16* yrow = Yc + (size_t)(row0 + pc) * 3072 + h * HD + 4 * fq;
#pragma unroll
    for (int n = 0; n < 8; ++n) { h4 w;
#pragma unroll
        for (int r = 0; r < 4; ++r) { const float gr = (float)grv[n][r]; w[r] = (f16)(gr * sigmoidf_(gr) * ((o[n][r] - mean) * rstd * gnv[n][r])); }
        *(h4*)(yrow + 16 * n) = w; }
    __syncthreads();
}

constexpr int N_PHASES = 26;
__global__ void __launch_bounds__(512, 2) mixer_fwd(Args a) {
    extern __shared__ __attribute__((aligned(16))) unsigned char lds_raw[];
    LAS unsigned char* lds = (LAS unsigned char*)lds_raw;
    const int tid = threadIdx.x, lane = tid & 63, wave = __builtin_amdgcn_readfirstlane(tid >> 6);
    const int wave0 = wave;
    const int G = gridDim.x;
    volatile LAS unsigned* MISC = (volatile LAS unsigned*)(lds + MISC_OFF);
    for (int u = tid; u < (LDS_BYTES - RING_BYTES) / 4; u += 512) ((LAS unsigned*)(lds + RING_BYTES))[u] = 0u;
    __syncthreads();
    unsigned* ctl = (unsigned*)(a.ws + WS_CTL);
    XcdBarrier bar; bar.bar = ctl + CW_BAR; bar.x = 0; bar.st = nullptr;
    if (!MK_PER_PHASE) bar = xcd_barrier_post(ctl + CW_BAR, MISC + 8, tid);
    const int lo = a.ph_lo, hi = a.ph_hi;
#ifndef PH_MASK
#define PH_MASK 0xFFFFFFFFu
#endif
#define PH_ON(b) (((PH_MASK) >> (b)) & 1u)
#ifndef RPT_MASK
#define RPT_MASK 0u
#endif
#define NREP(b) ((((RPT_MASK) >> (b)) & 1u) ? 2 : 1)
#define REPBAR(b, rep) do { if (NREP(b) == 2 && (rep) == 0) xcd_barrier(bar, wave0); } while (0)
#define IN(k) (lo <= (k) && (k) < hi)
#define SEAM(k) do { if (IN(k)) { if ((k) >= 2) bg_convert(a, lds, MISC, (k), G, wave0); if (IN((k) + 1)) xcd_barrier(bar, wave0); } } while (0)
#define TL() int tid = tid_of(wave0); asm volatile("" : "+v"(tid)); const int lane = tid & 63, wave = __builtin_amdgcn_readfirstlane(tid >> 6); (void)lane; (void)wave;
#define WSP() unsigned char* ws_ = a.ws; asm volatile("" : "+s"(ws_)); \
    float* MOD = (float*)(ws_ + WS_MOD); f16* H = (f16*)(ws_ + WS_H); f16* P = (f16*)(ws_ + WS_P); f16* Y = (f16*)(ws_ + WS_Y); f16* MH = (f16*)(ws_ + WS_MH); \
    f16* Z = (f16*)(ws_ + WS_Z); f16* LAT = (f16*)(ws_ + WS_LAT); f16* ACT = (f16*)(ws_ + WS_ACT); float* slab = (float*)(ws_ + WS_SLAB); unsigned* ctl_ = (unsigned*)(ws_ + WS_CTL); \
    const float* modl = MOD + (size_t)l * 3 * NMOD; (void)H; (void)P; (void)Y; (void)MH; (void)Z; (void)LAT; (void)ACT; (void)slab; (void)ctl_; (void)modl;
    if (PH_ON(0) && IN(0)) _Pragma("unroll") for (int rep_ = 0; rep_ < NREP(0); ++rep_) { {
        if (blockIdx.x == 0) rope_table((f32x2*)(a.ws + WS_ROPE), tid);
        if (G >= 256) {
            if ((int)blockIdx.x < 128) ph_modgemv(a, lds, tid, lane, wave, (int)blockIdx.x, 128, 128);
            else ph_convert0(a, lds, lane, wave, (int)blockIdx.x - 128, G - 128);
        } else { ph_modgemv(a, lds, tid, lane, wave, (int)blockIdx.x, 256, G); ph_convert0(a, lds, lane, wave, (int)blockIdx.x, G); }
    } REPBAR(0, rep_); }
    SEAM(0);
    if (PH_ON(1) && IN(1)) _Pragma("unroll") for (int rep_ = 0; rep_ < NREP(1); ++rep_) { { ph_modulate0(a, lane, wave); } REPBAR(1, rep_); }
    SEAM(1);

#pragma unroll 1
    for (int l = 0; l < 2; ++l) {
        const int pb = 2 + 12 * l;
        const bool last = (l == 1);
        const int Mrows = last ? NLAT : MTOT;
        if (PH_ON(2) && IN(pb + 0)) _Pragma("unroll") for (int rep_ = 0; rep_ < NREP(2); ++rep_) { { WSP();
            pg8::Gemm g{H, (const f16*)(a.ws + WS_WIN + l * SZ_WIN), MTOT, INW, DM}; pg8::SKOrder S; S.init(last ? NLAT : MTOT, INW, DM, G, (int)blockIdx.x, last ? 24 : 0);
            pg8::EpiIn E{P, (const f32x2*)(ws_ + WS_ROPE), a.q_norm_g + l * HD, a.k_norm_g + l * HD, (LAS float*)(lds + RING_BYTES + 1024), (f16*)(ws_ + WS_GLT), a.b_gate + l * 3 * DM};
            pg8::gemm_phase<pg8::EpiIn, pg8::SKOrder>(lds, g, S, E, pg8::SKCtx{slab, ctl_ + CW_SK + (l * 5 + 0) * SK_BANK}, wave0);
        } REPBAR(2, rep_); }
        do { if (IN(pb + 0)) { bg_convert(a, lds, MISC, pb + 0, G, wave0); if (IN(pb + 1) || IN(pb + 2)) xcd_barrier(bar, wave0); } } while (0);
        if (PH_ON(4) && IN(pb + 2)) _Pragma("unroll") for (int rep_ = 0; rep_ < NREP(4); ++rep_) { { WSP();
            for (int ui = blockIdx.x; ui < 256; ui += G) {
                const int b = ui >> 7, h = (ui >> 4) & 7, qb = ui & 15, g = h >> 2;
                const int kl0 = qb == 0 ? 0 : qb * 256 - 128, kend = qb == 15 ? SEQ : qb * 256 + 384;
                att::Unit u;
                u.Q = P + (size_t)(b * SEQ + qb * 256) * INW + QA_OFF + h * HD;
                u.Kc = P + (size_t)(NLAT + b * CTXL) * INW + KA_OFF + g * HD; u.Vc = P + (size_t)(NLAT + b * CTXL) * INW + VA_OFF + g * HD;
                u.Kl = P + (size_t)(b * SEQ + kl0) * INW + KA_OFF + g * HD; u.Vl = P + (size_t)(b * SEQ + kl0) * INW + VA_OFF + g * HD;
                u.O = Y + (size_t)(b * SEQ + qb * 256) * 3072 + h * HD; u.NT = 4 + (kend - kl0) / 64; u.qpos0 = qb * 256; u.kpos0 = kl0;
                u.sink = a.attn_sink[l * 8 + h]; u.has_sink = 1;
                att::attn_unit<true>(u, (char*)lds_raw, wave0);
            }
            if (!last) {
                for (int v = blockIdx.x; v < 32; v += G) {
                    const int isB = v >> 4, b = (v >> 3) & 1, h = v & 7, g = h >> 2;
                    att::Unit u;
                    const size_t r0 = (size_t)(NLAT + b * CTXL);
                    u.Q = P + r0 * INW + (isB ? QB_OFF : QA_OFF) + h * HD;
                    u.Kc = P + r0 * INW + (isB ? KB_OFF : KA_OFF) + g * HD; u.Vc = P + r0 * INW + (isB ? VB_OFF : VA_OFF) + g * HD;
                    u.Kl = u.Kc; u.Vl = u.Vc; u.O = Y + r0 * 3072 + (isB ? 1024 : 0) + h * HD; u.NT = 4; u.qpos0 = 0; u.kpos0 = 0;
                    u.sink = a.attn_sink[l * 8 + h]; u.has_sink = isB ? 0 : 1;
                    att::attn_unit<false>(u, (char*)lds_raw, wave0);
                }
            }
            for (int v = G - 1 - (int)blockIdx.x; v < NCHUNK * 8; v += G) ret_c1_unit(a, l, v >> 3, v & 7, lds, wave0);
        } REPBAR(4, rep_); }
        SEAM(pb + 2);
        if (PH_ON(5) && IN(pb + 3)) _Pragma("unroll") for (int rep_ = 0; rep_ < NREP(5); ++rep_) { { TL(); ph_scan(a, l, tid); } REPBAR(5, rep_); }
        SEAM(pb + 3);
        if (PH_ON(6) && IN(pb + 4)) _Pragma("unroll") for (int rep_ = 0; rep_ < NREP(6); ++rep_) { { WSP();
            for (int ui = blockIdx.x; ui < 256; ui += G) {
                const int b = ui >> 7, h = (ui >> 4) & 7, qb = ui & 15, g = h >> 2;
                att::Unit u;
                u.Q = P + (size_t)(b * SEQ + qb * 256) * INW + QB_OFF + h * HD;
                u.Kc = P + (size_t)(NLAT + b * CTXL) * INW + KB_OFF + g * HD; u.Vc = P + (size_t)(NLAT + b * CTXL) * INW + VB_OFF + g * HD;
                u.Kl = P + (size_t)(b * SEQ) * INW + KB_OFF + g * HD; u.Vl = P + (size_t)(b * SEQ) * INW + VB_OFF + g * HD;
                u.O = Y + (size_t)(b * SEQ + qb * 256) * 3072 + 1024 + h * HD; u.NT = 4 + SEQ / 64; u.qpos0 = 0; u.kpos0 = 0; u.sink = 0.f; u.has_sink = 0;
                att::attn_unit<false>(u, (char*)lds_raw, wave0);
            }
            for (int v = G - 1 - (int)blockIdx.x; v < NCHUNK * 8; v += G) {
                if (last && (v >> 3) % 34 < 2) continue;
                ret_c3_unit(a, l, v >> 3, v & 7, lds, wave0);
            }
        } REPBAR(6, rep_); }
        SEAM(pb + 4);
        if (PH_ON(7) && IN(pb + 5)) _Pragma("unroll") for (int rep_ = 0; rep_ < NREP(7); ++rep_) { { WSP();
            pg8::Gemm g{Y, (const f16*)(a.ws + WS_WBR + l * SZ_WBR), Mrows, DM, 3072}; pg8::SKOrder S; S.init(Mrows, DM, 3072, G, (int)blockIdx.x);
            pg8::EpiGateK E{(const f16*)(ws_ + WS_GLT), MH};
            pg8::gemm_phase<pg8::EpiGateK, pg8::SKOrder>(lds, g, S, E, pg8::SKCtx{slab, ctl_ + CW_SK + (l * 5 + 1) * SK_BANK}, wave0);
        } REPBAR(7, rep_); }
        SEAM(pb + 5);
        if (PH_ON(8) && IN(pb + 6)) _Pragma("unroll") for (int rep_ = 0; rep_ < NREP(8); ++rep_) { { WSP();
            pg8::Gemm g{MH, (const f16*)(a.ws + WS_WO + l * SZ_WO), Mrows, DM, DM}; pg8::SKOrder S; S.init(Mrows, DM, DM, G, (int)blockIdx.x, 0, 1);
            pg8::EpiResLN E{l == 0 ? (const void*)a.x : (const void*)LAT, l == 0 ? (const void*)a.ctx : (const void*)(LAT + (size_t)NLAT * DM), modl + 2 * DM, l == 0 ? 0 : 1,
                            a.ln1_g + l * DM, a.ln1_b + l * DM, modl + 3 * DM, modl + 4 * DM, LAT, H, a.out, 0,
                            (unsigned long long*)(slab + (size_t)4 * 1024 * 1024), ctl_ + CW_LN + (l * 2 + 0) * LN_BANK, lds + RING_BYTES + 1024};
            pg8::gemm_phase<pg8::EpiResLN, pg8::SKOrder>(lds, g, S, E, pg8::SKCtx{slab, ctl_ + CW_SK + (l * 5 + 2) * SK_BANK}, wave0);
        } REPBAR(8, rep_); }
        do { if (IN(pb + 6)) { bg_convert(a, lds, MISC, pb + 6, G, wave0); if (IN(pb + 7) || IN(pb + 8)) xcd_barrier(bar, wave0); } } while (0);
        if (PH_ON(10) && IN(pb + 8)) _Pragma("unroll") for (int rep_ = 0; rep_ < NREP(10); ++rep_) { { WSP();
            pg8::Gemm g{H, (const f16*)(a.ws + WS_WUP + l * SZ_WUP), Mrows, 2 * DFF, DM}; pg8::SKOrder S; S.init(Mrows, 2 * DFF, DM, G, (int)blockIdx.x);
            pg8::EpiConv E{a.conv_w + (size_t)l * 3 * DFF, a.conv_b + (size_t)l * DFF, ACT, slab, slab + (size_t)34 * 2 * DFF, slab + (size_t)2 * 34 * 2 * DFF, (LAS float*)(lds + RING_BYTES + 1024)};
            pg8::gemm_phase<pg8::EpiConv, pg8::SKOrder>(lds, g, S, E, pg8::SKCtx{slab, ctl_ + CW_SK + (l * 5 + 3) * SK_BANK}, wave0);
        } REPBAR(10, rep_); }
        SEAM(pb + 8);
        if (PH_ON(11) && IN(pb + 9)) _Pragma("unroll") for (int rep_ = 0; rep_ < NREP(11); ++rep_) { { TL(); ph_convfix(a, l, Mrows, tid); } REPBAR(11, rep_); }
        SEAM(pb + 9);
        if (PH_ON(12) && IN(pb + 10)) _Pragma("unroll") for (int rep_ = 0; rep_ < NREP(12); ++rep_) { { WSP();
            const float* modn = MOD + (size_t)(l + 1) * 3 * NMOD;
            int Gs_ = G; asm volatile("" : "+s"(Gs_));
            const bool sk8 = SK8_DN && l == 0 && Gs_ == 256;
            pg8::Gemm g{ACT, (const f16*)(a.ws + WS_WDN + l * SZ_WDN), Mrows, DM, DFF}; pg8::SKOrder S; S.init(sk8 ? NLAT : Mrows, DM, DFF, G, (int)blockIdx.x, 0, 1);
            pg8::EpiResLN E{(const void*)LAT, (const void*)(LAT + (size_t)NLAT * DM), modl + 5 * DM, 1,
                            a.ln2_g + l * DM, a.ln2_b + l * DM, last ? modl : modn, last ? modl : modn + DM, LAT, H, a.out, last ? 1 : 0,
                            (unsigned long long*)(slab + (size_t)4 * 1024 * 1024), ctl_ + CW_LN + (l * 2 + 1) * LN_BANK, lds + RING_BYTES + 1024};
            pg8::gemm_phase<pg8::EpiResLN, pg8::SKOrder>(lds, g, S, E, pg8::SKCtx{slab, ctl_ + CW_SK + (l * 5 + 4) * SK_BANK}, wave0);
            if (sk8) { pg8::SK8Order S8; S8.init(DFF, (int)blockIdx.x);
                pg8::gemm_phase<pg8::EpiResLN, pg8::SK8Order, true, true, true>(lds, g, S8, E, pg8::SKCtx{(float*)(ws_ + WS_MF), ctl_ + CW_SK + (l * 5 + 4) * SK_BANK}, wave0); }
        } REPBAR(12, rep_); }
        if (!last) do { if (IN(pb + 10)) { bg_convert(a, lds, MISC, pb + 10, G, wave0); if (IN(pb + 11) || IN(pb + 12)) xcd_barrier(bar, wave0); } } while (0);
    }
#undef IN
#undef SEAM
}

extern "C" void kernel_launch(void* const* d_in, const int* in_sizes, int n_in, void* d_out, int out_size, void* d_ws, size_t ws_size, hipStream_t stream) {
    static int grid = 0;
    if (grid == 0) {
        if (n_in != 23 || out_size != NLAT * DM || ws_size < WS_END) { fprintf(stderr, "kernel_launch: unexpected shapes (n_in %d out %d ws %zu, need %zu)\n", n_in, out_size, ws_size, (size_t)WS_END); grid = -1; return; }
        int dev = 0, cus = 0, per_cu = 0;
        if (hipGetDevice(&dev) != hipSuccess || hipDeviceGetAttribute(&cus, hipDeviceAttributeMultiprocessorCount, dev) != hipSuccess) { grid = -1; return; }
        if (hipFuncSetAttribute((const void*)mixer_fwd, hipFuncAttributeMaxDynamicSharedMemorySize, LDS_BYTES) != hipSuccess) { fprintf(stderr, "kernel_launch: hipFuncSetAttribute failed\n"); grid = -1; return; }
        if (hipOccupancyMaxActiveBlocksPerMultiprocessor(&per_cu, (const void*)mixer_fwd, 512, LDS_BYTES) != hipSuccess || per_cu < 1)
            fprintf(stderr, "kernel_launch: occupancy query reports %d workgroups per CU\n", per_cu);
        (void)hipGetLastError();
        grid = cus;
    }
    if (grid < 0) return;
    if (hipMemsetAsync((char*)d_ws + WS_CTL, 0, CTL_ZERO_BYTES, stream) != hipSuccess) return;
    Args a{};
    const float** ap = (const float**)&a;
    for (int i = 0; i < 23; ++i) ap[i] = (const float*)d_in[i];
    a.out = (float*)d_out; a.ws = (unsigned char*)d_ws; a.li = 0; a.pad = 0;
#if MK_PER_PHASE
    for (int p = 0; p < N_PHASES; ++p) { a.ph_lo = p; a.ph_hi = p + 1; hipLaunchKernelGGL(mixer_fwd, dim3(grid), dim3(512), LDS_BYTES, stream, a); }
#else
    a.ph_lo = 0; a.ph_hi = N_PHASES;
    hipLaunchKernelGGL(mixer_fwd, dim3(grid), dim3(512), LDS_BYTES, stream, a);
#endif
    const hipError_t le = hipPeekAtLastError();
    if (le != hipSuccess) fprintf(stderr, "kernel_launch: launch failed: %s\n", hipGetErrorName(le));
}
```

```cpp
#include <hip/hip_runtime.h>
#include <cstdio>
#include <cstdint>

#ifndef MK_PER_PHASE
#define MK_PER_PHASE 0
#endif
#ifndef XORDER
#define XORDER 1
#endif
#ifndef SK8_DN
#define SK8_DN 1
#endif
#ifndef SK8_WO
#define SK8_WO 0
#endif
#ifndef SK_ENABLE
#define SK_ENABLE 0
#endif

#define LAS __attribute__((address_space(3)))
#define GAS __attribute__((address_space(1)))
typedef _Float16 f16;
typedef _Float16 h8 __attribute__((ext_vector_type(8)));
typedef _Float16 h4 __attribute__((ext_vector_type(4)));
typedef _Float16 h2 __attribute__((ext_vector_type(2)));
typedef short s16x4 __attribute__((ext_vector_type(4)));
typedef float f32x2 __attribute__((ext_vector_type(2)));
typedef float f32x4 __attribute__((ext_vector_type(4)));
typedef float f32x16 __attribute__((ext_vector_type(16)));
typedef unsigned u32x2 __attribute__((ext_vector_type(2)));
typedef unsigned u32x4 __attribute__((ext_vector_type(4)));

constexpr int DM = 4096, NBATCH = 2, SEQ = 4096, CTXL = 256, NLAT = NBATCH * SEQ, NCTX = NBATCH * CTXL, MTOT = NLAT + NCTX;
constexpr int HD = 128, INW = 19456, DFF = 11008, NMOD = 6 * DM;
constexpr int QA_OFF = 0, KA_OFF = 1024, VA_OFF = 1280, QB_OFF = 1536, KB_OFF = 2560, VB_OFF = 2816, QR_OFF = 3072, KR_OFF = 4096, VR_OFF = 5120, GR_OFF = 6144, GL_OFF = 7168;
constexpr float LN_EPS = 1e-5f, RMS_EPS = 1e-6f, GN_EPS = 1e-5f;
constexpr float DN_ALPHA = 1.4142135623730951f;
constexpr float ATT_SCALE = 0.088388347648318440f;
constexpr int NCHUNK = 68;

constexpr size_t MiB = 1u << 20;
constexpr size_t WS_CTL = 0, CTL_ZERO_BYTES = 1 * MiB;
constexpr size_t WS_MOD = 1 * MiB;
constexpr size_t WS_ROPE = 2 * MiB;
constexpr size_t WS_WIN = 4 * MiB, SZ_WIN = 152 * MiB;
constexpr size_t WS_WBR = 308 * MiB, SZ_WBR = 24 * MiB;
constexpr size_t WS_WO = 356 * MiB, SZ_WO = 32 * MiB;
constexpr size_t WS_WUP = 420 * MiB, SZ_WUP = 172 * MiB;
constexpr size_t WS_WDN = 764 * MiB, SZ_WDN = 86 * MiB;
constexpr size_t WS_H = 936 * MiB;
constexpr size_t WS_P = 1004 * MiB;
constexpr size_t WS_Y = 1370 * MiB, SZ_Y1 = 17 * MiB;
constexpr size_t WS_MF = 1421 * MiB;
constexpr size_t WS_MH = 1557 * MiB;
constexpr size_t WS_Z = 1625 * MiB;
constexpr size_t WS_LAT = 1761 * MiB;
constexpr size_t WS_ACT = 1897 * MiB;
constexpr size_t WS_UT = 2080 * MiB;
constexpr size_t WS_ST = 2148 * MiB;
constexpr size_t WS_SLAB = 2182 * MiB;
constexpr size_t WS_GLT = 2246 * MiB;
constexpr size_t WS_END = 2450 * MiB;
static_assert(WS_WIN + 2 * SZ_WIN <= WS_WBR && WS_WBR + 2 * SZ_WBR <= WS_WO && WS_WO + 2 * SZ_WO <= WS_WUP && WS_WUP + 2 * SZ_WUP <= WS_WDN && WS_WDN + 2 * SZ_WDN <= WS_H, "ws map");
static_assert(WS_P + (size_t)MTOT * 22016 * 2 <= WS_Y && WS_ACT + (size_t)MTOT * DFF * 2 <= WS_UT, "ws map");
constexpr int CW_Q = 512, CW_QD = 1024;
constexpr int CW_BAR = 4096;
constexpr int CW_LN = 60000, LN_BANK = 64 * 34;
constexpr int CW_SK = 16384, SK_BANK = 4096;
static_assert((CW_SK + 10 * SK_BANK) * 4 <= (int)CTL_ZERO_BYTES && CW_SK + 10 * SK_BANK <= CW_LN && (CW_LN + 4 * LN_BANK) * 4 <= (int)CTL_ZERO_BYTES, "ctl");

constexpr int RING_BYTES = 131072, MISC_OFF = RING_BYTES + 320, LDS_BYTES = 147456;

__device__ __forceinline__ unsigned pkh(float lo, float hi) { h2 v = __builtin_convertvector((f32x2){lo, hi}, h2); return __builtin_bit_cast(unsigned, v); }
__device__ __forceinline__ float wave_sum(float v) {
#pragma unroll
    for (int o = 1; o < 64; o <<= 1) v += __shfl_xor(v, o);
    return v;
}
__device__ __forceinline__ float sigmoidf_(float x) { return __builtin_amdgcn_rcpf(1.0f + __expf(-x)); }
__device__ __forceinline__ int tid_of(int wave0) { return (wave0 << 6) | (int)__builtin_amdgcn_mbcnt_hi(~0u, __builtin_amdgcn_mbcnt_lo(~0u, 0u)); }
#define LDS_WAIT() asm volatile("s_waitcnt lgkmcnt(0)" ::: "memory")
#define VM_WAIT() asm volatile("s_waitcnt vmcnt(0)" ::: "memory")

struct Args {
    const float *x, *c, *ctx, *c_ctx, *w_mod, *b_mod, *w_in, *b_gate, *w_branch, *w_o, *attn_sink, *q_norm_g, *k_norm_g, *ret_decay, *ret_gn_g, *ln1_g, *ln1_b, *w_up, *conv_w, *conv_b, *w_down, *ln2_g, *ln2_b;
    float* out; unsigned char* ws; int ph_lo, ph_hi, li, pad;
};

namespace pg8 {
constexpr int BM = 256, BK = 64, HALF = 128, HTB = HALF * BK * 2, STAGE_BYTES = 8 * HTB, NXCD = 8, WGM = 4;
__host__ __device__ __forceinline__ int lds_byte(int r, int c) { const int st = (r >> 4) * 2 + (c >> 5), rr = r & 15, cc = c & 31, ob = rr * 64 + cc * 2; return st * 1024 + (ob ^ (((ob >> 9) & 1) << 5)); }
__host__ __device__ __forceinline__ void stage_rc(int b, int& R, int& C) { const int st = b / 1024, sb = b % 1024, swz = sb ^ (((sb >> 9) & 1) << 5); R = (st >> 1) * 16 + swz / 64; C = (st & 1) * 32 + (swz % 64) / 2; }
__host__ __device__ __forceinline__ int perm32(int rho) { const int n = rho >> 4, i = rho & 15; return 8 * (i >> 2) + 4 * n + (i & 3); }
struct Unit { int pm, pn, k0, nt, sl, ns, rid; };
struct Gemm { const f16* A; const f16* Bt; int M, N, K; };
struct SKCtx { float* slab; unsigned* cnt; };
struct SKOrder {
    int nM, nN, nwg, G, c, nfull, R, ns, npairs, nextra, lnord, sk8;
    __device__ __forceinline__ void init(int M, int N, int K, int G_, int c_, int nextra_ = 0, int lnord_ = 0, int sk8_ = 0) { lnord = lnord_; sk8 = sk8_; nM = M / BM; nN = N / BM; nwg = nM * nN; G = G_; asm volatile("" : "+s"(G)); c = c_; nextra = nextra_; nfull = (nwg / G) * G; R = nwg - nfull; npairs = K / 128;
        ns = 1; if (R > 0 && SK_ENABLE && nextra == 0) { ns = G / R; const int cap = npairs / 2; if (ns > cap) ns = cap; if (ns > 16) ns = 16; if (ns < 1) ns = 1; } }
    __device__ __forceinline__ bool next_x(int i, Unit& u) const {
        const int x = c & 7, w = c >> 3, nfullc = nN >> 3, remc = nN & 7;
        const int nrest = (nM - 32) * nN + nextra;
        const bool mainu = i < nfullc || (i == nfullc && (w >> 2) < remc);
        int r = 0;
        if (!mainu) { if (remc > 0) r = (i == nfullc) ? x * (4 * (8 - remc)) + (w - 4 * remc) : 32 * (8 - remc) + (i - nfullc - 1) * 256 + c; else r = (i - nfullc) * 256 + c; }
        const int t = (r >> 1) % 12;
        const int rpn = nextra > 0 ? (t < 2 ? 4 + t : (t < 4 ? 8 + t : 12 + t)) : (r >> 1);
        u.pm = mainu ? 4 * x + (w & 3) : 32 + (r & 1); u.pn = mainu ? 8 * i + (w >> 2) : rpn;
        if (lnord && mainu) { u.pm = 8 * (x >> 1) + 4 * i + (w & 3); u.pn = 8 * (x & 1) + (w >> 2); }
        u.k0 = 0; u.nt = 2 * npairs; u.sl = 0; u.ns = 1; u.rid = 0;
        return mainu || r < nrest;
    }
    __device__ __forceinline__ bool next(int i, Unit& u) const {
        if (XORDER && G == 256 && nM >= 32 && nM <= 34 && !SK_ENABLE) return next_x(i, u);
        const long L = (long)i * G + c;
        const bool ok = L < (long)(nwg + nextra);
        const bool ext = L >= nwg;
        int wgid = ok && !ext ? (int)L : 0;
        int sl = 0, nsl = 1, rid = 0, k0 = 0, ntl = 2 * npairs;
#if SK_ENABLE
        if (ok && !ext && L >= nfull && ns > 1) { const int j = (int)(L - nfull); const int r = j / ns; sl = j - r * ns; wgid = nfull + r; nsl = ns; rid = r;
            const int p0 = (int)((long)sl * npairs / ns), p1 = (int)((long)(sl + 1) * npairs / ns); k0 = p0 * 128; ntl = 2 * (p1 - p0); }
#endif
        { const int q = nwg / NXCD, r = nwg % NXCD, xcd = wgid % NXCD, off = wgid / NXCD; wgid = (xcd < r ? xcd * (q + 1) : r * (q + 1) + (xcd - r) * q) + off; }
        const int nig = WGM * nN, gid = wgid / nig, fm = gid * WGM, gsz = (nM - fm) < WGM ? (nM - fm) : WGM;
        int pm = fm + ((wgid % nig) % gsz), pn = (wgid % nig) / gsz;
        const int e = ext ? (int)(L - nwg) : 0, t = e % 12;
        if (ext) { pm = 32 + e / 12; pn = t < 2 ? 4 + t : (t < 4 ? 8 + t : 12 + t); }
        u.pm = pm; u.pn = pn; u.k0 = k0; u.nt = ntl; u.sl = sl; u.ns = nsl; u.rid = rid;
        return ok;
    }
};
struct SK8Order {
    int c, npairs;
    __device__ __forceinline__ void init(int K, int c_) { c = c_; npairs = K / 128; }
    __device__ __forceinline__ bool next(int i, Unit& u) const {
        const int rr = c >> 3, sl = c & 7, p0 = sl * npairs / 8, p1 = (sl + 1) * npairs / 8;
        u.pm = 32 + (rr & 1); u.pn = rr >> 1; u.k0 = p0 * 128; u.nt = 2 * (p1 - p0); u.sl = sl; u.ns = 8; u.rid = rr;
        return i == 0;
    }
};
struct EpiF16 {
    static constexpr bool PERM = true, HOOK = false, SK = false;
    f16* O; int ldc;
    __device__ __forceinline__ void pre(f32x4 (&)[2][2][4][2], const Unit&, int, int, int, int) const {}
    __device__ __forceinline__ void operator()(const f32x4 (&acc)[2][2][4][2], const Unit& u, int wr, int wc, int fr, int fq) const {
        const int row0 = u.pm * BM + wr * 64 + fr, col0 = u.pn * BM + wc * 32 + 8 * fq;
#pragma unroll
        for (int ai = 0; ai < 2; ++ai)
#pragma unroll
            for (int m = 0; m < 4; ++m) { f16* rowp = O + (size_t)(row0 + ai * HALF + m * 16) * ldc + col0;
#pragma unroll
                for (int bj = 0; bj < 2; ++bj) { const f32x4 v0 = acc[ai][bj][m][0], v1 = acc[ai][bj][m][1];
                    u32x4 w; w.x = pkh(v0[0], v0[1]); w.y = pkh(v0[2], v0[3]); w.z = pkh(v1[0], v1[1]); w.w = pkh(v1[2], v1[3]);
                    *(u32x4*)(rowp + bj * HALF) = w; } }
    }
};
struct EpiIn {
    static constexpr bool PERM = true, HOOK = false, SK = false;
    f16* O; const f32x2* rope; const float* qg; const float* kg; LAS float* red; f16* GLT; const float* bgate;
    __device__ __forceinline__ void pre(f32x4 (&)[2][2][4][2], const Unit&, int, int, int, int) const {}
    __device__ __forceinline__ void operator()(const f32x4 (&acc)[2][2][4][2], const Unit& u, int wr, int wc, int fr, int fq) const {
        const int pn = u.pn; const bool lat = u.pm < 32;
        if (pn >= 28) {
            const int gi = pn - 28, br = gi >> 4, pnn = gi & 15;
            int lo = fq * 16 + fr; asm volatile("" : "+v"(lo));
            f16* tp = GLT + ((size_t)((br * 34 + u.pm) * 16 + pnn) * 8 + (wr * 4 + wc)) * 8192 + lo * 8;
            const float* bp = bgate + gi * 256 + wc * 32 + 8 * (lo >> 4);
#pragma unroll
            for (int bj = 0; bj < 2; ++bj) { const f32x4 b0 = *(const f32x4*)(bp + bj * HALF), b1 = *(const f32x4*)(bp + bj * HALF + 4);
#pragma unroll
                for (int ai = 0; ai < 2; ++ai)
#pragma unroll
                    for (int m = 0; m < 4; ++m) { f32x4 v0 = acc[ai][bj][m][0] + b0, v1 = acc[ai][bj][m][1] + b1;
#pragma unroll
                        for (int j = 0; j < 4; ++j) { v0[j] = 1024.f * __builtin_amdgcn_rcpf(1.0f + __builtin_amdgcn_exp2f(fminf(fmaxf(v0[j], -20.f), 20.f) * -1.4426950408889634f));
                            v1[j] = 1024.f * __builtin_amdgcn_rcpf(1.0f + __builtin_amdgcn_exp2f(fminf(fmaxf(v1[j], -20.f), 20.f) * -1.4426950408889634f)); }
                        u32x4 w; w.x = pkh(v0[0], v0[1]); w.y = pkh(v0[2], v0[3]); w.z = pkh(v1[0], v1[1]); w.w = pkh(v1[2], v1[3]);
                        *(u32x4*)(tp + ((ai * 4 + m) * 2 + bj) * 512) = w; } }
            return;
        }
        int kind = 0;
        if (pn < 5) kind = 1; else if (pn >= 6 && pn < 10) kind = 2; else if (pn == 10) kind = 3; else if (pn >= 12 && pn < 16) kind = 1; else if (pn >= 16 && pn < 20) kind = 4;
        const int row0 = u.pm * BM + wr * 64 + fr, col0 = pn * BM + wc * 32 + 8 * fq;
        if (kind == 0 || (kind == 1 && !lat)) {
#pragma unroll
            for (int ai = 0; ai < 2; ++ai)
#pragma unroll
                for (int m = 0; m < 4; ++m) { f16* rowp = O + (size_t)(row0 + ai * HALF + m * 16) * INW + col0;
#pragma unroll
                    for (int bj = 0; bj < 2; ++bj) { const f32x4 v0 = acc[ai][bj][m][0], v1 = acc[ai][bj][m][1];
                        u32x4 w; w.x = pkh(v0[0], v0[1]); w.y = pkh(v0[2], v0[3]); w.z = pkh(v1[0], v1[1]); w.w = pkh(v1[2], v1[3]);
                        *(u32x4*)(rowp + bj * HALF) = w; } }
            return;
        }
        const bool rms = (kind == 2 || kind == 3);
        float rsv[2][2][4];
        if (rms) {
#pragma unroll
            for (int bj = 0; bj < 2; ++bj)
#pragma unroll
                for (int ai = 0; ai < 2; ++ai)
#pragma unroll
                    for (int m = 0; m < 4; ++m) { const f32x4 a0 = acc[ai][bj][m][0], a1 = acc[ai][bj][m][1];
                        float ss = (a0[0] * a0[0] + a0[1] * a0[1]) + (a0[2] * a0[2] + a0[3] * a0[3]) + (a1[0] * a1[0] + a1[1] * a1[1]) + (a1[2] * a1[2] + a1[3] * a1[3]);
                        ss += __shfl_xor(ss, 16); ss += __shfl_xor(ss, 32);
                        if (fq == 0) red[(bj * 256 + ai * HALF + wr * 64 + m * 16 + fr) * 4 + wc] = ss; }
            asm volatile("s_waitcnt lgkmcnt(0)" ::: "memory"); __builtin_amdgcn_s_barrier(); asm volatile("" ::: "memory");
#pragma unroll
            for (int bj = 0; bj < 2; ++bj)
#pragma unroll
                for (int ai = 0; ai < 2; ++ai)
#pragma unroll
                    for (int m = 0; m < 4; ++m) { const f32x4 t = *(const LAS f32x4*)(red + (bj * 256 + ai * HALF + wr * 64 + m * 16 + fr) * 4);
                        rsv[bj][ai][m] = 1.0f / sqrtf(((t[0] + t[1]) + (t[2] + t[3])) * (1.0f / HD) + RMS_EPS); }
        }
        const int dbase = 64 * (wc >> 1) + 16 * (wc & 1) + 4 * fq;
        f32x4 g0 = {1.f, 1.f, 1.f, 1.f}, g1 = g0;
        if (rms) { const float* g = (kind == 2 ? qg : kg) + dbase; g0 = *(const f32x4*)g; g1 = *(const f32x4*)(g + 32); }
        const float ksc = kind == 4 ? ATT_SCALE : 1.0f;
#pragma unroll
        for (int ai = 0; ai < 2; ++ai)
#pragma unroll
            for (int m = 0; m < 4; ++m) { const int row = row0 + ai * HALF + m * 16; const int t = row & (SEQ - 1); const int pos = (wc >> 1) ? (t & 63) : (t >> 6);
                f32x4 cv = {1.f, 1.f, 1.f, 1.f}, sv = {0.f, 0.f, 0.f, 0.f};
                if (lat) { const f32x4* cs = (const f32x4*)(rope + pos * 32 + 16 * (wc & 1) + 4 * fq); const f32x4 c01 = cs[0], c23 = cs[1]; cv = (f32x4){c01[0], c01[2], c23[0], c23[2]}; sv = (f32x4){c01[1], c01[3], c23[1], c23[3]}; }
                f16* rowp = O + (size_t)row * INW + col0;
#pragma unroll
                for (int bj = 0; bj < 2; ++bj) { f32x4 x1 = acc[ai][bj][m][0], x2 = acc[ai][bj][m][1];
                    if (rms) { x1 = x1 * rsv[bj][ai][m] * g0; x2 = x2 * rsv[bj][ai][m] * g1; }
                    const f32x4 o1 = (x1 * cv - x2 * sv) * ksc, o2 = (x2 * cv + x1 * sv) * ksc;
                    u32x4 w; w.x = pkh(o1[0], o1[1]); w.y = pkh(o1[2], o1[3]); w.z = pkh(o2[0], o2[1]); w.w = pkh(o2[2], o2[3]);
                    *(u32x4*)(rowp + bj * HALF) = w; } }
    }
};
struct EpiConv {
    static constexpr bool PERM = true, HOOK = false, SK = false;
    const float* cw; const float* cb; f16* ACT; float* GE; float* XP; float* UPE; LAS float* halo;
    __device__ __forceinline__ void pre(f32x4 (&)[2][2][4][2], const Unit&, int, int, int, int) const {}
    template <int CTRL> static __device__ __forceinline__ float dppf(float old, float src) {
        return __builtin_bit_cast(float, __builtin_amdgcn_update_dpp(__builtin_bit_cast(int, old), __builtin_bit_cast(int, src), CTRL, 0xf, 0xf, false)); }
    __device__ __forceinline__ void operator()(const f32x4 (&acc)[2][2][4][2], const Unit& u, int wr, int wc, int fr, int fq) const {
        const int f0 = u.pn * 128 + wc * 32 + 8 * fq;
        f32x4 w0[2], w1[2], w2[2], bb[2];
#pragma unroll
        for (int n = 0; n < 2; ++n) { w0[n] = *(const f32x4*)(cw + f0 + 4 * n); w1[n] = *(const f32x4*)(cw + DFF + f0 + 4 * n); w2[n] = *(const f32x4*)(cw + 2 * DFF + f0 + 4 * n); bb[n] = *(const f32x4*)(cb + f0 + 4 * n); }
        const int hcol = wc * 32 + 8 * fq;
#pragma unroll
        for (int ai = 0; ai < 2; ++ai) {
            if (fr == 0)  { *(LAS f32x4*)(halo + ((ai * 2 + wr) * 2 + 0) * 128 + hcol) = acc[ai][0][0][0]; *(LAS f32x4*)(halo + ((ai * 2 + wr) * 2 + 0) * 128 + hcol + 4) = acc[ai][0][0][1]; }
            if (fr == 15) { *(LAS f32x4*)(halo + ((ai * 2 + wr) * 2 + 1) * 128 + hcol) = acc[ai][0][3][0]; *(LAS f32x4*)(halo + ((ai * 2 + wr) * 2 + 1) * 128 + hcol + 4) = acc[ai][0][3][1]; }
        }
        if (wr == 0 && fr == 0)  { float* g = GE + (size_t)(u.pm * 2 + 0) * DFF + f0; *(f32x4*)g = acc[0][0][0][0]; *(f32x4*)(g + 4) = acc[0][0][0][1]; }
        if (wr == 1 && fr == 15) { float* g = GE + (size_t)(u.pm * 2 + 1) * DFF + f0; *(f32x4*)g = acc[1][0][3][0]; *(f32x4*)(g + 4) = acc[1][0][3][1]; }
        asm volatile("s_waitcnt lgkmcnt(0)" ::: "memory"); __builtin_amdgcn_s_barrier(); asm volatile("" ::: "memory");
#pragma unroll
        for (int ai = 0; ai < 2; ++ai) {
            f32x4 hp[2] = {{0.f, 0.f, 0.f, 0.f}, {0.f, 0.f, 0.f, 0.f}}, hn[2] = {{0.f, 0.f, 0.f, 0.f}, {0.f, 0.f, 0.f, 0.f}};
            if (wr == 1)      { hp[0] = *(const LAS f32x4*)(halo + ((ai * 2 + 0) * 2 + 1) * 128 + hcol); hp[1] = *(const LAS f32x4*)(halo + ((ai * 2 + 0) * 2 + 1) * 128 + hcol + 4); }
            else if (ai == 1) { hp[0] = *(const LAS f32x4*)(halo + ((0 * 2 + 1) * 2 + 1) * 128 + hcol);  hp[1] = *(const LAS f32x4*)(halo + ((0 * 2 + 1) * 2 + 1) * 128 + hcol + 4); }
            if (wr == 0)      { hn[0] = *(const LAS f32x4*)(halo + ((ai * 2 + 1) * 2 + 0) * 128 + hcol); hn[1] = *(const LAS f32x4*)(halo + ((ai * 2 + 1) * 2 + 0) * 128 + hcol + 4); }
            else if (ai == 0) { hn[0] = *(const LAS f32x4*)(halo + ((1 * 2 + 0) * 2 + 0) * 128 + hcol);  hn[1] = *(const LAS f32x4*)(halo + ((1 * 2 + 0) * 2 + 0) * 128 + hcol + 4); }
#pragma unroll
            for (int m = 0; m < 4; ++m) {
                float o[8], xs[8];
#pragma unroll
                for (int n = 0; n < 2; ++n)
#pragma unroll
                    for (int j = 0; j < 4; ++j) {
                        const float g = acc[ai][0][m][n][j];
                        const float oldp = m > 0 ? dppf<0x121>(0.f, acc[ai][0][m > 0 ? m - 1 : 0][n][j]) : hp[n][j];
                        const float pv = dppf<0x111>(oldp, g);
                        const float oldn = m < 3 ? dppf<0x12f>(0.f, acc[ai][0][m < 3 ? m + 1 : 3][n][j]) : hn[n][j];
                        const float nv = dppf<0x101>(oldn, g);
                        const float x = bb[n][j] + w0[n][j] * pv + w1[n][j] * g + w2[n][j] * nv;
                        xs[4 * n + j] = x; o[4 * n + j] = x * sigmoidf_(x) * acc[ai][1][m][n][j];
                    }
                const int row = u.pm * BM + ai * HALF + wr * 64 + m * 16 + fr;
                u32x4 w; w.x = pkh(o[0], o[1]); w.y = pkh(o[2], o[3]); w.z = pkh(o[4], o[5]); w.w = pkh(o[6], o[7]);
                *(u32x4*)(ACT + (size_t)row * DFF + f0) = w;
                if ((ai == 0 && m == 0 && wr == 0 && fr == 0) || (ai == 1 && m == 3 && wr == 1 && fr == 15)) {
                    const size_t eo = (size_t)(u.pm * 2 + ai) * DFF + f0;
                    *(f32x4*)(XP + eo) = (f32x4){xs[0], xs[1], xs[2], xs[3]}; *(f32x4*)(XP + eo + 4) = (f32x4){xs[4], xs[5], xs[6], xs[7]};
                    *(f32x4*)(UPE + eo) = acc[ai][1][m][0]; *(f32x4*)(UPE + eo + 4) = acc[ai][1][m][1];
                }
            }
        }
    }
};
struct EpiGateK {
    static constexpr bool PERM = true, HOOK = true, SK = false;
    const f16* GLT; f16* Mh;
    template <int MODE>
    __device__ __forceinline__ void scale(f32x4 (&acc)[2][2][4][2], const Unit& u, int sa, int sb, int wr, int wc, int fr, int fq) const {
        int lo = (fq * 16 + fr) * 8; asm volatile("" : "+v"(lo));
        const f16* ta = GLT + ((size_t)((sa * 34 + u.pm) * 16 + u.pn) * 8 + (wr * 4 + wc)) * 8192 + lo;
        const f16* tb = GLT + ((size_t)((sb * 34 + u.pm) * 16 + u.pn) * 8 + (wr * 4 + wc)) * 8192 + lo;
        h8 ca[4], cb[4];
#pragma unroll
        for (int m = 0; m < 4; ++m) { const int q = (m * 2) * 512; ca[m] = *(const h8*)(ta + q); cb[m] = ca[m]; if (MODE == 0) cb[m] = *(const h8*)(tb + q); }
#pragma unroll
        for (int G = 0; G < 4; ++G) { const int bj = G >> 1, ai = G & 1;
            h8 na[4], nb[4];
            if (G < 3) { const int bj2 = (G + 1) >> 1, ai2 = (G + 1) & 1;
#pragma unroll
                for (int m = 0; m < 4; ++m) { const int q = ((ai2 * 4 + m) * 2 + bj2) * 512; na[m] = *(const h8*)(ta + q); nb[m] = na[m]; if (MODE == 0) nb[m] = *(const h8*)(tb + q); } }
            __builtin_amdgcn_sched_barrier(0);
#pragma unroll
            for (int m = 0; m < 4; ++m) {
#pragma unroll
                for (int j = 0; j < 8; ++j) {
                    float f = (float)ca[m][j];
                    if (MODE == 0) f *= __builtin_amdgcn_rcpf((float)cb[m][j]); else f *= (1.0f / 1024.0f);
                    acc[ai][bj][m][j >> 2][j & 3] *= f; } }
            asm volatile("" : "+v"(acc[ai][bj][0][0]), "+v"(acc[ai][bj][0][1]), "+v"(acc[ai][bj][1][0]), "+v"(acc[ai][bj][1][1]), "+v"(acc[ai][bj][2][0]), "+v"(acc[ai][bj][2][1]), "+v"(acc[ai][bj][3][0]), "+v"(acc[ai][bj][3][1]) :: "memory");
            if (G < 3) {
#pragma unroll
                for (int m = 0; m < 4; ++m) { ca[m] = na[m]; cb[m] = nb[m]; } } }
    }
    __device__ __forceinline__ void hook(f32x4 (&acc)[2][2][4][2], const Unit& u, int gt, int wr, int wc, int fr, int fq) const { const int seg = gt >> 4; scale<0>(acc, u, seg - 1, seg, wr, wc, fr, fq); }
    __device__ __forceinline__ void pre(f32x4 (&acc)[2][2][4][2], const Unit& u, int wr, int wc, int fr, int fq) const { const int seg = SK_ENABLE ? (((u.k0 >> 6) + u.nt - 1) >> 4) : 2; scale<1>(acc, u, seg, seg, wr, wc, fr, fq); }
    __device__ __forceinline__ void operator()(const f32x4 (&acc)[2][2][4][2], const Unit& u, int wr, int wc, int fr, int fq) const {
        const int row0 = u.pm * BM + wr * 64 + fr, col0 = u.pn * BM + wc * 32 + 8 * fq;
#pragma unroll
        for (int ai = 0; ai < 2; ++ai)
#pragma unroll
            for (int m = 0; m < 4; ++m) { f16* rowp = Mh + (size_t)(row0 + ai * HALF + m * 16) * DM + col0;
#pragma unroll
                for (int bj = 0; bj < 2; ++bj) { const f32x4 v0 = acc[ai][bj][m][0], v1 = acc[ai][bj][m][1];
                    u32x4 w; w.x = pkh(v0[0], v0[1]); w.y = pkh(v0[2], v0[3]); w.z = pkh(v1[0], v1[1]); w.w = pkh(v1[2], v1[3]);
                    *(u32x4*)(rowp + bj * HALF) = w; } }
    }
};
struct EpiRes {
    static constexpr bool PERM = true, HOOK = false, SK = false;
    __device__ __forceinline__ void pre(f32x4 (&)[2][2][4][2], const Unit&, int, int, int, int) const {}
    const void* latA; const void* latB; const float* gv; f16* Z; int lat16;
    __device__ __forceinline__ void operator()(const f32x4 (&acc)[2][2][4][2], const Unit& u, int wr, int wc, int fr, int fq) const {
        const int row0 = u.pm * BM + wr * 64 + fr, col0 = u.pn * BM + wc * 32 + 8 * fq;
        const int mr = u.pm < 16 ? 0 : (u.pm < 32 ? 1 : 2);
        const size_t rbase = u.pm < 32 ? 0 : (size_t)NLAT * DM;
        const void* lat = u.pm < 32 ? latA : latB;
        const float* g = gv + (size_t)mr * NMOD;
#pragma unroll
        for (int bj = 0; bj < 2; ++bj) { const int col = col0 + bj * HALF;
            const f32x4 g0 = *(const f32x4*)(g + col), g1 = *(const f32x4*)(g + col + 4);
#pragma unroll
            for (int ai = 0; ai < 2; ++ai)
#pragma unroll
                for (int m = 0; m < 4; ++m) { const size_t off = (size_t)(row0 + ai * HALF + m * 16) * DM + col;
                    f32x4 l0, l1;
                    if (lat16) { const h8 t = *(const h8*)((const f16*)lat + (off - rbase)); l0 = (f32x4){(float)t[0], (float)t[1], (float)t[2], (float)t[3]}; l1 = (f32x4){(float)t[4], (float)t[5], (float)t[6], (float)t[7]}; }
                    else { l0 = *(const f32x4*)((const float*)lat + (off - rbase)); l1 = *(const f32x4*)((const float*)lat + (off - rbase) + 4); }
                    const f32x4 z0 = l0 * DN_ALPHA + g0 * acc[ai][bj][m][0], z1 = l1 * DN_ALPHA + g1 * acc[ai][bj][m][1];
                    u32x4 w; w.x = pkh(z0[0], z0[1]); w.y = pkh(z0[2], z0[3]); w.z = pkh(z1[0], z1[1]); w.w = pkh(z1[2], z1[3]); *(u32x4*)(Z + off) = w; } }
    }
};

struct EpiResLN {
    static constexpr bool PERM = true, HOOK = false, SK = true;
    const void* latA; const void* latB; const float* gv; int lat16;
    const float* lng; const float* lnb; const float* msh; const float* msc;
    f16* LAT; f16* H; float* out; int writeOut;
    unsigned long long* xslot; unsigned* cnt; LAS unsigned char* lx;
    __device__ __forceinline__ void pre(f32x4 (&acc)[2][2][4][2], const Unit& u, int wr, int wc, int fr, int fq) const {
        int row0 = u.pm * BM + wr * 64 + fr, col0 = u.pn * BM + wc * 32 + 8 * fq;
        asm volatile("" : "+v"(row0), "+v"(col0));
        const int mr = u.pm < 16 ? 0 : (u.pm < 32 ? 1 : 2);
        const size_t rbase = u.pm < 32 ? 0 : (size_t)NLAT * DM;
        const void* lat = u.pm < 32 ? latA : latB;
        const float* g = gv + (size_t)mr * NMOD;
#pragma unroll
        for (int bj = 0; bj < 2; ++bj) { const int col = col0 + bj * HALF;
            const f32x4 g0 = *(const f32x4*)(g + col), g1 = *(const f32x4*)(g + col + 4);
#pragma unroll
            for (int ai = 0; ai < 2; ++ai) {
#pragma unroll
                for (int m = 0; m < 4; ++m) { const size_t off = (size_t)(row0 + ai * HALF + m * 16) * DM + col - rbase;
                    f32x4 l0, l1;
                    if (lat16) { const h8 t = *(const h8*)((const f16*)lat + off); l0 = (f32x4){(float)t[0], (float)t[1], (float)t[2], (float)t[3]}; l1 = (f32x4){(float)t[4], (float)t[5], (float)t[6], (float)t[7]}; }
                    else { l0 = *(const f32x4*)((const float*)lat + off); l1 = *(const f32x4*)((const float*)lat + off + 4); }
                    acc[ai][bj][m][0] = l0 * DN_ALPHA + g0 * acc[ai][bj][m][0]; acc[ai][bj][m][1] = l1 * DN_ALPHA + g1 * acc[ai][bj][m][1]; }
                asm volatile("" : "+v"(acc[ai][bj][0][0]), "+v"(acc[ai][bj][0][1]), "+v"(acc[ai][bj][1][0]), "+v"(acc[ai][bj][1][1]), "+v"(acc[ai][bj][2][0]), "+v"(acc[ai][bj][2][1]), "+v"(acc[ai][bj][3][0]), "+v"(acc[ai][bj][3][1]) :: "memory"); } }
    }
    __device__ __forceinline__ void operator()(const f32x4 (&acc)[2][2][4][2], const Unit& u, int wr, int wc, int fr, int fq) const {
        LAS f32x2* P = (LAS f32x2*)lx; LAS f32x2* S = (LAS f32x2*)(lx + 8192); volatile LAS unsigned* flag = (volatile LAS unsigned*)(lx + 10240);
        const int wid = wr * 4 + wc, lane = fq * 16 + fr;
#pragma unroll
        for (int ai = 0; ai < 2; ++ai)
#pragma unroll
            for (int m = 0; m < 4; ++m) {
                float sm = 0.f;
#pragma unroll
                for (int bj = 0; bj < 2; ++bj)
#pragma unroll
                    for (int n = 0; n < 2; ++n) { const f32x4 xv = acc[ai][bj][m][n]; sm += (xv[0] + xv[1]) + (xv[2] + xv[3]); }
                sm += __shfl_xor(sm, 16); sm += __shfl_xor(sm, 32);
                const float mw = sm * (1.0f / 64.0f); float q = 0.f;
#pragma unroll
                for (int bj = 0; bj < 2; ++bj)
#pragma unroll
                    for (int n = 0; n < 2; ++n) { const f32x4 d = acc[ai][bj][m][n] - mw; q += (d[0] * d[0] + d[1] * d[1]) + (d[2] * d[2] + d[3] * d[3]); }
                q += __shfl_xor(q, 16); q += __shfl_xor(q, 32);
                if (fq == 0) P[(ai * HALF + wr * 64 + m * 16 + fr) * 4 + wc] = (f32x2){mw, q};
            }
        asm volatile("s_waitcnt lgkmcnt(0)" ::: "memory"); __builtin_amdgcn_s_barrier(); asm volatile("" ::: "memory");
        const int row = wid * 32 + (lane & 31);
        if (lane < 32) {
            const f32x2 pa = P[row * 4 + 0], pb = P[row * 4 + 1], pc = P[row * 4 + 2], pd = P[row * 4 + 3];
            const float mt = ((pa.x + pb.x) + (pc.x + pd.x)) * 0.25f;
            const float da = pa.x - mt, db = pb.x - mt, dc = pc.x - mt, dd = pd.x - mt;
            const float m2 = ((pa.y + pb.y) + (pc.y + pd.y)) + 64.0f * ((da * da + db * db) + (dc * dc + dd * dd));
            __hip_atomic_store(xslot + ((size_t)(u.pm * BM + row) * 16 + u.pn), ((unsigned long long)__float_as_uint(m2) << 32) | __float_as_uint(mt), __ATOMIC_RELAXED, __HIP_MEMORY_SCOPE_AGENT);
        }
        asm volatile("s_waitcnt vmcnt(0)" ::: "memory");
        if (lane == 0) __hip_atomic_fetch_add(cnt + 64 * u.pm, 1u, __ATOMIC_RELAXED, __HIP_MEMORY_SCOPE_AGENT);
        if (wid == 0) {
            unsigned sp = 0;
            while ((unsigned)__builtin_amdgcn_readfirstlane((int)__hip_atomic_load(cnt + 64 * u.pm, __ATOMIC_RELAXED, __HIP_MEMORY_SCOPE_AGENT)) < 128u) { __builtin_amdgcn_s_sleep(1); if (++sp > (1u << 22)) break; }
            __builtin_amdgcn_fence(__ATOMIC_ACQUIRE, "agent");
            if (lane == 0) flag[0] = 1u;
        }
        asm volatile("s_waitcnt vmcnt(0) lgkmcnt(0)" ::: "memory"); __builtin_amdgcn_s_barrier(); asm volatile("" ::: "memory");
        if (lane < 32) {
            const unsigned long long* sl = xslot + (size_t)(u.pm * BM + row) * 16; float mt[16], m2[16]; float ms = 0.f;
#pragma unroll
            for (int t = 0; t < 16; ++t) { const unsigned long long wv = __hip_atomic_load(sl + t, __ATOMIC_RELAXED, __HIP_MEMORY_SCOPE_AGENT); mt[t] = __uint_as_float((unsigned)wv); m2[t] = __uint_as_float((unsigned)(wv >> 32)); ms += mt[t]; }
            const float mean = ms * (1.0f / 16.0f); float q = 0.f;
#pragma unroll
            for (int t = 0; t < 16; ++t) { const float dm = mt[t] - mean; q += m2[t] + 256.0f * dm * dm; }
            S[row] = (f32x2){mean, 1.0f / sqrtf(q * (1.0f / DM) + LN_EPS)};
        }
        asm volatile("s_waitcnt lgkmcnt(0)" ::: "memory"); __builtin_amdgcn_s_barrier(); asm volatile("" ::: "memory");
        const int row0 = u.pm * BM + wr * 64 + fr, col0 = u.pn * BM + wc * 32 + 8 * fq;
        const int mr = u.pm < 16 ? 0 : (u.pm < 32 ? 1 : 2);
#pragma unroll
        for (int bj = 0; bj < 2; ++bj) { const int col = col0 + bj * HALF;
            const f32x4 g0 = *(const f32x4*)(lng + col), g1 = *(const f32x4*)(lng + col + 4), b0 = *(const f32x4*)(lnb + col), b1 = *(const f32x4*)(lnb + col + 4);
            f32x4 c0 = {0.f, 0.f, 0.f, 0.f}, c1 = c0, h0 = c0, h1 = c0;
            if (!writeOut) { const float* sc = msc + (size_t)mr * NMOD + col; const float* sh = msh + (size_t)mr * NMOD + col; c0 = *(const f32x4*)sc + 1.0f; c1 = *(const f32x4*)(sc + 4) + 1.0f; h0 = *(const f32x4*)sh; h1 = *(const f32x4*)(sh + 4); }
#pragma unroll
            for (int ai = 0; ai < 2; ++ai)
#pragma unroll
                for (int m = 0; m < 4; ++m) { const int rl = ai * HALF + wr * 64 + m * 16 + fr; const f32x2 st = S[rl]; const size_t off = (size_t)(row0 + ai * HALF + m * 16) * DM + col;
                    const f32x4 y0 = (acc[ai][bj][m][0] - st.x) * st.y * g0 + b0, y1 = (acc[ai][bj][m][1] - st.x) * st.y * g1 + b1;
                    if (writeOut) { if (u.pm < 32) { *(f32x4*)(out + off) = y0; *(f32x4*)(out + off + 4) = y1; } }
                    else { u32x4 w; w.x = pkh(y0[0], y0[1]); w.y = pkh(y0[2], y0[3]); w.z = pkh(y1[0], y1[1]); w.w = pkh(y1[2], y1[3]); *(u32x4*)(LAT + off) = w;
                        const f32x4 v0 = y0 * c0 + h0, v1 = y1 * c1 + h1; u32x4 w2; w2.x = pkh(v0[0], v0[1]); w2.y = pkh(v0[2], v0[3]); w2.z = pkh(v1[0], v1[1]); w2.w = pkh(v1[2], v1[3]); *(u32x4*)(H + off) = w2; } } }
    }
};

template <class Epi, class Sched, bool ALIGN_EPI = true, bool SP2 = true, bool SKW = false>
__device__ __forceinline__ void gemm_phase(LAS unsigned char* lds, const Gemm g, const Sched& S, const Epi& E, const SKCtx SK, const int wave0) {
    int tid = tid_of(wave0); asm volatile("" : "+v"(tid));
    const int wid = __builtin_amdgcn_readfirstlane(tid >> 6), lane = tid & 63, wr = wid >> 2, wc = wid & 3, fr = lane & 15, fq = lane >> 4;
    const int K = g.K;
    unsigned voffA[2], voffB[2];
#pragma unroll
    for (int i = 0; i < 2; ++i) { int R, C; stage_rc(tid * 16 + i * 8192, R, C); const int Rb = Epi::PERM ? ((R & ~31) + perm32(R & 31)) : R;
        voffA[i] = (unsigned)(R * K + C) * 2u; voffB[i] = (unsigned)(Rb * K + C) * 2u; }
    const size_t kstep = (size_t)(BK * 2);
    const size_t hstep = (size_t)HALF * K * 2;
    const size_t tstep = 2 * hstep;
    const unsigned ldsw = (unsigned)wid * 1024u;
    const int aoff = lds_byte(wr * 64 + fr, fq * 8), boff = lds_byte(wc * 32 + fr, fq * 8);
#define PG8_SA(b, h) (((b) * 2 + (h)) * HTB)
#define PG8_SB(b, h) ((4 + (b) * 2 + (h)) * HTB)
#define PG8_STAGE(bufoff, gbase, voff) do { _Pragma("unroll") for (int _i = 0; _i < 2; ++_i) \
        __builtin_amdgcn_global_load_lds((const unsigned*)((const char*)(gbase) + (voff)[_i]), (LAS unsigned*)(lds + (bufoff) + ldsw + _i * 8192), 16, 0, 0); } while (0)
#define PG8_LDA(dst, b, h) do { _Pragma("unroll") for (int m = 0; m < 4; ++m) _Pragma("unroll") for (int k = 0; k < 2; ++k) dst[m][k] = *(const LAS h8*)(lds + PG8_SA(b, h) + aoff + m * 2048 + k * 1024); } while (0)
#define PG8_LDB(dst, b, h) do { _Pragma("unroll") for (int n = 0; n < 2; ++n) _Pragma("unroll") for (int k = 0; k < 2; ++k) dst[n][k] = *(const LAS h8*)(lds + PG8_SB(b, h) + boff + n * 2048 + k * 1024); } while (0)
#define PG8_MMA(ai, bj, At, Bt) do { __builtin_amdgcn_s_setprio(1); _Pragma("unroll") for (int m = 0; m < 4; ++m) _Pragma("unroll") for (int n = 0; n < 2; ++n) _Pragma("unroll") for (int k = 0; k < 2; ++k) \
        acc[ai][bj][m][n] = __builtin_amdgcn_mfma_f32_16x16x32_f16(Bt[n][k], At[m][k], acc[ai][bj][m][n], 0, 0, 0); __builtin_amdgcn_s_setprio(0); } while (0)
#define PG8_WAIT_V(n) asm volatile("s_waitcnt vmcnt(" #n ")" ::: "memory")
#define PG8_WAIT_L(n) asm volatile("s_waitcnt lgkmcnt(" #n ")" ::: "memory")
#define PG8_BAR __builtin_amdgcn_s_barrier()
#define PG8_SCHED __builtin_amdgcn_sched_barrier(0)
    Unit cur, nxt; int ui = 0;
    if (!S.next(0, cur)) return;
    f32x4 acc[2][2][4][2];
#pragma unroll
    for (int a = 0; a < 2; ++a)
#pragma unroll
        for (int b = 0; b < 2; ++b)
#pragma unroll
            for (int m = 0; m < 4; ++m)
#pragma unroll
                for (int n = 0; n < 2; ++n) acc[a][b][m][n] = (f32x4){0.f, 0.f, 0.f, 0.f};
    h8 At[4][2], B0[2][2], B1[2][2];
    constexpr bool SKP = SK_ENABLE || SKW;
    const char* cA = (const char*)g.A + (size_t)cur.pm * tstep + (SKP ? (size_t)cur.k0 * 2 : 0); const char* cB = (const char*)g.Bt + (size_t)cur.pn * tstep + (SKP ? (size_t)cur.k0 * 2 : 0);
    if constexpr (SP2) {
        PG8_STAGE(PG8_SB(0, 0), cB, voffB); PG8_STAGE(PG8_SB(0, 1), cB + hstep, voffB); PG8_STAGE(PG8_SA(0, 0), cA, voffA); PG8_STAGE(PG8_SA(0, 1), cA + hstep, voffA);
        if (wr == 1) PG8_BAR;
        PG8_WAIT_V(2); PG8_BAR;
        PG8_STAGE(PG8_SB(1, 0), cB + kstep, voffB); PG8_STAGE(PG8_SA(1, 0), cA + kstep, voffA); PG8_STAGE(PG8_SB(1, 1), cB + hstep + kstep, voffB);
        PG8_WAIT_V(6); PG8_BAR;
    } else {
        PG8_STAGE(PG8_SB(0, 0), cB, voffB); PG8_STAGE(PG8_SA(0, 0), cA, voffA); PG8_STAGE(PG8_SB(0, 1), cB + hstep, voffB); PG8_STAGE(PG8_SA(0, 1), cA + hstep, voffA);
        if (wr == 1) PG8_BAR;
        PG8_WAIT_V(4); PG8_BAR;
        PG8_STAGE(PG8_SB(1, 0), cB + kstep, voffB); PG8_STAGE(PG8_SA(1, 0), cA + kstep, voffA); PG8_STAGE(PG8_SB(1, 1), cB + hstep + kstep, voffB);
        PG8_WAIT_V(6); PG8_BAR;
    }
    for (;;) {
        const bool has_next = S.next(ui + 1, nxt);
        const char* nA = has_next ? (const char*)g.A + (size_t)nxt.pm * tstep + (SKP ? (size_t)nxt.k0 * 2 : 0) : cA; const char* nB = has_next ? (const char*)g.Bt + (size_t)nxt.pn * tstep + (SKP ? (size_t)nxt.k0 * 2 : 0) : cB;
        const int nt = SKP ? cur.nt : K / BK, kt0 = SKP ? (cur.k0 >> 6) : 0;
        for (int t = 0; t < nt; t += 2) {
            const bool last = (t == nt - 2);
            if constexpr (Epi::HOOK) { const int gt = kt0 + t; if (t > 0 && (gt == 16 || gt == 32)) E.hook(acc, cur, gt, wr, wc, fr, fq); }
            const char* a1 = cA + (size_t)(t + 1) * kstep;
            const char* a2 = last ? nA : cA + (size_t)(t + 2) * kstep; const char* b2 = last ? nB : cB + (size_t)(t + 2) * kstep;
            const char* a3 = a2 + kstep; const char* b3 = b2 + kstep;
            if constexpr (SP2) {
            PG8_LDB(B0, 0, 0); PG8_LDB(B1, 0, 1); PG8_SCHED; PG8_LDA(At, 0, 0); PG8_STAGE(PG8_SA(1, 1), a1 + hstep, voffA);
            PG8_WAIT_V(8); PG8_WAIT_L(0); PG8_BAR; PG8_MMA(0, 0, At, B0); PG8_MMA(0, 1, At, B1); PG8_BAR; PG8_SCHED;
            PG8_LDA(At, 0, 1); PG8_STAGE(PG8_SB(0, 0), b2, voffB); PG8_STAGE(PG8_SB(0, 1), b2 + hstep, voffB); PG8_STAGE(PG8_SA(0, 0), a2, voffA);
            PG8_WAIT_V(8); PG8_WAIT_L(0); PG8_BAR; PG8_MMA(1, 0, At, B0); PG8_MMA(1, 1, At, B1); PG8_BAR; PG8_SCHED;
            PG8_LDB(B0, 1, 0); PG8_LDB(B1, 1, 1); PG8_SCHED; PG8_LDA(At, 1, 0); PG8_STAGE(PG8_SA(0, 1), a2 + hstep, voffA);
            PG8_WAIT_V(8); PG8_WAIT_L(0); PG8_BAR; PG8_MMA(0, 0, At, B0); PG8_MMA(0, 1, At, B1); PG8_BAR; PG8_SCHED;
            PG8_LDA(At, 1, 1); PG8_STAGE(PG8_SB(1, 0), b3, voffB); PG8_STAGE(PG8_SB(1, 1), b3 + hstep, voffB); PG8_STAGE(PG8_SA(1, 0), a3, voffA);
            PG8_WAIT_V(8); PG8_WAIT_L(0); PG8_BAR; PG8_MMA(1, 0, At, B0); PG8_MMA(1, 1, At, B1); PG8_BAR; PG8_SCHED;
            } else {
            PG8_LDB(B0, 0, 0); PG8_SCHED; PG8_LDA(At, 0, 0); PG8_STAGE(PG8_SA(1, 1), a1 + hstep, voffA);
            PG8_WAIT_L(8); PG8_BAR; PG8_WAIT_L(0); PG8_MMA(0, 0, At, B0); PG8_BAR; PG8_SCHED;
            PG8_LDB(B1, 0, 1); PG8_STAGE(PG8_SB(0, 0), b2, voffB);
            PG8_BAR; PG8_WAIT_L(0); PG8_MMA(0, 1, At, B1); PG8_BAR;
            PG8_LDA(At, 0, 1); PG8_STAGE(PG8_SA(0, 0), a2, voffA);
            PG8_BAR; PG8_WAIT_L(0); PG8_MMA(1, 0, At, B0); PG8_BAR; PG8_SCHED;
            PG8_STAGE(PG8_SB(0, 1), b2 + hstep, voffB);
            PG8_WAIT_V(6); PG8_BAR; PG8_MMA(1, 1, At, B1); PG8_BAR;
            PG8_LDB(B0, 1, 0); PG8_SCHED; PG8_LDA(At, 1, 0); PG8_STAGE(PG8_SA(0, 1), a2 + hstep, voffA);
            PG8_WAIT_L(8); PG8_BAR; PG8_WAIT_L(0); PG8_MMA(0, 0, At, B0); PG8_BAR; PG8_SCHED;
            PG8_LDB(B1, 1, 1); PG8_STAGE(PG8_SB(1, 0), b3, voffB);
            PG8_BAR; PG8_WAIT_L(0); PG8_MMA(0, 1, At, B1); PG8_BAR;
            PG8_LDA(At, 1, 1); PG8_STAGE(PG8_SA(1, 0), a3, voffA);
            PG8_BAR; PG8_WAIT_L(0); PG8_MMA(1, 0, At, B0); PG8_BAR; PG8_SCHED;
            PG8_STAGE(PG8_SB(1, 1), b3 + hstep, voffB);
            PG8_WAIT_V(6); PG8_BAR; PG8_MMA(1, 1, At, B1); PG8_BAR;
            }
        }
        if constexpr (ALIGN_EPI) { if (wr == 0) PG8_BAR; }
        if constexpr (SKW) {
            f32x4* af = &acc[0][0][0][0];
            const float* s0 = SK.slab + ((size_t)(cur.rid * cur.ns) * 8 + wid) * 8192;
            int voff = lane * 16; asm volatile("" : "+v"(voff));
            { uintptr_t sb = (uintptr_t)(s0 + (size_t)cur.sl * 8 * 8192); const unsigned lo = __builtin_amdgcn_readfirstlane((unsigned)sb), hi = __builtin_amdgcn_readfirstlane((unsigned)(sb >> 32));
              const __amdgpu_buffer_rsrc_t rs = __builtin_amdgcn_make_buffer_rsrc((void*)(((uintptr_t)hi << 32) | lo), 0, 32768, 0x00020000);
#pragma unroll
              for (int q = 0; q < 32; ++q) __builtin_amdgcn_raw_buffer_store_b128(__builtin_bit_cast(u32x4, af[q]), rs, voff, q * 1024, 16); }
            asm volatile("s_waitcnt vmcnt(0)" ::: "memory"); PG8_BAR;
            volatile LAS unsigned* mk = (volatile LAS unsigned*)(lds + MISC_OFF);
            if (wid == 0) { unsigned old = 0; if (voff == 0) old = __hip_atomic_fetch_add(SK.cnt + cur.rid * 16, 1u, __ATOMIC_RELAXED, __HIP_MEMORY_SCOPE_AGENT);
                old = __builtin_amdgcn_readfirstlane(old); if (voff == 0) mk[30] = old; }
            asm volatile("s_waitcnt vmcnt(0) lgkmcnt(0)" ::: "memory"); PG8_BAR;
            if ((unsigned)__builtin_amdgcn_readfirstlane((int)mk[30]) == (unsigned)(cur.ns - 1)) {
                __builtin_amdgcn_fence(__ATOMIC_ACQUIRE, "agent"); asm volatile("s_waitcnt vmcnt(0)" ::: "memory");
#pragma unroll
                for (int q = 0; q < 32; ++q) af[q] = (f32x4){0.f, 0.f, 0.f, 0.f};
                for (int sl = 0; sl < cur.ns; ++sl) {
                    uintptr_t sb = (uintptr_t)(s0 + (size_t)sl * 8 * 8192); const unsigned lo = __builtin_amdgcn_readfirstlane((unsigned)sb), hi = __builtin_amdgcn_readfirstlane((unsigned)(sb >> 32));
                    const __amdgpu_buffer_rsrc_t rs = __builtin_amdgcn_make_buffer_rsrc((void*)(((uintptr_t)hi << 32) | lo), 0, 32768, 0x00020000);
#pragma unroll
                    for (int qg = 0; qg < 4; ++qg) {
#pragma unroll
                        for (int q = 8 * qg; q < 8 * qg + 8; ++q) af[q] += __builtin_bit_cast(f32x4, __builtin_amdgcn_raw_buffer_load_b128(rs, voff, q * 1024, 0));
                        asm volatile("" : "+v"(af[8 * qg]), "+v"(af[8 * qg + 1]), "+v"(af[8 * qg + 2]), "+v"(af[8 * qg + 3]), "+v"(af[8 * qg + 4]), "+v"(af[8 * qg + 5]), "+v"(af[8 * qg + 6]), "+v"(af[8 * qg + 7]) :: "memory"); } }
                E.pre(acc, cur, wr, wc, fr, fq); E(acc, cur, wr, wc, fr, fq);
            }
        } else if (!SK_ENABLE || cur.ns == 1) { E.pre(acc, cur, wr, wc, fr, fq); E(acc, cur, wr, wc, fr, fq); }
        else {
            E.pre(acc, cur, wr, wc, fr, fq);
            f32x4* af = &acc[0][0][0][0];
            const float* s0 = SK.slab + ((size_t)(cur.rid * cur.ns) * 8 + wid) * 8192;
            int voff = lane * 16; asm volatile("" : "+v"(voff));
            { uintptr_t sb = (uintptr_t)(s0 + (size_t)cur.sl * 8 * 8192); const unsigned lo = __builtin_amdgcn_readfirstlane((unsigned)sb), hi = __builtin_amdgcn_readfirstlane((unsigned)(sb >> 32));
              const __amdgpu_buffer_rsrc_t rs = __builtin_amdgcn_make_buffer_rsrc((void*)(((uintptr_t)hi << 32) | lo), 0, 32768, 0x00020000);
#pragma unroll
              for (int q = 0; q < 32; ++q) __builtin_amdgcn_raw_buffer_store_b128(__builtin_bit_cast(u32x4, af[q]), rs, voff, q * 1024, 16); }
            asm volatile("s_waitcnt vmcnt(0)" ::: "memory");
            unsigned old = 0; if (lane == 0) old = __hip_atomic_fetch_add(SK.cnt + cur.rid * 16 + wid, 1u, __ATOMIC_RELAXED, __HIP_MEMORY_SCOPE_AGENT);
            old = __builtin_amdgcn_readfirstlane(old);
            if (old == (unsigned)(cur.ns - 1)) {
                __builtin_amdgcn_fence(__ATOMIC_ACQUIRE, "agent"); asm volatile("s_waitcnt vmcnt(0)" ::: "memory");
#pragma unroll
                for (int q = 0; q < 32; ++q) af[q] = (f32x4){0.f, 0.f, 0.f, 0.f};
                for (int sl = 0; sl < cur.ns; ++sl) {
                    uintptr_t sb = (uintptr_t)(s0 + (size_t)sl * 8 * 8192); const unsigned lo = __builtin_amdgcn_readfirstlane((unsigned)sb), hi = __builtin_amdgcn_readfirstlane((unsigned)(sb >> 32));
                    const __amdgpu_buffer_rsrc_t rs = __builtin_amdgcn_make_buffer_rsrc((void*)(((uintptr_t)hi << 32) | lo), 0, 32768, 0x00020000);
#pragma unroll
                    for (int qg = 0; qg < 4; ++qg) {
#pragma unroll
                        for (int q = 8 * qg; q < 8 * qg + 8; ++q) af[q] += __builtin_bit_cast(f32x4, __builtin_amdgcn_raw_buffer_load_b128(rs, voff, q * 1024, 0));
                        asm volatile("" : "+v"(af[8 * qg]), "+v"(af[8 * qg + 1]), "+v"(af[8 * qg + 2]), "+v"(af[8 * qg + 3]), "+v"(af[8 * qg + 4]), "+v"(af[8 * qg + 5]), "+v"(af[8 * qg + 6]), "+v"(af[8 * qg + 7]) :: "memory"); } }
                E(acc, cur, wr, wc, fr, fq);
            }
        }
        if (!has_next) break;
#pragma unroll
        for (int a = 0; a < 2; ++a)
#pragma unroll
            for (int b = 0; b < 2; ++b)
#pragma unroll
                for (int m = 0; m < 4; ++m)
#pragma unroll
                    for (int n = 0; n < 2; ++n) acc[a][b][m][n] = (f32x4){0.f, 0.f, 0.f, 0.f};
        cur = nxt; cA = nA; cB = nB; ++ui;
        if constexpr (ALIGN_EPI) { if (wr == 1) PG8_BAR; }
    }
    PG8_WAIT_V(0);
    if constexpr (!ALIGN_EPI) { if (wr == 0) PG8_BAR; }
    PG8_BAR;
#undef PG8_SA
#undef PG8_SB
#undef PG8_STAGE
#undef PG8_LDA
#undef PG8_LDB
#undef PG8_MMA
#undef PG8_WAIT_V
#undef PG8_WAIT_L
#undef PG8_BAR
#undef PG8_SCHED
}
}

#define XB_TMO      128
#define XB_XCNT(j)  (256  + 64 * (j))
#define XB_XSUB(j)  (1280 + 64 * (j))
#define XB_XGEN(j)  (2304 + 64 * (j))
#define XB_TOP      3328
#define XB_TOPGEN   3392
#define XCD_BAR_WORDS 3456
#define XB_SPIN_CAP (1u << 22)
__device__ __forceinline__ unsigned xb_ld(unsigned* p)              { return __hip_atomic_load(p, __ATOMIC_RELAXED, __HIP_MEMORY_SCOPE_AGENT); }
__device__ __forceinline__ unsigned xb_add(unsigned* p, unsigned v) { return __hip_atomic_fetch_add(p, v, __ATOMIC_RELAXED, __HIP_MEMORY_SCOPE_AGENT); }
__device__ __forceinline__ unsigned xb_xcc_id() { return (unsigned)__builtin_amdgcn_s_getreg((3 << 11) | 20) & 0xFu; }
#define XB_SPIN(cond, bar) do { unsigned _sp = 0; while (cond) { __builtin_amdgcn_s_sleep(1); \
    if ((++_sp & 255u) == 0u) { if (xb_ld(&(bar)[XB_TMO])) break; if (_sp > XB_SPIN_CAP) { atomicAdd(&(bar)[XB_TMO], 1u); break; } } } } while (0)
struct XcdBarrier { unsigned* bar; unsigned x; volatile LAS unsigned* st; };
__device__ __forceinline__ XcdBarrier xcd_barrier_post(unsigned* bar, volatile LAS unsigned* st, int tid0) {
    XcdBarrier b; b.bar = bar; b.x = xb_xcc_id(); b.st = st;
    if (tid0 == 0) (void)xb_add(&bar[XB_XCNT(b.x)], 1u);
    return b;
}
__device__ __forceinline__ void xcd_barrier_complete(unsigned* bar, unsigned x, unsigned& nloc, unsigned& nx) {
    const unsigned G = gridDim.x * gridDim.y * gridDim.z;
    unsigned sum, cnt, mine, sp = 0u;
    for (;;) {
        sum = 0u; cnt = 0u; mine = 0u;
#pragma unroll
        for (unsigned j = 0; j < 16; ++j) { const unsigned c = xb_ld(&bar[XB_XCNT(j)]); sum += c; cnt += (c > 0u) ? 1u : 0u; mine = (j == x) ? c : mine; }
        if (sum == G) break;
        __builtin_amdgcn_s_sleep(1);
        if ((++sp & 255u) == 0u) { if (xb_ld(&bar[XB_TMO])) break; if (sp > XB_SPIN_CAP) { atomicAdd(&bar[XB_TMO], 1u); break; } }
    }
    nloc = mine > 0u ? mine : 1u; nx = cnt > 0u ? cnt : 1u;
}
__device__ __forceinline__ void xcd_barrier(const XcdBarrier& b, const int wave0) {
    asm volatile("s_waitcnt vmcnt(0)" ::: "memory");
    __syncthreads();
    int t0_ = tid_of(wave0); asm volatile("" : "+v"(t0_));
    if (t0_ == 0) {
        unsigned* bar = b.bar;
        __builtin_amdgcn_s_waitcnt(0);
        unsigned nloc = b.st[0], nx = b.st[1];
        if (nloc == 0u) { unsigned xl = b.x; asm volatile("" : "+s"(xl)); xcd_barrier_complete(bar, xl, nloc, nx); b.st[0] = nloc; b.st[1] = nx; }
        const unsigned old = xb_add(&bar[XB_XSUB(b.x)], 1u);
        const unsigned gen = old / nloc;
        if (old + 1u == (gen + 1u) * nloc) {
            __builtin_amdgcn_fence(__ATOMIC_RELEASE, "agent");
            asm volatile("s_waitcnt vmcnt(0)" ::: "memory");
            const unsigned og = xb_add(&bar[XB_TOP], 1u);
            const unsigned tg = og / nx;
            if (og + 1u == (tg + 1u) * nx) xb_add(&bar[XB_TOPGEN], 1u);
            else XB_SPIN(xb_ld(&bar[XB_TOPGEN]) == tg, bar);
            __builtin_amdgcn_fence(__ATOMIC_ACQUIRE, "agent");
            xb_add(&bar[XB_XGEN(b.x)], 1u);
            asm volatile("s_waitcnt vmcnt(0)" ::: "memory");
        } else {
            XB_SPIN(xb_ld(&bar[XB_XGEN(b.x)]) == gen, bar);
            __builtin_amdgcn_fence(__ATOMIC_ACQUIRE, "agent");
            asm volatile("s_waitcnt vmcnt(0)" ::: "memory");
        }
    }
    __syncthreads();
}

__device__ __forceinline__ void rope_table(f32x2* tab, int tid) {
    for (int e = tid; e < 64 * 32; e += 512) {
        const int pos = e >> 5, i = e & 31;
        double invf = 1.0; for (int j = 0; j < i; ++j) invf *= 0.74989420933245582730;
        const float ang = (float)pos * (float)invf;
        const double xd = (double)ang;
        const double kq = __builtin_rint(xd * 0.63661977236758134308);
        const double r = (xd - kq * 1.5707963267948966192) - kq * 6.123233995736766e-17;
        const double r2 = r * r;
        double sn = r * (1.0 + r2 * (-1.0 / 6 + r2 * (1.0 / 120 + r2 * (-1.0 / 5040 + r2 * (1.0 / 362880 + r2 * (-1.0 / 39916800 + r2 * (1.0 / 6227020800.0 + r2 * (-1.0 / 1307674368000.0))))))));
        double cs = 1.0 + r2 * (-0.5 + r2 * (1.0 / 24 + r2 * (-1.0 / 720 + r2 * (1.0 / 40320 + r2 * (-1.0 / 3628800 + r2 * (1.0 / 479001600 + r2 * (-1.0 / 87178291200.0)))))));
        const int q = ((int)kq) & 3;
        double c2, s2;
        if (q == 0) { c2 = cs; s2 = sn; } else if (q == 1) { c2 = -sn; s2 = cs; } else if (q == 2) { c2 = -cs; s2 = -sn; } else { c2 = sn; s2 = -cs; }
        tab[e] = (f32x2){(float)c2, (float)s2};
    }
}
__device__ __forceinline__ void ph_modgemv(const Args& a, LAS unsigned char* lds, int tid, int lane, int wave, int first, int last_item, int stride) {
    LAS float* sv = (LAS float*)lds;
    LAS float* red = (LAS float*)(lds + 49152);
    float* MOD = (float*)(a.ws + WS_MOD);
    for (int i = tid; i < 3 * DM; i += 512) { const int r = i >> 12, k = i & 4095; const float c = r < 2 ? a.c[r * DM + k] : a.c_ctx[k]; sv[i] = c * sigmoidf_(c); }
    __syncthreads();
    for (int item = first; item < last_item; item += stride) {
        const int l = item >> 7, cb = item & 127;
        f32x4 acc0 = {0.f, 0.f, 0.f, 0.f}, acc1 = acc0, acc2 = acc0;
        if (lane < 48) {
            const float* wp = a.w_mod + (size_t)l * DM * NMOD + (size_t)(wave * 512) * NMOD + cb * 192 + lane * 4;
            const LAS float* s0 = sv + wave * 512;
            for (int k = 0; k < 512; k += 16) {
                f32x4 v[16];
#pragma unroll
                for (int j = 0; j < 16; ++j) v[j] = *(const f32x4*)(wp + (size_t)(k + j) * NMOD);
#pragma unroll
                for (int j = 0; j < 16; ++j) { acc0 += v[j] * s0[k + j]; acc1 += v[j] * s0[DM + k + j]; acc2 += v[j] * s0[2 * DM + k + j]; }
            }
            *(LAS f32x4*)(red + (wave * 3 + 0) * 192 + lane * 4) = acc0; *(LAS f32x4*)(red + (wave * 3 + 1) * 192 + lane * 4) = acc1; *(LAS f32x4*)(red + (wave * 3 + 2) * 192 + lane * 4) = acc2;
        }
        __syncthreads();
        for (int i = tid; i < 3 * 192; i += 512) { const int r = i / 192, n = i % 192; float s = 0.f;
#pragma unroll
            for (int w = 0; w < 8; ++w) s += red[(w * 3 + r) * 192 + n];
            MOD[(size_t)(l * 3 + r) * NMOD + cb * 192 + n] = s + a.b_mod[l * NMOD + cb * 192 + n]; }
        __syncthreads();
    }
}
__device__ __forceinline__ void cvt_item(const float* W, int K, int N, f16* WT, int ldk, LAS unsigned char* tile, int idx, int lane, bool pair_up = false, bool qk_perm = false) {
    const int nblk = N >> 6, kb = idx / nblk, nb = idx - kb * nblk, k0 = kb * 64, n0 = nb * 64;
    const int d0 = !pair_up ? n0 : (n0 < DFF ? (n0 >> 7) * 256 + (n0 & 127) : ((n0 - DFF) >> 7) * 256 + 128 + ((n0 - DFF) & 127));
    const int g = lane >> 4, q = lane & 15;
    const float* src = W + (size_t)(k0 + 2 * g) * N + n0 + 4 * q;
    f32x4 va[8], vb[8];
#pragma unroll
    for (int i = 0; i < 8; ++i) { va[i] = *(const f32x4*)(src + (size_t)(8 * i) * N); vb[i] = *(const f32x4*)(src + (size_t)(8 * i + 1) * N); }
    LAS unsigned* T32 = (LAS unsigned*)tile;
#pragma unroll
    for (int i = 0; i < 8; ++i)
#pragma unroll
        for (int j = 0; j < 4; ++j) T32[(4 * q + j) * 36 + 4 * i + g] = pkh(va[i][j], vb[i][j]);
    LDS_WAIT();
    const int c = lane & 7;
#pragma unroll
    for (int jj = 0; jj < 8; ++jj) { const int n = (lane >> 3) + 8 * jj; const u32x4 o = *(const LAS u32x4*)(tile + n * 144 + 16 * c);
        int dr = d0 + n;
        if (qk_perm) { const int cc = n0 + n; if (cc < 1280 || (cc >= 1536 && cc < 2816) || (cc >= 3072 && cc < 5120)) { const int d = cc & 127;
                dr = (cc & ~127) + 32 * (2 * (d >> 6) + ((d >> 4) & 1)) + 8 * ((d >> 2) & 3) + 4 * ((d >> 5) & 1) + (d & 3); } }
        *(u32x4*)(WT + (size_t)dr * ldk + k0 + 8 * c) = o; }
    LDS_WAIT();
}
constexpr int I_IN = 64 * 304, I_BR = 16 * 64, I_O = 64 * 64, I_UP = 64 * 344, I_DN = 172 * 64;
constexpr int QT_BR0 = 3 * I_BR, QT_O0 = QT_BR0 + I_O, QT_UP0 = QT_O0 + I_UP, QT_DN0 = QT_UP0 + I_DN, QT_IN1 = QT_DN0 + I_IN,
              QT_BR1 = QT_IN1 + 3 * I_BR, QT_O1 = QT_BR1 + I_O, QT_UP1 = QT_O1 + I_UP, QT_DN1 = QT_UP1 + I_DN, QTOT = QT_DN1;
__device__ __forceinline__ void ph_convert0(const Args& a, LAS unsigned char* lds, int lane, int wave, int wg, int nwgs) {
    LAS unsigned char* tile = lds + wave * 9216;
    for (int it = wg * 8 + wave; it < I_IN; it += nwgs * 8) cvt_item(a.w_in, DM, INW, (f16*)(a.ws + WS_WIN), DM, tile, it, lane, false, true);
}
__device__ __forceinline__ void cvt_queue_item(const Args& a, int q, LAS unsigned char* tile, int lane) {
    int l = 0, r = q;
    if (q >= QT_DN0) { r = q - QT_DN0; if (r < I_IN) { cvt_item(a.w_in + (size_t)DM * INW, DM, INW, (f16*)(a.ws + WS_WIN + SZ_WIN), DM, tile, r, lane, false, true); return; } r -= I_IN; l = 1; }
    if (r < 3 * I_BR) { const int br = r / I_BR; r -= br * I_BR; cvt_item(a.w_branch + (size_t)(l * 3 + br) * 1024 * DM, 1024, DM, (f16*)(a.ws + WS_WBR + l * SZ_WBR) + br * 1024, 3072, tile, r, lane); return; } r -= 3 * I_BR;
    if (r < I_O) { cvt_item(a.w_o + (size_t)l * DM * DM, DM, DM, (f16*)(a.ws + WS_WO + l * SZ_WO), DM, tile, r, lane); return; } r -= I_O;
    if (r < I_UP) { cvt_item(a.w_up + (size_t)l * DM * 2 * DFF, DM, 2 * DFF, (f16*)(a.ws + WS_WUP + l * SZ_WUP), DM, tile, r, lane, true); return; } r -= I_UP;
    cvt_item(a.w_down + (size_t)l * DFF * DM, DFF, DM, (f16*)(a.ws + WS_WDN + l * SZ_WDN), DFF, tile, r, lane);
}
__device__ __forceinline__ int q_need(int p) {
    return p < 6 ? 0 : p < 7 ? QT_BR0 : p < 8 ? QT_O0 : p < 11 ? QT_UP0 : p < 12 ? QT_DN0 : p < 18 ? QT_IN1 : p < 19 ? QT_BR1 : p < 20 ? QT_O1 : p < 23 ? QT_UP1 : QT_DN1;
}
__device__ __forceinline__ bool q_gemm_phase(int p) { const int j = (p - 2) % 12; return p >= 2 && (j == 0 || j == 5 || j == 6 || j == 8 || j == 10); }
__device__ __forceinline__ void bg_convert(const Args& a, LAS unsigned char* lds, volatile LAS unsigned* MISC, int p, int G, const int wave0) {
    unsigned* ctl = (unsigned*)(a.ws + WS_CTL);
    int tid = tid_of(wave0); asm volatile("" : "+v"(tid));
    const int lane = tid & 63, wave = __builtin_amdgcn_readfirstlane(tid >> 6);
    const bool opp = q_gemm_phase(p); const int need = q_need(p);
    if (opp && tid == 0) __hip_atomic_fetch_add(ctl + CW_QD + 64 * p, 1u, __ATOMIC_RELAXED, __HIP_MEMORY_SCOPE_AGENT);
    if (p == 10 && G >= 256 && (int)blockIdx.x >= 128) ph_modgemv(a, lds, tid, lane, wave, 128 + (int)blockIdx.x - 128, 256, 128);
    const int skip = G > 64 ? 32 : 0;
    if ((int)blockIdx.x < skip) return;
    const int NW = (G - skip) * 8, w = ((int)blockIdx.x - skip) * 8 + wave;
    LAS unsigned char* tile = lds + wave * 9216;
    int k = (int)MISC[16 + wave];
    for (;;) {
        const int q = w + k * NW;
        if (q >= QTOT) { if (wave == 0 && lane == 0) MISC[31] = (unsigned)(p + 1); break; }
        if (q >= need) {
            if (!opp) break;
            if (wave == 0) { if ((unsigned)__builtin_amdgcn_readfirstlane((int)__hip_atomic_load(ctl + CW_QD + 64 * p, __ATOMIC_RELAXED, __HIP_MEMORY_SCOPE_AGENT)) >= (unsigned)G) { if (lane == 0) MISC[31] = (unsigned)(p + 1); break; } }
            else if (MISC[31] == (unsigned)(p + 1)) break;
        }
        cvt_queue_item(a, q, tile, lane);
        ++k;
    }
    if (lane == 0) MISC[16 + wave] = (unsigned)k;
}
__device__ __forceinline__ void ph_modulate0(const Args& a, int lane, int wave) {
    const float* MOD = (const float*)(a.ws + WS_MOD);
    f16* H = (f16*)(a.ws + WS_H);
    for (int row = blockIdx.x * 8 + wave; row < MTOT; row += gridDim.x * 8) {
        const int mr = row < SEQ ? 0 : (row < NLAT ? 1 : 2);
        const f32x4* src = (const f32x4*)(row < NLAT ? a.x + (size_t)row * DM : a.ctx + (size_t)(row - NLAT) * DM) + lane;
        const f32x4* sh = (const f32x4*)(MOD + (size_t)mr * NMOD) + lane; const f32x4* sc = (const f32x4*)(MOD + (size_t)mr * NMOD + DM) + lane;
        u32x2* o = (u32x2*)(H + (size_t)row * DM) + lane;
#pragma unroll 4
        for (int j = 0; j < 16; ++j) { const f32x4 v = src[64 * j], s = sc[64 * j], t = sh[64 * j]; const f32x4 y = v * (s + 1.0f) + t;
            o[64 * j] = (u32x2){pkh(y[0], y[1]), pkh(y[2], y[3])}; }
    }
}

__device__ __forceinline__ void ph_post(const Args& a, int l, int lane, int wave) {
    f16* P = (f16*)(a.ws + WS_P);
    const f32x2* rope = (const f32x2*)(a.ws + WS_ROPE);
    const float* qg = a.q_norm_g + l * HD; const float* kg = a.k_norm_g + l * HD;
    const int gsub = lane >> 3, s = lane & 7;
    const int e0 = (s & 3) * 8 + (s >> 2) * 64;
    const int nitems = MTOT * 36;
    for (int it = (blockIdx.x * 8 + wave) * 8 + gsub; it < nitems; it += gridDim.x * 64) {
        const int row = it / 36, hv = it - row * 36;
        int col, kind;
        if (hv < 8) { col = QA_OFF + hv * HD; kind = 0; } else if (hv < 10) { col = KA_OFF + (hv - 8) * HD; kind = 0; }
        else if (hv < 18) { col = QB_OFF + (hv - 10) * HD; kind = 1; } else if (hv < 20) { col = KB_OFF + (hv - 18) * HD; kind = 2; }
        else if (hv < 28) { col = QR_OFF + (hv - 20) * HD; kind = 0; } else { col = KR_OFF + (hv - 28) * HD; kind = 3; }
        const bool lat = row < NLAT;
        if (!lat && kind == 0) continue;
        f16* p = P + (size_t)row * INW + col + e0;
        const h8 x1 = *(const h8*)p, x2 = *(const h8*)(p + 32);
        float f1[8], f2[8];
#pragma unroll
        for (int j = 0; j < 8; ++j) { f1[j] = (float)x1[j]; f2[j] = (float)x2[j]; }
        if (kind == 1 || kind == 2) {
            float ss = 0.f;
#pragma unroll
            for (int j = 0; j < 8; ++j) ss += f1[j] * f1[j] + f2[j] * f2[j];
            ss += __shfl_xor(ss, 1); ss += __shfl_xor(ss, 2); ss += __shfl_xor(ss, 4);
            const float rs = 1.0f / sqrtf(ss * (1.0f / HD) + RMS_EPS);
            const float* g = (kind == 1 ? qg : kg) + e0;
#pragma unroll
            for (int j = 0; j < 8; ++j) { f1[j] = f1[j] * rs * g[j]; f2[j] = f2[j] * rs * g[32 + j]; }
        }
        if (lat) {
            const int t = row & (SEQ - 1); const int pos = (s < 4) ? (t >> 6) : (t & 63);
            const f32x2* cs = rope + pos * 32 + (s & 3) * 8;
#pragma unroll
            for (int j = 0; j < 8; ++j) { const f32x2 w = cs[j]; const float o1 = f1[j] * w.x - f2[j] * w.y, o2 = f2[j] * w.x + f1[j] * w.y; f1[j] = o1; f2[j] = o2; }
        }
        if (kind == 3) {
#pragma unroll
            for (int j = 0; j < 8; ++j) { f1[j] *= ATT_SCALE; f2[j] *= ATT_SCALE; }
        }
        u32x4 w1, w2; w1.x = pkh(f1[0], f1[1]); w1.y = pkh(f1[2], f1[3]); w1.z = pkh(f1[4], f1[5]); w1.w = pkh(f1[6], f1[7]);
        w2.x = pkh(f2[0], f2[1]); w2.y = pkh(f2[2], f2[3]); w2.z = pkh(f2[4], f2[5]); w2.w = pkh(f2[6], f2[7]);
        *(u32x4*)p = w1; *(u32x4*)(p + 32) = w2;
    }
}
__device__ __forceinline__ void ph_ln(const Args& a, const float* g, const float* b, const float* msh, const float* msc, bool writeH, bool writeOut, int Mrows, int lane, int wave) {
    const f16* Z = (const f16*)(a.ws + WS_Z); f16* LAT = (f16*)(a.ws + WS_LAT); f16* H = (f16*)(a.ws + WS_H);
    for (int row = blockIdx.x * 8 + wave; row < Mrows; row += gridDim.x * 8) {
        const h8* zr = (const h8*)(Z + (size_t)row * DM) + lane;
        f32x4 v[8][2]; float s = 0.f;
#pragma unroll
        for (int j = 0; j < 8; ++j) { const h8 t = zr[64 * j]; v[j][0] = (f32x4){(float)t[0], (float)t[1], (float)t[2], (float)t[3]}; v[j][1] = (f32x4){(float)t[4], (float)t[5], (float)t[6], (float)t[7]};
            s += ((v[j][0][0] + v[j][0][1]) + (v[j][0][2] + v[j][0][3])) + ((v[j][1][0] + v[j][1][1]) + (v[j][1][2] + v[j][1][3])); }
        const float mean = wave_sum(s) * (1.0f / DM); float s2 = 0.f;
#pragma unroll
        for (int j = 0; j < 8; ++j)
#pragma unroll
            for (int hh = 0; hh < 2; ++hh) { v[j][hh] = v[j][hh] - mean; s2 += (v[j][hh][0] * v[j][hh][0] + v[j][hh][1] * v[j][hh][1]) + (v[j][hh][2] * v[j][hh][2] + v[j][hh][3] * v[j][hh][3]); }
        const float rstd = 1.0f / sqrtf(wave_sum(s2) * (1.0f / DM) + LN_EPS);
        const int mr = row < SEQ ? 0 : (row < NLAT ? 1 : 2);
        u32x4* lo = (u32x4*)(LAT + (size_t)row * DM) + lane;
        u32x4* ho = (u32x4*)(H + (size_t)row * DM) + lane;
        float* oo = a.out + (size_t)row * DM + lane * 8;
        const float* gg = g + lane * 8; const float* bb = b + lane * 8;
        const float* sh = msh + (size_t)mr * NMOD + lane * 8; const float* sc = msc + (size_t)mr * NMOD + lane * 8;
#pragma unroll
        for (int j = 0; j < 8; ++j) {
            const f32x4 y0 = v[j][0] * rstd * *(const f32x4*)(gg + 512 * j) + *(const f32x4*)(bb + 512 * j), y1 = v[j][1] * rstd * *(const f32x4*)(gg + 512 * j + 4) + *(const f32x4*)(bb + 512 * j + 4);
            if (writeOut) { if (row < NLAT) { *(f32x4*)(oo + 512 * j) = y0; *(f32x4*)(oo + 512 * j + 4) = y1; } }
            else lo[64 * j] = (u32x4){pkh(y0[0], y0[1]), pkh(y0[2], y0[3]), pkh(y1[0], y1[1]), pkh(y1[2], y1[3])};
            if (writeH) { const f32x4 h0 = y0 * (*(const f32x4*)(sc + 512 * j) + 1.0f) + *(const f32x4*)(sh + 512 * j), h1 = y1 * (*(const f32x4*)(sc + 512 * j + 4) + 1.0f) + *(const f32x4*)(sh + 512 * j + 4);
                ho[64 * j] = (u32x4){pkh(h0[0], h0[1]), pkh(h0[2], h0[3]), pkh(h1[0], h1[1]), pkh(h1[2], h1[3])}; } }
    }
}
__device__ __forceinline__ void ph_convfix(const Args& a, int l, int Mrows, int tid) {
    const float* GE = (const float*)(a.ws + WS_SLAB); const float* XP = GE + (size_t)34 * 2 * DFF; const float* UPE = XP + (size_t)34 * 2 * DFF;
    f16* ACT = (f16*)(a.ws + WS_ACT);
    const float* cw = a.conv_w + (size_t)l * 3 * DFF;
    constexpr int NF4 = DFF / 4;
    const int nitems = (Mrows / 256) * 2 * NF4;
    for (int it = blockIdx.x * 512 + tid; it < nitems; it += gridDim.x * 512) {
        const int pe = it / NF4, f = (it - pe * NF4) * 4, pm = pe >> 1, e = pe & 1;
        f32x4 x = *(const f32x4*)(XP + (size_t)pe * DFF + f); const f32x4 up = *(const f32x4*)(UPE + (size_t)pe * DFF + f);
        const bool has = e == 0 ? !(pm >= 32 || (pm & 15) == 0) : !(pm >= 32 || (pm & 15) == 15);
        if (has) { const f32x4 ge = *(const f32x4*)(GE + (size_t)((e ? pm + 1 : pm - 1) * 2 + (e ? 0 : 1)) * DFF + f); const f32x4 w = *(const f32x4*)(cw + (e ? 2 : 0) * DFF + f); x += w * ge; }
        float o[4];
#pragma unroll
        for (int j = 0; j < 4; ++j) o[j] = x[j] * sigmoidf_(x[j]) * up[j];
        *(u32x2*)(ACT + (size_t)(pm * 256 + 255 * e) * DFF + f) = (u32x2){pkh(o[0], o[1]), pkh(o[2], o[3])};
    }
}

namespace att {
constexpr int D = 128, NW = 8, QBLK = 32, KVBLK = 64;
constexpr float SCALE = ATT_SCALE;
constexpr float THR = 8.f;
constexpr int LDQ = INW, LDK = INW, LDO = 3072;
constexpr size_t SHM_V = KVBLK * D * 2, SHM_K = KVBLK * D * 2, SHM_ATTN = 2 * SHM_V + 2 * SHM_K + NW * 64 * 4;
#define KSWZ(row, colB) ((row) * 256 + ((colB) ^ (((row) & 7) << 4)))
#define SBAR() __builtin_amdgcn_sched_barrier(0)
__device__ __forceinline__ int crow(int r, int hi) { return (r & 3) + 8 * (r >> 2) + 4 * hi; }
struct Unit { const f16* Q; const f16* Kc; const f16* Vc; const f16* Kl; const f16* Vl; f16* O; int NT; int qpos0; int kpos0; float sink; int has_sink; };
template <bool MASK>
__device__ __forceinline__ void partialSM(f32x16& p0, f32x16& p1, float& m_reg, float& mn, float& alpha, int dq, bool domask) {
    constexpr float C = SCALE * 1.4426950408889634f;
    if (MASK) { if (domask) {
#pragma unroll
        for (int r = 0; r < 16; ++r) { const int k0 = (r & 3) + 8 * (r >> 2); const int d0 = dq - k0, d1 = dq - 32 - k0;
            p0[r] = (d0 > 128 || d0 < -128) ? -1e30f : p0[r]; p1[r] = (d1 > 128 || d1 < -128) ? -1e30f : p1[r]; } } }
    float pmax = p0[0];
#pragma unroll
    for (int r = 1; r < 16; ++r) pmax = fmaxf(pmax, p0[r]);
#pragma unroll
    for (int r = 0; r < 16; ++r) pmax = fmaxf(pmax, p1[r]);
    { auto rr = __builtin_amdgcn_permlane32_swap(__float_as_uint(pmax), __float_as_uint(pmax), false, false);
      pmax = fmaxf(__uint_as_float(rr[0]), __uint_as_float(rr[1])); }
    if (__builtin_expect(__all(pmax - m_reg <= THR / SCALE), 1)) { mn = m_reg; alpha = 1.f; }
    else { mn = fmaxf(m_reg, pmax); alpha = __builtin_amdgcn_exp2f((m_reg - mn) * C); m_reg = mn; }
    const float mnC = -mn * C;
#pragma unroll
    for (int r = 0; r < 16; ++r) p0[r] = fmaf(p0[r], C, mnC);
#pragma unroll
    for (int r = 0; r < 16; ++r) p1[r] = fmaf(p1[r], C, mnC);
#pragma unroll
    for (int r = 0; r < 16; ++r) p0[r] = __builtin_amdgcn_exp2f(p0[r]);
}
__device__ __forceinline__ void finishSM(f32x16& p0, f32x16& p1, float alpha, float& l_reg, h8& pa0, h8& pa1, h8& pa2, h8& pa3) {
#pragma unroll
    for (int r = 0; r < 16; ++r) p1[r] = __builtin_amdgcn_exp2f(p1[r]);
    float ps = 0;
#pragma unroll
    for (int r = 0; r < 16; ++r) ps += p0[r];
#pragma unroll
    for (int r = 0; r < 16; ++r) ps += p1[r];
    { auto rr = __builtin_amdgcn_permlane32_swap(__float_as_uint(ps), __float_as_uint(ps), false, false);
      ps = __uint_as_float(rr[0]) + __uint_as_float(rr[1]); }
    l_reg = l_reg * alpha + ps;
#define PK4(P, BASE, OUT) do { unsigned a0 = pkh(P[BASE + 0], P[BASE + 1]), a1 = pkh(P[BASE + 2], P[BASE + 3]);   \
    unsigned b0 = pkh(P[BASE + 4], P[BASE + 5]), b1 = pkh(P[BASE + 6], P[BASE + 7]);                              \
    auto r0 = __builtin_amdgcn_permlane32_swap(a0, b0, false, false); auto r1 = __builtin_amdgcn_permlane32_swap(a1, b1, false, false); \
    u32x4 w = {r0[0], r1[0], r0[1], r1[1]}; OUT = __builtin_bit_cast(h8, w); } while (0)
    PK4(p0, 0, pa0); PK4(p0, 8, pa1); PK4(p1, 0, pa2); PK4(p1, 8, pa3);
#undef PK4
}
__device__ __forceinline__ void qkt(f32x16& p0, f32x16& p1, const char* Ks, const h8* qr, int r32, int hi) {
    p0 = f32x16{}; p1 = f32x16{};
#pragma unroll
    for (int d0 = 0; d0 < 8; ++d0) { const int cb = (d0 * 16 + hi * 8) * 2;
        const h8 b0 = *reinterpret_cast<const h8*>(Ks + KSWZ(r32, cb));
        const h8 b1 = *reinterpret_cast<const h8*>(Ks + KSWZ(32 + r32, cb));
        p0 = __builtin_amdgcn_mfma_f32_32x32x16_f16(b0, qr[d0], p0, 0, 0, 0);
        p1 = __builtin_amdgcn_mfma_f32_32x32x16_f16(b1, qr[d0], p1, 0, 0, 0); }
}
__device__ __forceinline__ int v_st(int k, int c) { const int kk = (k & ~0xC) | ((k & 4) << 1) | ((k & 8) >> 1); return ((kk >> 3) * 4 + (c >> 5)) * 512 + ((kk & 7) * 32 + (c & 31)) * 2; }
__device__ __forceinline__ int v_rd_base(int lane) { return ((lane & 3) << 3) | (((lane >> 2) & 3) << 6) | (((lane >> 4) & 1) << 5) | (((lane >> 5) & 1) << 8); }
constexpr int v_rd_off(int d0, int ks, int half) { return d0 * 512 + ks * 4096 + half * 2048; }
template <int OFF> __device__ __forceinline__ s16x4 tr_read(int vb) {
    s16x4 r; asm volatile("ds_read_b64_tr_b16 %0, %1 offset:%2" : "=&v"(r) : "v"(vb), "i"(OFF) : "memory"); return r;
}
template <int D0> __device__ __forceinline__ void pv_one(f32x16& od, int vb, h8 pa0, h8 pa1, h8 pa2, h8 pa3) {
    const s16x4 l0 = tr_read<v_rd_off(D0, 0, 0)>(vb), h0 = tr_read<v_rd_off(D0, 0, 1)>(vb), l1 = tr_read<v_rd_off(D0, 1, 0)>(vb), h1 = tr_read<v_rd_off(D0, 1, 1)>(vb);
    const s16x4 l2 = tr_read<v_rd_off(D0, 2, 0)>(vb), h2_ = tr_read<v_rd_off(D0, 2, 1)>(vb), l3 = tr_read<v_rd_off(D0, 3, 0)>(vb), h3 = tr_read<v_rd_off(D0, 3, 1)>(vb);
    asm volatile("s_waitcnt lgkmcnt(0)" ::: "memory"); SBAR();
#define PK(L, H) __builtin_bit_cast(h8, (__attribute__((ext_vector_type(8))) short){L[0], L[1], L[2], L[3], H[0], H[1], H[2], H[3]})
    od = __builtin_amdgcn_mfma_f32_32x32x16_f16(pa0, PK(l0, h0), od, 0, 0, 0);
    od = __builtin_amdgcn_mfma_f32_32x32x16_f16(pa1, PK(l1, h1), od, 0, 0, 0);
    od = __builtin_amdgcn_mfma_f32_32x32x16_f16(pa2, PK(l2, h2_), od, 0, 0, 0);
    od = __builtin_amdgcn_mfma_f32_32x32x16_f16(pa3, PK(l3, h3), od, 0, 0, 0);
#undef PK
}
__device__ __forceinline__ void pv_d0(f32x16* o, int vb, h8 pa0, h8 pa1, h8 pa2, h8 pa3) {
    pv_one<0>(o[0], vb, pa0, pa1, pa2, pa3); pv_one<1>(o[1], vb, pa0, pa1, pa2, pa3); pv_one<2>(o[2], vb, pa0, pa1, pa2, pa3); pv_one<3>(o[3], vb, pa0, pa1, pa2, pa3);
}
template <bool MASK>
__device__ __forceinline__ void attn_unit(const Unit& u, char* lds, const int wave0) {
    int tid = tid_of(wave0); asm volatile("" : "+v"(tid));
    const int wid = tid >> 6, lane = tid & 63, r32 = lane & 31, hi = lane >> 5;
    char* V_lds = lds; char* K_lds = lds + 2 * SHM_V;
    float* ws = (float*)(lds + 2 * SHM_V + 2 * SHM_K) + wid * 64; float* li_l = ws; float* al_l = ws + 32;
    float m_reg = u.has_sink ? u.sink * (1.0f / SCALE) : -1e30f, l_reg = u.has_sink ? 1.0f : 0.0f; f32x16 o[4] = {}; h8 qr[8];
    const f16* Qw = u.Q + (long)(wid * QBLK + r32) * LDQ + hi * 8;
#pragma unroll
    for (int d0 = 0; d0 < 8; ++d0) qr[d0] = *reinterpret_cast<const h8*>(Qw + d0 * 16);
    const int sr = tid >> 4, sc = (tid & 15) * 8, vst0 = v_st(sr, sc), vst1 = v_st(32 + sr, sc);
    const int vb0 = (int)(uintptr_t)V_lds + v_rd_base(lane);
    struct { h8 vs0, vs1, ks0, ks1; } sr_[2];
    const int qposw = u.qpos0 + wid * QBLK + r32;
#define TILEK(j) ((j) < 4 ? u.Kc + (long)(j) * KVBLK * LDK : u.Kl + (long)((j) - 4) * KVBLK * LDK)
#define TILEV(j) ((j) < 4 ? u.Vc + (long)(j) * KVBLK * LDK : u.Vl + (long)((j) - 4) * KVBLK * LDK)
#define SLOAD(i, j) do { const f16* kp_ = TILEK(j); const f16* vp_ = TILEV(j); sr_[i].vs0 = *(const h8*)(vp_ + (long)sr * LDK + sc); sr_[i].vs1 = *(const h8*)(vp_ + (long)(32 + sr) * LDK + sc); \
    sr_[i].ks0 = *(const h8*)(kp_ + (long)sr * LDK + sc); sr_[i].ks1 = *(const h8*)(kp_ + (long)(32 + sr) * LDK + sc); } while (0)
#define SWRITE(b, i) do { *(h8*)(V_lds + (b) * SHM_V + vst0) = sr_[i].vs0;          \
    *(h8*)(V_lds + (b) * SHM_V + vst1) = sr_[i].vs1; const int kc = sc * 2;               \
    *(h8*)(K_lds + (b) * SHM_K + KSWZ(sr, kc)) = sr_[i].ks0;                       \
    *(h8*)(K_lds + (b) * SHM_K + KSWZ(32 + sr, kc)) = sr_[i].ks1; } while (0)
#define SWAIT() asm volatile("s_waitcnt vmcnt(4)" ::: "memory")
#define RESC(a) do { if (__any((a) < 1.f)) { if (hi == 0) al_l[r32] = (a); asm volatile("s_waitcnt lgkmcnt(0)" ::: "memory"); \
    _Pragma("unroll") for (int d = 0; d < 4; ++d) _Pragma("unroll") for (int r = 0; r < 16; ++r) o[d][r] *= al_l[crow(r, hi)]; } } while (0)
#define DQ(j) (qposw - (u.kpos0 + ((j) - 4) * KVBLK) - 4 * hi)
    f32x16 pA0, pA1, pB0, pB1; float mnA, mnB, alA, alB; h8 pa0, pa1, pa2, pa3; const int NT = u.NT;
    constexpr int SE = 0, SO = 1;
    SLOAD(SE, 0); asm volatile("s_waitcnt vmcnt(0)" ::: "memory"); SWRITE(0, SE); __syncthreads();
    qkt(pA0, pA1, K_lds, qr, r32, hi); partialSM<MASK>(pA0, pA1, m_reg, mnA, alA, 0, false);
    SLOAD(SO, 1); if (2 < NT) SLOAD(SE, 2);
    SWAIT(); SWRITE(1, SO); __syncthreads();
    for (int j = 1; j + 1 < NT; j += 2) {
        SBAR(); qkt(pB0, pB1, K_lds + SHM_K, qr, r32, hi);
        finishSM(pA0, pA1, alA, l_reg, pa0, pa1, pa2, pa3); SBAR();
        SLOAD(SO, j + 2); SBAR();
        pv_d0(o, vb0, pa0, pa1, pa2, pa3); partialSM<MASK>(pB0, pB1, m_reg, mnB, alB, DQ(j), j >= 4);
        __syncthreads(); SWAIT(); SWRITE(0, SE);
        RESC(alB); __syncthreads();
        SBAR(); qkt(pA0, pA1, K_lds, qr, r32, hi);
        finishSM(pB0, pB1, alB, l_reg, pa0, pa1, pa2, pa3); SBAR();
        if (j + 3 < NT) SLOAD(SE, j + 3); SBAR();
        pv_d0(o, vb0 + (int)SHM_V, pa0, pa1, pa2, pa3); partialSM<MASK>(pA0, pA1, m_reg, mnA, alA, DQ(j + 1), j + 1 >= 4);
        __syncthreads(); SWAIT(); SWRITE(1, SO);
        RESC(alA); __syncthreads();
    }
    SBAR(); qkt(pB0, pB1, K_lds + SHM_K, qr, r32, hi);
    finishSM(pA0, pA1, alA, l_reg, pa0, pa1, pa2, pa3); SBAR();
    pv_d0(o, vb0, pa0, pa1, pa2, pa3); partialSM<MASK>(pB0, pB1, m_reg, mnB, alB, DQ(NT - 1), NT - 1 >= 4);
    __syncthreads(); RESC(alB);
    finishSM(pB0, pB1, alB, l_reg, pa0, pa1, pa2, pa3); SBAR();
    pv_d0(o, vb0 + (int)SHM_V, pa0, pa1, pa2, pa3);
    if (hi == 0) li_l[r32] = l_reg; asm volatile("s_waitcnt lgkmcnt(0)" ::: "memory");
    float rli[16];
#pragma unroll
    for (int r = 0; r < 16; ++r) rli[r] = __builtin_amdgcn_rcpf(li_l[crow(r, hi)]);
    f16* Ow = u.O + (long)(wid * QBLK) * LDO;
#pragma unroll
    for (int r = 0; r < 16; ++r) { const int orow = crow(r, hi);
#pragma unroll
        for (int d0 = 0; d0 < 4; ++d0) Ow[(long)orow * LDO + d0 * 32 + r32] = (f16)(o[d0][r] * rli[r]); }
    __syncthreads();
#undef TILEK
#undef TILEV
#undef SLOAD
#undef SWRITE
#undef SWAIT
#undef RESC
#undef DQ
}
}

__device__ __forceinline__ int chunk_row0(int cidx) { const int b = cidx / 34, cid = cidx - b * 34; return cid < 2 ? NLAT + b * CTXL + cid * 128 : b * SEQ + (cid - 2) * 128; }
constexpr int RS = 136;
template <int NOUT>
__device__ __forceinline__ void load_transposed(const f16* src, LAS f16* T0, LAS f16* T1, float lg0, float lg1, int tid) {
#pragma unroll
    for (int it = 0; it < 4; ++it) { const int idx = tid + it * 512, g = idx >> 7, t = idx & 127;
        const h8 x = *(const h8*)(src + (size_t)t * INW + g * 8);
        if (NOUT == 1) {
#pragma unroll
            for (int i = 0; i < 8; ++i) T0[(g * 8 + i) * RS + t] = x[i];
        } else {
            const float wf = __builtin_amdgcn_exp2f(lg0 * (float)(127 - t)), wb = __builtin_amdgcn_exp2f(lg1 * (float)t);
#pragma unroll
            for (int i = 0; i < 8; ++i) { T0[(g * 8 + i) * RS + t] = (f16)((float)x[i] * wf); T1[(g * 8 + i) * RS + t] = (f16)((float)x[i] * wb); }
        } }
}
__device__ __forceinline__ void load_rows(const f16* src, size_t ld, LAS f16* T, int tid) {
#pragma unroll
    for (int it = 0; it < 4; ++it) { const int idx = tid + it * 512, r = idx >> 4, c = (idx & 15) * 8;
        *(LAS h8*)(T + r * RS + c) = *(const h8*)(src + (size_t)r * ld + c); }
}
__device__ __forceinline__ void ret_c1_unit(const Args& a, int l, int cidx, int h, LAS unsigned char* lds, const int wave0) {
    int tid = tid_of(wave0); asm volatile("" : "+v"(tid));
    const int lane = tid & 63, wave = __builtin_amdgcn_readfirstlane(tid >> 6);
    const f16* P = (const f16*)(a.ws + WS_P);
    float* UT = (float*)(a.ws + WS_UT);
    LAS f16* VT = (LAS f16*)lds; LAS f16* KTf = VT + 128 * RS; LAS f16* KTb = KTf + 128 * RS;
    const float lgf = -__expf(a.ret_decay[(l * 2 + 0) * 8 + h]) * 1.4426950408889634f, lgb = -__expf(a.ret_decay[(l * 2 + 1) * 8 + h]) * 1.4426950408889634f;
    const int row0 = chunk_row0(cidx);
    load_transposed<1>(P + (size_t)row0 * INW + VR_OFF + h * HD, VT, VT, 0.f, 0.f, tid);
    load_transposed<2>(P + (size_t)row0 * INW + KR_OFF + h * HD, KTf, KTb, lgf, lgb, tid);
    __syncthreads();
    const int fr = lane & 15, fq = lane >> 4;
    f32x4 af[8], ab[8];
#pragma unroll
    for (int n = 0; n < 8; ++n) { af[n] = (f32x4){0.f, 0.f, 0.f, 0.f}; ab[n] = af[n]; }
#pragma unroll
    for (int ks = 0; ks < 4; ++ks) {
        const h8 A = *(const LAS h8*)(VT + (16 * wave + fr) * RS + 32 * ks + 8 * fq);
#pragma unroll
        for (int n = 0; n < 8; ++n) {
            const h8 Bf = *(const LAS h8*)(KTf + (16 * n + fr) * RS + 32 * ks + 8 * fq);
            const h8 Bb = *(const LAS h8*)(KTb + (16 * n + fr) * RS + 32 * ks + 8 * fq);
            af[n] = __builtin_amdgcn_mfma_f32_16x16x32_f16(Bf, A, af[n], 0, 0, 0);
            ab[n] = __builtin_amdgcn_mfma_f32_16x16x32_f16(Bb, A, ab[n], 0, 0, 0);
        }
    }
    float* uf = UT + ((size_t)(cidx * 8 + h) * 2 + 0) * 16384 + (16 * wave + fr) * 128 + 4 * fq; float* ub = uf + 16384;
#pragma unroll
    for (int n = 0; n < 8; ++n) { *(f32x4*)(uf + 16 * n) = af[n]; *(f32x4*)(ub + 16 * n) = ab[n]; }
    __syncthreads();
}
__device__ __forceinline__ void ph_scan(const Args& a, int l, int tid) {
    const float* UT = (const float*)(a.ws + WS_UT); f16* ST = (f16*)(a.ws + WS_ST);
    for (int it = blockIdx.x * 512 + tid; it < NBATCH * 8 * 2 * 4096; it += gridDim.x * 512) {
        const int e4 = it & 4095, dir = (it >> 12) & 1, h = (it >> 13) & 7, b = it >> 16;
        const float decay = __expf(-__expf(a.ret_decay[(l * 2 + dir) * 8 + h]) * 128.0f);
        f32x4 s = {0.f, 0.f, 0.f, 0.f};
#pragma unroll 17
        for (int i = 0; i < 34; ++i) {
            const int cid = dir == 0 ? i : (i < 2 ? 1 - i : 35 - i);
            const size_t off = ((size_t)((b * 34 + cid) * 8 + h) * 2 + dir) * 16384 + (size_t)e4 * 4;
            const f32x4 uv = *(const f32x4*)(UT + off);
            *(u32x2*)(ST + off) = (u32x2){pkh(s[0], s[1]), pkh(s[2], s[3])};
            s = s * decay + uv;
        }
    }
}
__device__ __forceinline__ void ret_c3_unit(const Args& a, int l, int cidx, int h, LAS unsigned char* lds, const int wave0) {
    int tid = tid_of(wave0); asm volatile("" : "+v"(tid));
    const int lane = tid & 63, wave = __builtin_amdgcn_readfirstlane(tid >> 6);
    unsigned char* wsl = a.ws; asm volatile("" : "+s"(wsl));
    const f16* P = (const f16*)(wsl + WS_P);
    const f16* ST = (const f16*)(wsl + WS_ST);
    f16* Yc = (f16*)(wsl + WS_Y) + 2048;
    LAS f16* KS = (LAS f16*)lds; LAS f16* VT = KS + 128 * RS; LAS f16* ATT = VT + 128 * RS + wave * 16 * RS;
    const float lgf = -__expf(a.ret_decay[(l * 2 + 0) * 8 + h]) * 1.4426950408889634f, lgb = -__expf(a.ret_decay[(l * 2 + 1) * 8 + h]) * 1.4426950408889634f;
    const int row0 = chunk_row0(cidx);
    const int fr = lane & 15, fq = lane >> 4;
    const int pc = 16 * wave + fr;
    const f16* STf = ST + ((size_t)(cidx * 8 + h) * 2 + 0) * 16384; const f16* STb = STf + 16384;
    h8 kr[4], vr[4], sf[4], sb[4], qf[4]; h4 grv[8]; f32x4 gnv[8];
#pragma unroll
    for (int it = 0; it < 4; ++it) { const int idx = tid + it * 512, r = idx >> 4, c = (idx & 15) * 8, g = idx >> 7, t = idx & 127;
        kr[it] = *(const h8*)(P + (size_t)(row0 + r) * INW + KR_OFF + h * HD + c);
        vr[it] = *(const h8*)(P + (size_t)(row0 + t) * INW + VR_OFF + h * HD + g * 8); }
#pragma unroll
    for (int ks = 0; ks < 4; ++ks) qf[ks] = *(const h8*)(P + (size_t)(row0 + pc) * INW + QR_OFF + h * HD + 32 * ks + 8 * fq);
#pragma unroll
    for (int it = 0; it < 4; ++it) { const int idx = tid + it * 512, r = idx >> 4, c = (idx & 15) * 8; sf[it] = *(const h8*)(STf + r * 128 + c); }
    const float* gn = a.ret_gn_g + l * 1024 + h * HD;
#pragma unroll
    for (int it = 0; it < 4; ++it) { const int idx = tid + it * 512, r = idx >> 4, c = (idx & 15) * 8, g = idx >> 7, t = idx & 127;
        *(LAS h8*)(KS + r * RS + c) = kr[it];
#pragma unroll
        for (int i = 0; i < 8; ++i) VT[(g * 8 + i) * RS + t] = vr[it][i]; }
    __syncthreads();
#pragma unroll
    for (int it = 0; it < 4; ++it) { const int idx = tid + it * 512, r = idx >> 4, c = (idx & 15) * 8; sb[it] = *(const h8*)(STb + r * 128 + c); }
#pragma unroll
    for (int n = 0; n < 8; ++n) grv[n] = *(const h4*)(P + (size_t)(row0 + pc) * INW + GR_OFF + h * HD + 16 * n + 4 * fq);
    f32x4 acc[8];
#pragma unroll
    for (int n = 0; n < 8; ++n) acc[n] = (f32x4){0.f, 0.f, 0.f, 0.f};
#pragma unroll
    for (int ks = 0; ks < 4; ++ks)
#pragma unroll
        for (int n = 0; n < 8; ++n) acc[n] = __builtin_amdgcn_mfma_f32_16x16x32_f16(*(const LAS h8*)(KS + (16 * n + fr) * RS + 32 * ks + 8 * fq), qf[ks], acc[n], 0, 0, 0);
#pragma unroll
    for (int n = 0; n < 8; ++n) { h4 w;
#pragma unroll
        for (int r = 0; r < 4; ++r) { const int m = 16 * n + 4 * fq + r, dl = pc - m;
            const float wgt = dl >= 0 ? __builtin_amdgcn_exp2f(lgf * (float)dl) : __builtin_amdgcn_exp2f(lgb * (float)(-dl));
            w[r] = (f16)(acc[n][r] * wgt); }
        *(LAS h4*)(ATT + fr * RS + 16 * n + 4 * fq) = w; }
    __syncthreads();
#pragma unroll
    for (int it = 0; it < 4; ++it) { const int idx = tid + it * 512, r = idx >> 4, c = (idx & 15) * 8; *(LAS h8*)(KS + r * RS + c) = sf[it]; }
    f32x4 o[8];
#pragma unroll
    for (int n = 0; n < 8; ++n) o[n] = (f32x4){0.f, 0.f, 0.f, 0.f};
#pragma unroll
    for (int ks = 0; ks < 4; ++ks) { const h8 B = *(const LAS h8*)(ATT + fr * RS + 32 * ks + 8 * fq);
#pragma unroll
        for (int n = 0; n < 8; ++n) o[n] = __builtin_amdgcn_mfma_f32_16x16x32_f16(*(const LAS h8*)(VT + (16 * n + fr) * RS + 32 * ks + 8 * fq), B, o[n], 0, 0, 0); }
    __syncthreads();
#pragma unroll
    for (int it = 0; it < 4; ++it) { const int idx = tid + it * 512, r = idx >> 4, c = (idx & 15) * 8; *(LAS h8*)(VT + r * RS + c) = sb[it]; }
#pragma unroll
    for (int n = 0; n < 8; ++n) acc[n] = (f32x4){0.f, 0.f, 0.f, 0.f};
#pragma unroll
    for (int ks = 0; ks < 4; ++ks)
#pragma unroll
        for (int n = 0; n < 8; ++n) acc[n] = __builtin_amdgcn_mfma_f32_16x16x32_f16(*(const LAS h8*)(KS + (16 * n + fr) * RS + 32 * ks + 8 * fq), qf[ks], acc[n], 0, 0, 0);
    { const float dq = __builtin_amdgcn_exp2f(lgf * (float)(pc + 1));
#pragma unroll
      for (int n = 0; n < 8; ++n) o[n] += dq * acc[n]; }
    __syncthreads();
#pragma unroll
    for (int n = 0; n < 8; ++n) gnv[n] = *(const f32x4*)(gn + 16 * n + 4 * fq);
#pragma unroll
    for (int n = 0; n < 8; ++n) acc[n] = (f32x4){0.f, 0.f, 0.f, 0.f};
#pragma unroll
    for (int ks = 0; ks < 4; ++ks)
#pragma unroll
        for (int n = 0; n < 8; ++n) acc[n] = __builtin_amdgcn_mfma_f32_16x16x32_f16(*(const LAS h8*)(VT + (16 * n + fr) * RS + 32 * ks + 8 * fq), qf[ks], acc[n], 0, 0, 0);
    { const float dq = __builtin_amdgcn_exp2f(lgb * (float)(128 - pc));
#pragma unroll
      for (int n = 0; n < 8; ++n) o[n] += dq * acc[n]; }
    float s = 0.f;
#pragma unroll
    for (int n = 0; n < 8; ++n) s += (o[n][0] + o[n][1]) + (o[n][2] + o[n][3]);
    s += __shfl_xor(s, 16); s += __shfl_xor(s, 32);
    const float mean = s * (1.0f / 128.0f); float q = 0.f;
#pragma unroll
    for (int n = 0; n < 8; ++n) { const f32x4 d = o[n] - mean; q += (d[0] * d[0] + d[1] * d[1]) + (d[2] * d[2] + d[3] * d[3]); }
    q += __shfl_xor(q, 16); q += __shfl_xor(q, 32);
    const float rstd = 1.0f / sqrtf(q * (1.0f / 128.0f) + GN_EPS);
    f16* yrow = Yc + (size_t)(row0 + pc) * 3072 + h * HD + 4 * fq;
#pragma unroll
    for (int n = 0; n < 8; ++n) { h4 w;
#pragma unroll
        for (int r = 0; r < 4; ++r) { const float gr = (float)grv[n][r]; w[r] = (f16)(gr * sigmoidf_(gr) * ((o[n][r] - mean) * rstd * gnv[n][r])); }
        *(h4*)(yrow + 16 * n) = w; }
    __syncthreads();
}

constexpr int N_PHASES = 26;
__global__ void __launch_bounds__(512, 2) mixer_fwd(Args a) {
    extern __shared__ __attribute__((aligned(16))) unsigned char lds_raw[];
    LAS unsigned char* lds = (LAS unsigned char*)lds_raw;
    const int tid = threadIdx.x, lane = tid & 63, wave = __builtin_amdgcn_readfirstlane(tid >> 6);
    const int wave0 = wave;
    const int G = gridDim.x;
    volatile LAS unsigned* MISC = (volatile LAS unsigned*)(lds + MISC_OFF);
    for (int u = tid; u < (LDS_BYTES - RING_BYTES) / 4; u += 512) ((LAS unsigned*)(lds + RING_BYTES))[u] = 0u;
    __syncthreads();
    unsigned* ctl = (unsigned*)(a.ws + WS_CTL);
    XcdBarrier bar; bar.bar = ctl + CW_BAR; bar.x = 0; bar.st = nullptr;
    if (!MK_PER_PHASE) bar = xcd_barrier_post(ctl + CW_BAR, MISC + 8, tid);
    const int lo = a.ph_lo, hi = a.ph_hi;
#ifndef PH_MASK
#define PH_MASK 0xFFFFFFFFu
#endif
#define PH_ON(b) (((PH_MASK) >> (b)) & 1u)
#ifndef RPT_MASK
#define RPT_MASK 0u
#endif
#define NREP(b) ((((RPT_MASK) >> (b)) & 1u) ? 2 : 1)
#define REPBAR(b, rep) do { if (NREP(b) == 2 && (rep) == 0) xcd_barrier(bar, wave0); } while (0)
#define IN(k) (lo <= (k) && (k) < hi)
#define SEAM(k) do { if (IN(k)) { if ((k) >= 2) bg_convert(a, lds, MISC, (k), G, wave0); if (IN((k) + 1)) xcd_barrier(bar, wave0); } } while (0)
#define TL() int tid = tid_of(wave0); asm volatile("" : "+v"(tid)); const int lane = tid & 63, wave = __builtin_amdgcn_readfirstlane(tid >> 6); (void)lane; (void)wave;
#define WSP() unsigned char* ws_ = a.ws; asm volatile("" : "+s"(ws_)); \
    float* MOD = (float*)(ws_ + WS_MOD); f16* H = (f16*)(ws_ + WS_H); f16* P = (f16*)(ws_ + WS_P); f16* Y = (f16*)(ws_ + WS_Y); f16* MH = (f16*)(ws_ + WS_MH); \
    f16* Z = (f16*)(ws_ + WS_Z); f16* LAT = (f16*)(ws_ + WS_LAT); f16* ACT = (f16*)(ws_ + WS_ACT); float* slab = (float*)(ws_ + WS_SLAB); unsigned* ctl_ = (unsigned*)(ws_ + WS_CTL); \
    const float* modl = MOD + (size_t)l * 3 * NMOD; (void)H; (void)P; (void)Y; (void)MH; (void)Z; (void)LAT; (void)ACT; (void)slab; (void)ctl_; (void)modl;
    if (PH_ON(0) && IN(0)) _Pragma("unroll") for (int rep_ = 0; rep_ < NREP(0); ++rep_) { {
        if (blockIdx.x == 0) rope_table((f32x2*)(a.ws + WS_ROPE), tid);
        if (G >= 256) {
            if ((int)blockIdx.x < 128) ph_modgemv(a, lds, tid, lane, wave, (int)blockIdx.x, 128, 128);
            else ph_convert0(a, lds, lane, wave, (int)blockIdx.x - 128, G - 128);
        } else { ph_modgemv(a, lds, tid, lane, wave, (int)blockIdx.x, 256, G); ph_convert0(a, lds, lane, wave, (int)blockIdx.x, G); }
    } REPBAR(0, rep_); }
    SEAM(0);
    if (PH_ON(1) && IN(1)) _Pragma("unroll") for (int rep_ = 0; rep_ < NREP(1); ++rep_) { { ph_modulate0(a, lane, wave); } REPBAR(1, rep_); }
    SEAM(1);

#pragma unroll 1
    for (int l = 0; l < 2; ++l) {
        const int pb = 2 + 12 * l;
        const bool last = (l == 1);
        const int Mrows = last ? NLAT : MTOT;
        if (PH_ON(2) && IN(pb + 0)) _Pragma("unroll") for (int rep_ = 0; rep_ < NREP(2); ++rep_) { { WSP();
            pg8::Gemm g{H, (const f16*)(a.ws + WS_WIN + l * SZ_WIN), MTOT, INW, DM}; pg8::SKOrder S; S.init(last ? NLAT : MTOT, INW, DM, G, (int)blockIdx.x, last ? 24 : 0);
            pg8::EpiIn E{P, (const f32x2*)(ws_ + WS_ROPE), a.q_norm_g + l * HD, a.k_norm_g + l * HD, (LAS float*)(lds + RING_BYTES + 1024), (f16*)(ws_ + WS_GLT), a.b_gate + l * 3 * DM};
            pg8::gemm_phase<pg8::EpiIn, pg8::SKOrder>(lds, g, S, E, pg8::SKCtx{slab, ctl_ + CW_SK + (l * 5 + 0) * SK_BANK}, wave0);
        } REPBAR(2, rep_); }
        do { if (IN(pb + 0)) { bg_convert(a, lds, MISC, pb + 0, G, wave0); if (IN(pb + 1) || IN(pb + 2)) xcd_barrier(bar, wave0); } } while (0);
        if (PH_ON(4) && IN(pb + 2)) _Pragma("unroll") for (int rep_ = 0; rep_ < NREP(4); ++rep_) { { WSP();
            for (int ui = blockIdx.x; ui < 256; ui += G) {
                const int b = ui >> 7, h = (ui >> 4) & 7, qb = ui & 15, g = h >> 2;
                const int kl0 = qb == 0 ? 0 : qb * 256 - 128, kend = qb == 15 ? SEQ : qb * 256 + 384;
                att::Unit u;
                u.Q = P + (size_t)(b * SEQ + qb * 256) * INW + QA_OFF + h * HD;
                u.Kc = P + (size_t)(NLAT + b * CTXL) * INW + KA_OFF + g * HD; u.Vc = P + (size_t)(NLAT + b * CTXL) * INW + VA_OFF + g * HD;
                u.Kl = P + (size_t)(b * SEQ + kl0) * INW + KA_OFF + g * HD; u.Vl = P + (size_t)(b * SEQ + kl0) * INW + VA_OFF + g * HD;
                u.O = Y + (size_t)(b * SEQ + qb * 256) * 3072 + h * HD; u.NT = 4 + (kend - kl0) / 64; u.qpos0 = qb * 256; u.kpos0 = kl0;
                u.sink = a.attn_sink[l * 8 + h]; u.has_sink = 1;
                att::attn_unit<true>(u, (char*)lds_raw, wave0);
            }
            if (!last) {
                for (int v = blockIdx.x; v < 32; v += G) {
                    const int isB = v >> 4, b = (v >> 3) & 1, h = v & 7, g = h >> 2;
                    att::Unit u;
                    const size_t r0 = (size_t)(NLAT + b * CTXL);
                    u.Q = P + r0 * INW + (isB ? QB_OFF : QA_OFF) + h * HD;
                    u.Kc = P + r0 * INW + (isB ? KB_OFF : KA_OFF) + g * HD; u.Vc = P + r0 * INW + (isB ? VB_OFF : VA_OFF) + g * HD;
                    u.Kl = u.Kc; u.Vl = u.Vc; u.O = Y + r0 * 3072 + (isB ? 1024 : 0) + h * HD; u.NT = 4; u.qpos0 = 0; u.kpos0 = 0;
                    u.sink = a.attn_sink[l * 8 + h]; u.has_sink = isB ? 0 : 1;
                    att::attn_unit<false>(u, (char*)lds_raw, wave0);
                }
            }
            for (int v = G - 1 - (int)blockIdx.x; v < NCHUNK * 8; v += G) ret_c1_unit(a, l, v >> 3, v & 7, lds, wave0);
        } REPBAR(4, rep_); }
        SEAM(pb + 2);
        if (PH_ON(5) && IN(pb + 3)) _Pragma("unroll") for (int rep_ = 0; rep_ < NREP(5); ++rep_) { { TL(); ph_scan(a, l, tid); } REPBAR(5, rep_); }
        SEAM(pb + 3);
        if (PH_ON(6) && IN(pb + 4)) _Pragma("unroll") for (int rep_ = 0; rep_ < NREP(6); ++rep_) { { WSP();
            for (int ui = blockIdx.x; ui < 256; ui += G) {
                const int b = ui >> 7, h = (ui >> 4) & 7, qb = ui & 15, g = h >> 2;
                att::Unit u;
                u.Q = P + (size_t)(b * SEQ + qb * 256) * INW + QB_OFF + h * HD;
                u.Kc = P + (size_t)(NLAT + b * CTXL) * INW + KB_OFF + g * HD; u.Vc = P + (size_t)(NLAT + b * CTXL) * INW + VB_OFF + g * HD;
                u.Kl = P + (size_t)(b * SEQ) * INW + KB_OFF + g * HD; u.Vl = P + (size_t)(b * SEQ) * INW + VB_OFF + g * HD;
                u.O = Y + (size_t)(b * SEQ + qb * 256) * 3072 + 1024 + h * HD; u.NT = 4 + SEQ / 64; u.qpos0 = 0; u.kpos0 = 0; u.sink = 0.f; u.has_sink = 0;
                att::attn_unit<false>(u, (char*)lds_raw, wave0);
            }
            for (int v = G - 1 - (int)blockIdx.x; v < NCHUNK * 8; v += G) {
                if (last && (v >> 3) % 34 < 2) continue;
                ret_c3_unit(a, l, v >> 3, v & 7, lds, wave0);
            }
        } REPBAR(6, rep_); }
        SEAM(pb + 4);
        if (PH_ON(7) && IN(pb + 5)) _Pragma("unroll") for (int rep_ = 0; rep_ < NREP(7); ++rep_) { { WSP();
            pg8::Gemm g{Y, (const f16*)(a.ws + WS_WBR + l * SZ_WBR), Mrows, DM, 3072}; pg8::SKOrder S; S.init(Mrows, DM, 3072, G, (int)blockIdx.x);
            pg8::EpiGateK E{(const f16*)(ws_ + WS_GLT), MH};
            pg8::gemm_phase<pg8::EpiGateK, pg8::SKOrder>(lds, g, S, E, pg8::SKCtx{slab, ctl_ + CW_SK + (l * 5 + 1) * SK_BANK}, wave0);
        } REPBAR(7, rep_); }
        SEAM(pb + 5);
        if (PH_ON(8) && IN(pb + 6)) _Pragma("unroll") for (int rep_ = 0; rep_ < NREP(8); ++rep_) { { WSP();
            pg8::Gemm g{MH, (const f16*)(a.ws + WS_WO + l * SZ_WO), Mrows, DM, DM}; pg8::SKOrder S; S.init(Mrows, DM, DM, G, (int)blockIdx.x, 0, 1);
            pg8::EpiResLN E{l == 0 ? (const void*)a.x : (const void*)LAT, l == 0 ? (const void*)a.ctx : (const void*)(LAT + (size_t)NLAT * DM), modl + 2 * DM, l == 0 ? 0 : 1,
                            a.ln1_g + l * DM, a.ln1_b + l * DM, modl + 3 * DM, modl + 4 * DM, LAT, H, a.out, 0,
                            (unsigned long long*)(slab + (size_t)4 * 1024 * 1024), ctl_ + CW_LN + (l * 2 + 0) * LN_BANK, lds + RING_BYTES + 1024};
            pg8::gemm_phase<pg8::EpiResLN, pg8::SKOrder>(lds, g, S, E, pg8::SKCtx{slab, ctl_ + CW_SK + (l * 5 + 2) * SK_BANK}, wave0);
        } REPBAR(8, rep_); }
        do { if (IN(pb + 6)) { bg_convert(a, lds, MISC, pb + 6, G, wave0); if (IN(pb + 7) || IN(pb + 8)) xcd_barrier(bar, wave0); } } while (0);
        if (PH_ON(10) && IN(pb + 8)) _Pragma("unroll") for (int rep_ = 0; rep_ < NREP(10); ++rep_) { { WSP();
            pg8::Gemm g{H, (const f16*)(a.ws + WS_WUP + l * SZ_WUP), Mrows, 2 * DFF, DM}; pg8::SKOrder S; S.init(Mrows, 2 * DFF, DM, G, (int)blockIdx.x);
            pg8::EpiConv E{a.conv_w + (size_t)l * 3 * DFF, a.conv_b + (size_t)l * DFF, ACT, slab, slab + (size_t)34 * 2 * DFF, slab + (size_t)2 * 34 * 2 * DFF, (LAS float*)(lds + RING_BYTES + 1024)};
            pg8::gemm_phase<pg8::EpiConv, pg8::SKOrder>(lds, g, S, E, pg8::SKCtx{slab, ctl_ + CW_SK + (l * 5 + 3) * SK_BANK}, wave0);
        } REPBAR(10, rep_); }
        SEAM(pb + 8);
        if (PH_ON(11) && IN(pb + 9)) _Pragma("unroll") for (int rep_ = 0; rep_ < NREP(11); ++rep_) { { TL(); ph_convfix(a, l, Mrows, tid); } REPBAR(11, rep_); }
        SEAM(pb + 9);
        if (PH_ON(12) && IN(pb + 10)) _Pragma("unroll") for (int rep_ = 0; rep_ < NREP(12); ++rep_) { { WSP();
            const float* modn = MOD + (size_t)(l + 1) * 3 * NMOD;
            int Gs_ = G; asm volatile("" : "+s"(Gs_));
            const bool sk8 = SK8_DN && l == 0 && Gs_ == 256;
            pg8::Gemm g{ACT, (const f16*)(a.ws + WS_WDN + l * SZ_WDN), Mrows, DM, DFF}; pg8::SKOrder S; S.init(sk8 ? NLAT : Mrows, DM, DFF, G, (int)blockIdx.x, 0, 1);
            pg8::EpiResLN E{(const void*)LAT, (const void*)(LAT + (size_t)NLAT * DM), modl + 5 * DM, 1,
                            a.ln2_g + l * DM, a.ln2_b + l * DM, last ? modl : modn, last ? modl : modn + DM, LAT, H, a.out, last ? 1 : 0,
                            (unsigned long long*)(slab + (size_t)4 * 1024 * 1024), ctl_ + CW_LN + (l * 2 + 1) * LN_BANK, lds + RING_BYTES + 1024};
            pg8::gemm_phase<pg8::EpiResLN, pg8::SKOrder>(lds, g, S, E, pg8::SKCtx{slab, ctl_ + CW_SK + (l * 5 + 4) * SK_BANK}, wave0);
            if (sk8) { pg8::SK8Order S8; S8.init(DFF, (int)blockIdx.x);
                pg8::gemm_phase<pg8::EpiResLN, pg8::SK8Order, true, true, true>(lds, g, S8, E, pg8::SKCtx{(float*)(ws_ + WS_MF), ctl_ + CW_SK + (l * 5 + 4) * SK_BANK}, wave0); }
        } REPBAR(12, rep_); }
        if (!last) do { if (IN(pb + 10)) { bg_convert(a, lds, MISC, pb + 10, G, wave0); if (IN(pb + 11) || IN(pb + 12)) xcd_barrier(bar, wave0); } } while (0);
    }
#undef IN
#undef SEAM
}

extern "C" void kernel_launch(void* const* d_in, const int* in_sizes, int n_in, void* d_out, int out_size, void* d_ws, size_t ws_size, hipStream_t stream) {
    static int grid = 0;
    if (grid == 0) {
        if (n_in != 23 || out_size != NLAT * DM || ws_size < WS_END) { fprintf(stderr, "kernel_launch: unexpected shapes (n_in %d out %d ws %zu, need %zu)\n", n_in, out_size, ws_size, (size_t)WS_END); grid = -1; return; }
        int dev = 0, cus = 0, per_cu = 0;
        if (hipGetDevice(&dev) != hipSuccess || hipDeviceGetAttribute(&cus, hipDeviceAttributeMultiprocessorCount, dev) != hipSuccess) { grid = -1; return; }
        if (hipFuncSetAttribute((const void*)mixer_fwd, hipFuncAttributeMaxDynamicSharedMemorySize, LDS_BYTES) != hipSuccess) { fprintf(stderr, "kernel_launch: hipFuncSetAttribute failed\n"); grid = -1; return; }
        if (hipOccupancyMaxActiveBlocksPerMultiprocessor(&per_cu, (const void*)mixer_fwd, 512, LDS_BYTES) != hipSuccess || per_cu < 1)
            fprintf(stderr, "kernel_launch: occupancy query reports %d workgroups per CU\n", per_cu);
        (void)hipGetLastError();
        grid = cus;
    }
    if (grid < 0) return;
    if (hipMemsetAsync((char*)d_ws + WS_CTL, 0, CTL_ZERO_BYTES, stream) != hipSuccess) return;
    Args a{};
    const float** ap = (const float**)&a;
    for (int i = 0; i < 23; ++i) ap[i] = (const float*)d_in[i];
    a.out = (float*)d_out; a.ws = (unsigned char*)d_ws; a.li = 0; a.pad = 0;
#if MK_PER_PHASE
    for (int p = 0; p < N_PHASES; ++p) { a.ph_lo = p; a.ph_hi = p + 1; hipLaunchKernelGGL(mixer_fwd, dim3(grid), dim3(512), LDS_BYTES, stream, a); }
#else
    a.ph_lo = 0; a.ph_hi = N_PHASES;
    hipLaunchKernelGGL(mixer_fwd, dim3(grid), dim3(512), LDS_BYTES, stream, a);
#endif
    const hipError_t le = hipPeekAtLastError();
    if (le != hipSuccess) fprintf(stderr, "kernel_launch: launch failed: %s\n", hipGetErrorName(le));
}
```

```cpp
#include <hip/hip_runtime.h>
#include <cstdio>
#include <cstdint>

#ifndef MK_PER_PHASE
#define MK_PER_PHASE 0
#endif
#ifndef XORDER
#define XORDER 1
#endif
#ifndef SK8_DN
#define SK8_DN 1
#endif
#ifndef SK8_WO
#define SK8_WO 0
#endif
#ifndef SK_ENABLE
#define SK_ENABLE 0
#endif

#define LAS __attribute__((address_space(3)))
#define GAS __attribute__((address_space(1)))
typedef _Float16 f16;
typedef _Float16 h8 __attribute__((ext_vector_type(8)));
typedef _Float16 h4 __attribute__((ext_vector_type(4)));
typedef _Float16 h2 __attribute__((ext_vector_type(2)));
typedef short s16x4 __attribute__((ext_vector_type(4)));
typedef float f32x2 __attribute__((ext_vector_type(2)));
typedef float f32x4 __attribute__((ext_vector_type(4)));
typedef float f32x16 __attribute__((ext_vector_type(16)));
typedef unsigned u32x2 __attribute__((ext_vector_type(2)));
typedef unsigned u32x4 __attribute__((ext_vector_type(4)));

constexpr int DM = 4096, NBATCH = 2, SEQ = 4096, CTXL = 256, NLAT = NBATCH * SEQ, NCTX = NBATCH * CTXL, MTOT = NLAT + NCTX;
constexpr int HD = 128, INW = 19456, DFF = 11008, NMOD = 6 * DM;
constexpr int QA_OFF = 0, KA_OFF = 1024, VA_OFF = 1280, QB_OFF = 1536, KB_OFF = 2560, VB_OFF = 2816, QR_OFF = 3072, KR_OFF = 4096, VR_OFF = 5120, GR_OFF = 6144, GL_OFF = 7168;
constexpr float LN_EPS = 1e-5f, RMS_EPS = 1e-6f, GN_EPS = 1e-5f;
constexpr float DN_ALPHA = 1.4142135623730951f;
constexpr float ATT_SCALE = 0.088388347648318440f;
constexpr int NCHUNK = 68;

constexpr size_t MiB = 1u << 20;
constexpr size_t WS_CTL = 0, CTL_ZERO_BYTES = 1 * MiB;
constexpr size_t WS_MOD = 1 * MiB;
constexpr size_t WS_ROPE = 2 * MiB;
constexpr size_t WS_WIN = 4 * MiB, SZ_WIN = 152 * MiB;
constexpr size_t WS_WBR = 308 * MiB, SZ_WBR = 24 * MiB;
constexpr size_t WS_WO = 356 * MiB, SZ_WO = 32 * MiB;
constexpr size_t WS_WUP = 420 * MiB, SZ_WUP = 172 * MiB;
constexpr size_t WS_WDN = 764 * MiB, SZ_WDN = 86 * MiB;
constexpr size_t WS_H = 936 * MiB;
constexpr size_t WS_P = 1004 * MiB;
constexpr size_t WS_Y = 1370 * MiB, SZ_Y1 = 17 * MiB;
constexpr size_t WS_MF = 1421 * MiB;
constexpr size_t WS_MH = 1557 * MiB;
constexpr size_t WS_Z = 1625 * MiB;
constexpr size_t WS_LAT = 1761 * MiB;
constexpr size_t WS_ACT = 1897 * MiB;
constexpr size_t WS_UT = 2080 * MiB;
constexpr size_t WS_ST = 2148 * MiB;
constexpr size_t WS_SLAB = 2182 * MiB;
constexpr size_t WS_GLT = 2246 * MiB;
constexpr size_t WS_END = 2450 * MiB;
static_assert(WS_WIN + 2 * SZ_WIN <= WS_WBR && WS_WBR + 2 * SZ_WBR <= WS_WO && WS_WO + 2 * SZ_WO <= WS_WUP && WS_WUP + 2 * SZ_WUP <= WS_WDN && WS_WDN + 2 * SZ_WDN <= WS_H, "ws map");
static_assert(WS_P + (size_t)MTOT * 22016 * 2 <= WS_Y && WS_ACT + (size_t)MTOT * DFF * 2 <= WS_UT, "ws map");
constexpr int CW_Q = 512, CW_QD = 1024;
constexpr int CW_BAR = 4096;
constexpr int CW_LN = 60000, LN_BANK = 64 * 34;
constexpr int CW_SK = 16384, SK_BANK = 4096;
static_assert((CW_SK + 10 * SK_BANK) * 4 <= (int)CTL_ZERO_BYTES && CW_SK + 10 * SK_BANK <= CW_LN && (CW_LN + 4 * LN_BANK) * 4 <= (int)CTL_ZERO_BYTES, "ctl");

constexpr int RING_BYTES = 131072, MISC_OFF = RING_BYTES + 320, LDS_BYTES = 147456;

__device__ __forceinline__ unsigned pkh(float lo, float hi) { h2 v = __builtin_convertvector((f32x2){lo, hi}, h2); return __builtin_bit_cast(unsigned, v); }
__device__ __forceinline__ float wave_sum(float v) {
#pragma unroll
    for (int o = 1; o < 64; o <<= 1) v += __shfl_xor(v, o);
    return v;
}
__device__ __forceinline__ float sigmoidf_(float x) { return __builtin_amdgcn_rcpf(1.0f + __expf(-x)); }
__device__ __forceinline__ int tid_of(int wave0) { return (wave0 << 6) | (int)__builtin_amdgcn_mbcnt_hi(~0u, __builtin_amdgcn_mbcnt_lo(~0u, 0u)); }
#define LDS_WAIT() asm volatile("s_waitcnt lgkmcnt(0)" ::: "memory")
#define VM_WAIT() asm volatile("s_waitcnt vmcnt(0)" ::: "memory")

struct Args {
    const float *x, *c, *ctx, *c_ctx, *w_mod, *b_mod, *w_in, *b_gate, *w_branch, *w_o, *attn_sink, *q_norm_g, *k_norm_g, *ret_decay, *ret_gn_g, *ln1_g, *ln1_b, *w_up, *conv_w, *conv_b, *w_down, *ln2_g, *ln2_b;
    float* out; unsigned char* ws; int ph_lo, ph_hi, li, pad;
};

namespace pg8 {
constexpr int BM = 256, BK = 64, HALF = 128, HTB = HALF * BK * 2, STAGE_BYTES = 8 * HTB, NXCD = 8, WGM = 4;
__host__ __device__ __forceinline__ int lds_byte(int r, int c) { const int st = (r >> 4) * 2 + (c >> 5), rr = r & 15, cc = c & 31, ob = rr * 64 + cc * 2; return st * 1024 + (ob ^ (((ob >> 9) & 1) << 5)); }
__host__ __device__ __forceinline__ void stage_rc(int b, int& R, int& C) { const int st = b / 1024, sb = b % 1024, swz = sb ^ (((sb >> 9) & 1) << 5); R = (st >> 1) * 16 + swz / 64; C = (st & 1) * 32 + (swz % 64) / 2; }
__host__ __device__ __forceinline__ int perm32(int rho) { const int n = rho >> 4, i = rho & 15; return 8 * (i >> 2) + 4 * n + (i & 3); }
struct Unit { int pm, pn, k0, nt, sl, ns, rid; };
struct Gemm { const f16* A; const f16* Bt; int M, N, K; };
struct SKCtx { float* slab; unsigned* cnt; };
struct SKOrder {
    int nM, nN, nwg, G, c, nfull, R, ns, npairs, nextra, lnord, sk8;
    __device__ __forceinline__ void init(int M, int N, int K, int G_, int c_, int nextra_ = 0, int lnord_ = 0, int sk8_ = 0) { lnord = lnord_; sk8 = sk8_; nM = M / BM; nN = N / BM; nwg = nM * nN; G = G_; asm volatile("" : "+s"(G)); c = c_; nextra = nextra_; nfull = (nwg / G) * G; R = nwg - nfull; npairs = K / 128;
        ns = 1; if (R > 0 && SK_ENABLE && nextra == 0) { ns = G / R; const int cap = npairs / 2; if (ns > cap) ns = cap; if (ns > 16) ns = 16; if (ns < 1) ns = 1; } }
    __device__ __forceinline__ bool next_x(int i, Unit& u) const {
        const int x = c & 7, w = c >> 3, nfullc = nN >> 3, remc = nN & 7;
        const int nrest = (nM - 32) * nN + nextra;
        const bool mainu = i < nfullc || (i == nfullc && (w >> 2) < remc);
        int r = 0;
        if (!mainu) { if (remc > 0) r = (i == nfullc) ? x * (4 * (8 - remc)) + (w - 4 * remc) : 32 * (8 - remc) + (i - nfullc - 1) * 256 + c; else r = (i - nfullc) * 256 + c; }
        const int t = (r >> 1) % 12;
        const int rpn = nextra > 0 ? (t < 2 ? 4 + t : (t < 4 ? 8 + t : 12 + t)) : (r >> 1);
        u.pm = mainu ? 4 * x + (w & 3) : 32 + (r & 1); u.pn = mainu ? 8 * i + (w >> 2) : rpn;
        if (lnord && mainu) { u.pm = 8 * (x >> 1) + 4 * i + (w & 3); u.pn = 8 * (x & 1) + (w >> 2); }
        u.k0 = 0; u.nt = 2 * npairs; u.sl = 0; u.ns = 1; u.rid = 0;
        return mainu || r < nrest;
    }
    __device__ __forceinline__ bool next(int i, Unit& u) const {
        if (XORDER && G == 256 && nM >= 32 && nM <= 34 && !SK_ENABLE) return next_x(i, u);
        const long L = (long)i * G + c;
        const bool ok = L < (long)(nwg + nextra);
        const bool ext = L >= nwg;
        int wgid = ok && !ext ? (int)L : 0;
        int sl = 0, nsl = 1, rid = 0, k0 = 0, ntl = 2 * npairs;
#if SK_ENABLE
        if (ok && !ext && L >= nfull && ns > 1) { const int j = (int)(L - nfull); const int r = j / ns; sl = j - r * ns; wgid = nfull + r; nsl = ns; rid = r;
            const int p0 = (int)((long)sl * npairs / ns), p1 = (int)((long)(sl + 1) * npairs / ns); k0 = p0 * 128; ntl = 2 * (p1 - p0); }
#endif
        { const int q = nwg / NXCD, r = nwg % NXCD, xcd = wgid % NXCD, off = wgid / NXCD; wgid = (xcd < r ? xcd * (q + 1) : r * (q + 1) + (xcd - r) * q) + off; }
        const int nig = WGM * nN, gid = wgid / nig, fm = gid * WGM, gsz = (nM - fm) < WGM ? (nM - fm) : WGM;
        int pm = fm + ((wgid % nig) % gsz), pn = (wgid % nig) / gsz;
        const int e = ext ? (int)(L - nwg) : 0, t = e % 12;
        if (ext) { pm = 32 + e / 12; pn = t < 2 ? 4 + t : (t < 4 ? 8 + t : 12 + t); }
        u.pm = pm; u.pn = pn; u.k0 = k0; u.nt = ntl; u.sl = sl; u.ns = nsl; u.rid = rid;
        return ok;
    }
};
struct SK8Order {
    int c, npairs;
    __device__ __forceinline__ void init(int K, int c_) { c = c_; npairs = K / 128; }
    __device__ __forceinline__ bool next(int i, Unit& u) const {
        const int rr = c >> 3, sl = c & 7, p0 = sl * npairs / 8, p1 = (sl + 1) * npairs / 8;
        u.pm = 32 + (rr & 1); u.pn = rr >> 1; u.k0 = p0 * 128; u.nt = 2 * (p1 - p0); u.sl = sl; u.ns = 8; u.rid = rr;
        return i == 0;
    }
};
struct EpiF16 {
    static constexpr bool PERM = true, HOOK = false, SK = false;
    f16* O; int ldc;
    __device__ __forceinline__ void pre(f32x4 (&)[2][2][4][2], const Unit&, int, int, int, int) const {}
    __device__ __forceinline__ void operator()(const f32x4 (&acc)[2][2][4][2], const Unit& u, int wr, int wc, int fr, int fq) const {
        const int row0 = u.pm * BM + wr * 64 + fr, col0 = u.pn * BM + wc * 32 + 8 * fq;
#pragma unroll
        for (int ai = 0; ai < 2; ++ai)
#pragma unroll
            for (int m = 0; m < 4; ++m) { f16* rowp = O + (size_t)(row0 + ai * HALF + m * 16) * ldc + col0;
#pragma unroll
                for (int bj = 0; bj < 2; ++bj) { const f32x4 v0 = acc[ai][bj][m][0], v1 = acc[ai][bj][m][1];
                    u32x4 w; w.x = pkh(v0[0], v0[1]); w.y = pkh(v0[2], v0[3]); w.z = pkh(v1[0], v1[1]); w.w = pkh(v1[2], v1[3]);
                    *(u32x4*)(rowp + bj * HALF) = w; } }
    }
};
struct EpiIn {
    static constexpr bool PERM = true, HOOK = false, SK = false;
    f16* O; const f32x2* rope; const float* qg; const float* kg; LAS float* red; f16* GLT; const float* bgate;
    __device__ __forceinline__ void pre(f32x4 (&)[2][2][4][2], const Unit&, int, int, int, int) const {}
    __device__ __forceinline__ void operator()(const f32x4 (&acc)[2][2][4][2], const Unit& u, int wr, int wc, int fr, int fq) const {
        const int pn = u.pn; const bool lat = u.pm < 32;
        if (pn >= 28) {
            const int gi = pn - 28, br = gi >> 4, pnn = gi & 15;
            int lo = fq * 16 + fr; asm volatile("" : "+v"(lo));
            f16* tp = GLT + ((size_t)((br * 34 + u.pm) * 16 + pnn) * 8 + (wr * 4 + wc)) * 8192 + lo * 8;
            const float* bp = bgate + gi * 256 + wc * 32 + 8 * (lo >> 4);
#pragma unroll
            for (int bj = 0; bj < 2; ++bj) { const f32x4 b0 = *(const f32x4*)(bp + bj * HALF), b1 = *(const f32x4*)(bp + bj * HALF + 4);
#pragma unroll
                for (int ai = 0; ai < 2; ++ai)
#pragma unroll
                    for (int m = 0; m < 4; ++m) { f32x4 v0 = acc[ai][bj][m][0] + b0, v1 = acc[ai][bj][m][1] + b1;
#pragma unroll
                        for (int j = 0; j < 4; ++j) { v0[j] = 1024.f * __builtin_amdgcn_rcpf(1.0f + __builtin_amdgcn_exp2f(fminf(fmaxf(v0[j], -20.f), 20.f) * -1.4426950408889634f));
                            v1[j] = 1024.f * __builtin_amdgcn_rcpf(1.0f + __builtin_amdgcn_exp2f(fminf(fmaxf(v1[j], -20.f), 20.f) * -1.4426950408889634f)); }
                        u32x4 w; w.x = pkh(v0[0], v0[1]); w.y = pkh(v0[2], v0[3]); w.z = pkh(v1[0], v1[1]); w.w = pkh(v1[2], v1[3]);
                        *(u32x4*)(tp + ((ai * 4 + m) * 2 + bj) * 512) = w; } }
            return;
        }
        int kind = 0;
        if (pn < 5) kind = 1; else if (pn >= 6 && pn < 10) kind = 2; else if (pn == 10) kind = 3; else if (pn >= 12 && pn < 16) kind = 1; else if (pn >= 16 && pn < 20) kind = 4;
        const int row0 = u.pm * BM + wr * 64 + fr, col0 = pn * BM + wc * 32 + 8 * fq;
        if (kind == 0 || (kind == 1 && !lat)) {
#pragma unroll
            for (int ai = 0; ai < 2; ++ai)
#pragma unroll
                for (int m = 0; m < 4; ++m) { f16* rowp = O + (size_t)(row0 + ai * HALF + m * 16) * INW + col0;
#pragma unroll
                    for (int bj = 0; bj < 2; ++bj) { const f32x4 v0 = acc[ai][bj][m][0], v1 = acc[ai][bj][m][1];
                        u32x4 w; w.x = pkh(v0[0], v0[1]); w.y = pkh(v0[2], v0[3]); w.z = pkh(v1[0], v1[1]); w.w = pkh(v1[2], v1[3]);
                        *(u32x4*)(rowp + bj * HALF) = w; } }
            return;
        }
        const bool rms = (kind == 2 || kind == 3);
        float rsv[2][2][4];
        if (rms) {
#pragma unroll
            for (int bj = 0; bj < 2; ++bj)
#pragma unroll
                for (int ai = 0; ai < 2; ++ai)
#pragma unroll
                    for (int m = 0; m < 4; ++m) { const f32x4 a0 = acc[ai][bj][m][0], a1 = acc[ai][bj][m][1];
                        float ss = (a0[0] * a0[0] + a0[1] * a0[1]) + (a0[2] * a0[2] + a0[3] * a0[3]) + (a1[0] * a1[0] + a1[1] * a1[1]) + (a1[2] * a1[2] + a1[3] * a1[3]);
                        ss += __shfl_xor(ss, 16); ss += __shfl_xor(ss, 32);
                        if (fq == 0) red[(bj * 256 + ai * HALF + wr * 64 + m * 16 + fr) * 4 + wc] = ss; }
            asm volatile("s_waitcnt lgkmcnt(0)" ::: "memory"); __builtin_amdgcn_s_barrier(); asm volatile("" ::: "memory");
#pragma unroll
            for (int bj = 0; bj < 2; ++bj)
#pragma unroll
                for (int ai = 0; ai < 2; ++ai)
#pragma unroll
                    for (int m = 0; m < 4; ++m) { const f32x4 t = *(const LAS f32x4*)(red + (bj * 256 + ai * HALF + wr * 64 + m * 16 + fr) * 4);
                        rsv[bj][ai][m] = 1.0f / sqrtf(((t[0] + t[1]) + (t[2] + t[3])) * (1.0f / HD) + RMS_EPS); }
        }
        const int dbase = 64 * (wc >> 1) + 16 * (wc & 1) + 4 * fq;
        f32x4 g0 = {1.f, 1.f, 1.f, 1.f}, g1 = g0;
        if (rms) { const float* g = (kind == 2 ? qg : kg) + dbase; g0 = *(const f32x4*)g; g1 = *(const f32x4*)(g + 32); }
        const float ksc = kind == 4 ? ATT_SCALE : 1.0f;
#pragma unroll
        for (int ai = 0; ai < 2; ++ai)
#pragma unroll
            for (int m = 0; m < 4; ++m) { const int row = row0 + ai * HALF + m * 16; const int t = row & (SEQ - 1); const int pos = (wc >> 1) ? (t & 63) : (t >> 6);
                f32x4 cv = {1.f, 1.f, 1.f, 1.f}, sv = {0.f, 0.f, 0.f, 0.f};
                if (lat) { const f32x4* cs = (const f32x4*)(rope + pos * 32 + 16 * (wc & 1) + 4 * fq); const f32x4 c01 = cs[0], c23 = cs[1]; cv = (f32x4){c01[0], c01[2], c23[0], c23[2]}; sv = (f32x4){c01[1], c01[3], c23[1], c23[3]}; }
                f16* rowp = O + (size_t)row * INW + col0;
#pragma unroll
                for (int bj = 0; bj < 2; ++bj) { f32x4 x1 = acc[ai][bj][m][0], x2 = acc[ai][bj][m][1];
                    if (rms) { x1 = x1 * rsv[bj][ai][m] * g0; x2 = x2 * rsv[bj][ai][m] * g1; }
                    const f32x4 o1 = (x1 * cv - x2 * sv) * ksc, o2 = (x2 * cv + x1 * sv) * ksc;
                    u32x4 w; w.x = pkh(o1[0], o1[1]); w.y = pkh(o1[2], o1[3]); w.z = pkh(o2[0], o2[1]); w.w = pkh(o2[2], o2[3]);
                    *(u32x4*)(rowp + bj * HALF) = w; } }
    }
};
struct EpiConv {
    static constexpr bool PERM = true, HOOK = false, SK = false;
    const float* cw; const float* cb; f16* ACT; float* GE; float* XP; float* UPE; LAS float* halo;
    __device__ __forceinline__ void pre(f32x4 (&)[2][2][4][2], const Unit&, int, int, int, int) const {}
    template <int CTRL> static __device__ __forceinline__ float dppf(float old, float src) {
        return __builtin_bit_cast(float, __builtin_amdgcn_update_dpp(__builtin_bit_cast(int, old), __builtin_bit_cast(int, src), CTRL, 0xf, 0xf, false)); }
    __device__ __forceinline__ void operator()(const f32x4 (&acc)[2][2][4][2], const Unit& u, int wr, int wc, int fr, int fq) const {
        const int f0 = u.pn * 128 + wc * 32 + 8 * fq;
        f32x4 w0[2], w1[2], w2[2], bb[2];
#pragma unroll
        for (int n = 0; n < 2; ++n) { w0[n] = *(const f32x4*)(cw + f0 + 4 * n); w1[n] = *(const f32x4*)(cw + DFF + f0 + 4 * n); w2[n] = *(const f32x4*)(cw + 2 * DFF + f0 + 4 * n); bb[n] = *(const f32x4*)(cb + f0 + 4 * n); }
        const int hcol = wc * 32 + 8 * fq;
#pragma unroll
        for (int ai = 0; ai < 2; ++ai) {
            if (fr == 0)  { *(LAS f32x4*)(halo + ((ai * 2 + wr) * 2 + 0) * 128 + hcol) = acc[ai][0][0][0]; *(LAS f32x4*)(halo + ((ai * 2 + wr) * 2 + 0) * 128 + hcol + 4) = acc[ai][0][0][1]; }
            if (fr == 15) { *(LAS f32x4*)(halo + ((ai * 2 + wr) * 2 + 1) * 128 + hcol) = acc[ai][0][3][0]; *(LAS f32x4*)(halo + ((ai * 2 + wr) * 2 + 1) * 128 + hcol + 4) = acc[ai][0][3][1]; }
        }
        if (wr == 0 && fr == 0)  { float* g = GE + (size_t)(u.pm * 2 + 0) * DFF + f0; *(f32x4*)g = acc[0][0][0][0]; *(f32x4*)(g + 4) = acc[0][0][0][1]; }
        if (wr == 1 && fr == 15) { float* g = GE + (size_t)(u.pm * 2 + 1) * DFF + f0; *(f32x4*)g = acc[1][0][3][0]; *(f32x4*)(g + 4) = acc[1][0][3][1]; }
        asm volatile("s_waitcnt lgkmcnt(0)" ::: "memory"); __builtin_amdgcn_s_barrier(); asm volatile("" ::: "memory");
#pragma unroll
        for (int ai = 0; ai < 2; ++ai) {
            f32x4 hp[2] = {{0.f, 0.f, 0.f, 0.f}, {0.f, 0.f, 0.f, 0.f}}, hn[2] = {{0.f, 0.f, 0.f, 0.f}, {0.f, 0.f, 0.f, 0.f}};
            if (wr == 1)      { hp[0] = *(const LAS f32x4*)(halo + ((ai * 2 + 0) * 2 + 1) * 128 + hcol); hp[1] = *(const LAS f32x4*)(halo + ((ai * 2 + 0) * 2 + 1) * 128 + hcol + 4); }
            else if (ai == 1) { hp[0] = *(const LAS f32x4*)(halo + ((0 * 2 + 1) * 2 + 1) * 128 + hcol);  hp[1] = *(const LAS f32x4*)(halo + ((0 * 2 + 1) * 2 + 1) * 128 + hcol + 4); }
            if (wr == 0)      { hn[0] = *(const LAS f32x4*)(halo + ((ai * 2 + 1) * 2 + 0) * 128 + hcol); hn[1] = *(const LAS f32x4*)(halo + ((ai * 2 + 1) * 2 + 0) * 128 + hcol + 4); }
            else if (ai == 0) { hn[0] = *(const LAS f32x4*)(halo + ((1 * 2 + 0) * 2 + 0) * 128 + hcol);  hn[1] = *(const LAS f32x4*)(halo + ((1 * 2 + 0) * 2 + 0) * 128 + hcol + 4); }
#pragma unroll
            for (int m = 0; m < 4; ++m) {
                float o[8], xs[8];
#pragma unroll
                for (int n = 0; n < 2; ++n)
#pragma unroll
                    for (int j = 0; j < 4; ++j) {
                        const float g = acc[ai][0][m][n][j];
                        const float oldp = m > 0 ? dppf<0x121>(0.f, acc[ai][0][m > 0 ? m - 1 : 0][n][j]) : hp[n][j];
                        const float pv = dppf<0x111>(oldp, g);
                        const float oldn = m < 3 ? dppf<0x12f>(0.f, acc[ai][0][m < 3 ? m + 1 : 3][n][j]) : hn[n][j];
                        const float nv = dppf<0x101>(oldn, g);
                        const float x = bb[n][j] + w0[n][j] * pv + w1[n][j] * g + w2[n][j] * nv;
                        xs[4 * n + j] = x; o[4 * n + j] = x * sigmoidf_(x) * acc[ai][1][m][n][j];
                    }
                const int row = u.pm * BM + ai * HALF + wr * 64 + m * 16 + fr;
                u32x4 w; w.x = pkh(o[0], o[1]); w.y = pkh(o[2], o[3]); w.z = pkh(o[4], o[5]); w.w = pkh(o[6], o[7]);
                *(u32x4*)(ACT + (size_t)row * DFF + f0) = w;
                if ((ai == 0 && m == 0 && wr == 0 && fr == 0) || (ai == 1 && m == 3 && wr == 1 && fr == 15)) {
                    const size_t eo = (size_t)(u.pm * 2 + ai) * DFF + f0;
                    *(f32x4*)(XP + eo) = (f32x4){xs[0], xs[1], xs[2], xs[3]}; *(f32x4*)(XP + eo + 4) = (f32x4){xs[4], xs[5], xs[6], xs[7]};
                    *(f32x4*)(UPE + eo) = acc[ai][1][m][0]; *(f32x4*)(UPE + eo + 4) = acc[ai][1][m][1];
                }
            }
        }
    }
};
struct EpiGateK {
    static constexpr bool PERM = true, HOOK = true, SK = false;
    const f16* GLT; f16* Mh;
    template <int MODE>
    __device__ __forceinline__ void scale(f32x4 (&acc)[2][2][4][2], const Unit& u, int sa, int sb, int wr, int wc, int fr, int fq) const {
        int lo = (fq * 16 + fr) * 8; asm volatile("" : "+v"(lo));
        const f16* ta = GLT + ((size_t)((sa * 34 + u.pm) * 16 + u.pn) * 8 + (wr * 4 + wc)) * 8192 + lo;
        const f16* tb = GLT + ((size_t)((sb * 34 + u.pm) * 16 + u.pn) * 8 + (wr * 4 + wc)) * 8192 + lo;
        h8 ca[4], cb[4];
#pragma unroll
        for (int m = 0; m < 4; ++m) { const int q = (m * 2) * 512; ca[m] = *(const h8*)(ta + q); cb[m] = ca[m]; if (MODE == 0) cb[m] = *(const h8*)(tb + q); }
#pragma unroll
        for (int G = 0; G < 4; ++G) { const int bj = G >> 1, ai = G & 1;
            h8 na[4], nb[4];
            if (G < 3) { const int bj2 = (G + 1) >> 1, ai2 = (G + 1) & 1;
#pragma unroll
                for (int m = 0; m < 4; ++m) { const int q = ((ai2 * 4 + m) * 2 + bj2) * 512; na[m] = *(const h8*)(ta + q); nb[m] = na[m]; if (MODE == 0) nb[m] = *(const h8*)(tb + q); } }
            __builtin_amdgcn_sched_barrier(0);
#pragma unroll
            for (int m = 0; m < 4; ++m) {
#pragma unroll
                for (int j = 0; j < 8; ++j) {
                    float f = (float)ca[m][j];
                    if (MODE == 0) f *= __builtin_amdgcn_rcpf((float)cb[m][j]); else f *= (1.0f / 1024.0f);
                    acc[ai][bj][m][j >> 2][j & 3] *= f; } }
            asm volatile("" : "+v"(acc[ai][bj][0][0]), "+v"(acc[ai][bj][0][1]), "+v"(acc[ai][bj][1][0]), "+v"(acc[ai][bj][1][1]), "+v"(acc[ai][bj][2][0]), "+v"(acc[ai][bj][2][1]), "+v"(acc[ai][bj][3][0]), "+v"(acc[ai][bj][3][1]) :: "memory");
            if (G < 3) {
#pragma unroll
                for (int m = 0; m < 4; ++m) { ca[m] = na[m]; cb[m] = nb[m]; } } }
    }
    __device__ __forceinline__ void hook(f32x4 (&acc)[2][2][4][2], const Unit& u, int gt, int wr, int wc, int fr, int fq) const { const int seg = gt >> 4; scale<0>(acc, u, seg - 1, seg, wr, wc, fr, fq); }
    __device__ __forceinline__ void pre(f32x4 (&acc)[2][2][4][2], const Unit& u, int wr, int wc, int fr, int fq) const { const int seg = SK_ENABLE ? (((u.k0 >> 6) + u.nt - 1) >> 4) : 2; scale<1>(acc, u, seg, seg, wr, wc, fr, fq); }
    __device__ __forceinline__ void operator()(const f32x4 (&acc)[2][2][4][2], const Unit& u, int wr, int wc, int fr, int fq) const {
        const int row0 = u.pm * BM + wr * 64 + fr, col0 = u.pn * BM + wc * 32 + 8 * fq;
#pragma unroll
        for (int ai = 0; ai < 2; ++ai)
#pragma unroll
            for (int m = 0; m < 4; ++m) { f16* rowp = Mh + (size_t)(row0 + ai * HALF + m * 16) * DM + col0;
#pragma unroll
                for (int bj = 0; bj < 2; ++bj) { const f32x4 v0 = acc[ai][bj][m][0], v1 = acc[ai][bj][m][1];
                    u32x4 w; w.x = pkh(v0[0], v0[1]); w.y = pkh(v0[2], v0[3]); w.z = pkh(v1[0], v1[1]); w.w = pkh(v1[2], v1[3]);
                    *(u32x4*)(rowp + bj * HALF) = w; } }
    }
};
struct EpiRes {
    static constexpr bool PERM = true, HOOK = false, SK = false;
    __device__ __forceinline__ void pre(f32x4 (&)[2][2][4][2], const Unit&, int, int, int, int) const {}
    const void* latA; const void* latB; const float* gv; f16* Z; int lat16;
    __device__ __forceinline__ void operator()(const f32x4 (&acc)[2][2][4][2], const Unit& u, int wr, int wc, int fr, int fq) const {
        const int row0 = u.pm * BM + wr * 64 + fr, col0 = u.pn * BM + wc * 32 + 8 * fq;
        const int mr = u.pm < 16 ? 0 : (u.pm < 32 ? 1 : 2);
        const size_t rbase = u.pm < 32 ? 0 : (size_t)NLAT * DM;
        const void* lat = u.pm < 32 ? latA : latB;
        const float* g = gv + (size_t)mr * NMOD;
#pragma unroll
        for (int bj = 0; bj < 2; ++bj) { const int col = col0 + bj * HALF;
            const f32x4 g0 = *(const f32x4*)(g + col), g1 = *(const f32x4*)(g + col + 4);
#pragma unroll
            for (int ai = 0; ai < 2; ++ai)
#pragma unroll
                for (int m = 0; m < 4; ++m) { const size_t off = (size_t)(row0 + ai * HALF + m * 16) * DM + col;
                    f32x4 l0, l1;
                    if (lat16) { const h8 t = *(const h8*)((const f16*)lat + (off - rbase)); l0 = (f32x4){(float)t[0], (float)t[1], (float)t[2], (float)t[3]}; l1 = (f32x4){(float)t[4], (float)t[5], (float)t[6], (float)t[7]}; }
                    else { l0 = *(const f32x4*)((const float*)lat + (off - rbase)); l1 = *(const f32x4*)((const float*)lat + (off - rbase) + 4); }
                    const f32x4 z0 = l0 * DN_ALPHA + g0 * acc[ai][bj][m][0], z1 = l1 * DN_ALPHA + g1 * acc[ai][bj][m][1];
                    u32x4 w; w.x = pkh(z0[0], z0[1]); w.y = pkh(z0[2], z0[3]); w.z = pkh(z1[0], z1[1]); w.w = pkh(z1[2], z1[3]); *(u32x4*)(Z + off) = w; } }
    }
};

struct EpiResLN {
    static constexpr bool PERM = true, HOOK = false, SK = true;
    const void* latA; const void* latB; const float* gv; int lat16;
    const float* lng; const float* lnb; const float* msh; const float* msc;
    f16* LAT; f16* H; float* out; int writeOut;
    unsigned long long* xslot; unsigned* cnt; LAS unsigned char* lx;
    __device__ __forceinline__ void pre(f32x4 (&acc)[2][2][4][2], const Unit& u, int wr, int wc, int fr, int fq) const {
        int row0 = u.pm * BM + wr * 64 + fr, col0 = u.pn * BM + wc * 32 + 8 * fq;
        asm volatile("" : "+v"(row0), "+v"(col0));
        const int mr = u.pm < 16 ? 0 : (u.pm < 32 ? 1 : 2);
        const size_t rbase = u.pm < 32 ? 0 : (size_t)NLAT * DM;
        const void* lat = u.pm < 32 ? latA : latB;
        const float* g = gv + (size_t)mr * NMOD;
#pragma unroll
        for (int bj = 0; bj < 2; ++bj) { const int col = col0 + bj * HALF;
            const f32x4 g0 = *(const f32x4*)(g + col), g1 = *(const f32x4*)(g + col + 4);
#pragma unroll
            for (int ai = 0; ai < 2; ++ai) {
#pragma unroll
                for (int m = 0; m < 4; ++m) { const size_t off = (size_t)(row0 + ai * HALF + m * 16) * DM + col - rbase;
                    f32x4 l0, l1;
                    if (lat16) { const h8 t = *(const h8*)((const f16*)lat + off); l0 = (f32x4){(float)t[0], (float)t[1], (float)t[2], (float)t[3]}; l1 = (f32x4){(float)t[4], (float)t[5], (float)t[6], (float)t[7]}; }
                    else { l0 = *(const f32x4*)((const float*)lat + off); l1 = *(const f32x4*)((const float*)lat + off + 4); }
                    acc[ai][bj][m][0] = l0 * DN_ALPHA + g0 * acc[ai][bj][m][0]; acc[ai][bj][m][1] = l1 * DN_ALPHA + g1 * acc[ai][bj][m][1]; }
                asm volatile("" : "+v"(acc[ai][bj][0][0]), "+v"(acc[ai][bj][0][1]), "+v"(acc[ai][bj][1][0]), "+v"(acc[ai][bj][1][1]), "+v"(acc[ai][bj][2][0]), "+v"(acc[ai][bj][2][1]), "+v"(acc[ai][bj][3][0]), "+v"(acc[ai][bj][3][1]) :: "memory"); } }
    }
    __device__ __forceinline__ void operator()(const f32x4 (&acc)[2][2][4][2], const Unit& u, int wr, int wc, int fr, int fq) const {
        LAS f32x2* P = (LAS f32x2*)lx; LAS f32x2* S = (LAS f32x2*)(lx + 8192); volatile LAS unsigned* flag = (volatile LAS unsigned*)(lx + 10240);
        const int wid = wr * 4 + wc, lane = fq * 16 + fr;
#pragma unroll
        for (int ai = 0; ai < 2; ++ai)
#pragma unroll
            for (int m = 0; m < 4; ++m) {
                float sm = 0.f;
#pragma unroll
                for (int bj = 0; bj < 2; ++bj)
#pragma unroll
                    for (int n = 0; n < 2; ++n) { const f32x4 xv = acc[ai][bj][m][n]; sm += (xv[0] + xv[1]) + (xv[2] + xv[3]); }
                sm += __shfl_xor(sm, 16); sm += __shfl_xor(sm, 32);
                const float mw = sm * (1.0f / 64.0f); float q = 0.f;
#pragma unroll
                for (int bj = 0; bj < 2; ++bj)
#pragma unroll
                    for (int n = 0; n < 2; ++n) { const f32x4 d = acc[ai][bj][m][n] - mw; q += (d[0] * d[0] + d[1] * d[1]) + (d[2] * d[2] + d[3] * d[3]); }
                q += __shfl_xor(q, 16); q += __shfl_xor(q, 32);
                if (fq == 0) P[(ai * HALF + wr * 64 + m * 16 + fr) * 4 + wc] = (f32x2){mw, q};
            }
        asm volatile("s_waitcnt lgkmcnt(0)" ::: "memory"); __builtin_amdgcn_s_barrier(); asm volatile("" ::: "memory");
        const int row = wid * 32 + (lane & 31);
        if (lane < 32) {
            const f32x2 pa = P[row * 4 + 0], pb = P[row * 4 + 1], pc = P[row * 4 + 2], pd = P[row * 4 + 3];
            const float mt = ((pa.x + pb.x) + (pc.x + pd.x)) * 0.25f;
            const float da = pa.x - mt, db = pb.x - mt, dc = pc.x - mt, dd = pd.x - mt;
            const float m2 = ((pa.y + pb.y) + (pc.y + pd.y)) + 64.0f * ((da * da + db * db) + (dc * dc + dd * dd));
            __hip_atomic_store(xslot + ((size_t)(u.pm * BM + row) * 16 + u.pn), ((unsigned long long)__float_as_uint(m2) << 32) | __float_as_uint(mt), __ATOMIC_RELAXED, __HIP_MEMORY_SCOPE_AGENT);
        }
        asm volatile("s_waitcnt vmcnt(0)" ::: "memory");
        if (lane == 0) __hip_atomic_fetch_add(cnt + 64 * u.pm, 1u, __ATOMIC_RELAXED, __HIP_MEMORY_SCOPE_AGENT);
        if (wid == 0) {
            unsigned sp = 0;
            while ((unsigned)__builtin_amdgcn_readfirstlane((int)__hip_atomic_load(cnt + 64 * u.pm, __ATOMIC_RELAXED, __HIP_MEMORY_SCOPE_AGENT)) < 128u) { __builtin_amdgcn_s_sleep(1); if (++sp > (1u << 22)) break; }
            __builtin_amdgcn_fence(__ATOMIC_ACQUIRE, "agent");
            if (lane == 0) flag[0] = 1u;
        }
        asm volatile("s_waitcnt vmcnt(0) lgkmcnt(0)" ::: "memory"); __builtin_amdgcn_s_barrier(); asm volatile("" ::: "memory");
        if (lane < 32) {
            const unsigned long long* sl = xslot + (size_t)(u.pm * BM + row) * 16; float mt[16], m2[16]; float ms = 0.f;
#pragma unroll
            for (int t = 0; t < 16; ++t) { const unsigned long long wv = __hip_atomic_load(sl + t, __ATOMIC_RELAXED, __HIP_MEMORY_SCOPE_AGENT); mt[t] = __uint_as_float((unsigned)wv); m2[t] = __uint_as_float((unsigned)(wv >> 32)); ms += mt[t]; }
            const float mean = ms * (1.0f / 16.0f); float q = 0.f;
#pragma unroll
            for (int t = 0; t < 16; ++t) { const float dm = mt[t] - mean; q += m2[t] + 256.0f * dm * dm; }
            S[row] = (f32x2){mean, 1.0f / sqrtf(q * (1.0f / DM) + LN_EPS)};
        }
        asm volatile("s_waitcnt lgkmcnt(0)" ::: "memory"); __builtin_amdgcn_s_barrier(); asm volatile("" ::: "memory");
        const int row0 = u.pm * BM + wr * 64 + fr, col0 = u.pn * BM + wc * 32 + 8 * fq;
        const int mr = u.pm < 16 ? 0 : (u.pm < 32 ? 1 : 2);
#pragma unroll
        for (int bj = 0; bj < 2; ++bj) { const int col = col0 + bj * HALF;
            const f32x4 g0 = *(const f32x4*)(lng + col), g1 = *(const f32x4*)(lng + col + 4), b0 = *(const f32x4*)(lnb + col), b1 = *(const f32x4*)(lnb + col + 4);
            f32x4 c0 = {0.f, 0.f, 0.f, 0.f}, c1 = c0, h0 = c0, h1 = c0;
            if (!writeOut) { const float* sc = msc + (size_t)mr * NMOD + col; const float* sh = msh + (size_t)mr * NMOD + col; c0 = *(const f32x4*)sc + 1.0f; c1 = *(const f32x4*)(sc + 4) + 1.0f; h0 = *(const f32x4*)sh; h1 = *(const f32x4*)(sh + 4); }
#pragma unroll
            for (int ai = 0; ai < 2; ++ai)
#pragma unroll
                for (int m = 0; m < 4; ++m) { const int rl = ai * HALF + wr * 64 + m * 16 + fr; const f32x2 st = S[rl]; const size_t off = (size_t)(row0 + ai * HALF + m * 16) * DM + col;
                    const f32x4 y0 = (acc[ai][bj][m][0] - st.x) * st.y * g0 + b0, y1 = (acc[ai][bj][m][1] - st.x) * st.y * g1 + b1;
                    if (writeOut) { if (u.pm < 32) { *(f32x4*)(out + off) = y0; *(f32x4*)(out + off + 4) = y1; } }
                    else { u32x4 w; w.x = pkh(y0[0], y0[1]); w.y = pkh(y0[2], y0[3]); w.z = pkh(y1[0], y1[1]); w.w = pkh(y1[2], y1[3]); *(u32x4*)(LAT + off) = w;
                        const f32x4 v0 = y0 * c0 + h0, v1 = y1 * c1 + h1; u32x4 w2; w2.x = pkh(v0[0], v0[1]); w2.y = pkh(v0[2], v0[3]); w2.z = pkh(v1[0], v1[1]); w2.w = pkh(v1[2], v1[3]); *(u32x4*)(H + off) = w2; } } }
    }
};

template <class Epi, class Sched, bool ALIGN_EPI = true, bool SP2 = true, bool SKW = false>
__device__ __forceinline__ void gemm_phase(LAS unsigned char* lds, const Gemm g, const Sched& S, const Epi& E, const SKCtx SK, const int wave0) {
    int tid = tid_of(wave0); asm volatile("" : "+v"(tid));
    const int wid = __builtin_amdgcn_readfirstlane(tid >> 6), lane = tid & 63, wr = wid >> 2, wc = wid & 3, fr = lane & 15, fq = lane >> 4;
    const int K = g.K;
    unsigned voffA[2], voffB[2];
#pragma unroll
    for (int i = 0; i < 2; ++i) { int R, C; stage_rc(tid * 16 + i * 8192, R, C); const int Rb = Epi::PERM ? ((R & ~31) + perm32(R & 31)) : R;
        voffA[i] = (unsigned)(R * K + C) * 2u; voffB[i] = (unsigned)(Rb * K + C) * 2u; }
    const size_t kstep = (size_t)(BK * 2);
    const size_t hstep = (size_t)HALF * K * 2;
    const size_t tstep = 2 * hstep;
    const unsigned ldsw = (unsigned)wid * 1024u;
    const int aoff = lds_byte(wr * 64 + fr, fq * 8), boff = lds_byte(wc * 32 + fr, fq * 8);
#define PG8_SA(b, h) (((b) * 2 + (h)) * HTB)
#define PG8_SB(b, h) ((4 + (b) * 2 + (h)) * HTB)
#define PG8_STAGE(bufoff, gbase, voff) do { _Pragma("unroll") for (int _i = 0; _i < 2; ++_i) \
        __builtin_amdgcn_global_load_lds((const unsigned*)((const char*)(gbase) + (voff)[_i]), (LAS unsigned*)(lds + (bufoff) + ldsw + _i * 8192), 16, 0, 0); } while (0)
#define PG8_LDA(dst, b, h) do { _Pragma("unroll") for (int m = 0; m < 4; ++m) _Pragma("unroll") for (int k = 0; k < 2; ++k) dst[m][k] = *(const LAS h8*)(lds + PG8_SA(b, h) + aoff + m * 2048 + k * 1024); } while (0)
#define PG8_LDB(dst, b, h) do { _Pragma("unroll") for (int n = 0; n < 2; ++n) _Pragma("unroll") for (int k = 0; k < 2; ++k) dst[n][k] = *(const LAS h8*)(lds + PG8_SB(b, h) + boff + n * 2048 + k * 1024); } while (0)
#define PG8_MMA(ai, bj, At, Bt) do { __builtin_amdgcn_s_setprio(1); _Pragma("unroll") for (int m = 0; m < 4; ++m) _Pragma("unroll") for (int n = 0; n < 2; ++n) _Pragma("unroll") for (int k = 0; k < 2; ++k) \
        acc[ai][bj][m][n] = __builtin_amdgcn_mfma_f32_16x16x32_f16(Bt[n][k], At[m][k], acc[ai][bj][m][n], 0, 0, 0); __builtin_amdgcn_s_setprio(0); } while (0)
#define PG8_WAIT_V(n) asm volatile("s_waitcnt vmcnt(" #n ")" ::: "memory")
#define PG8_WAIT_L(n) asm volatile("s_waitcnt lgkmcnt(" #n ")" ::: "memory")
#define PG8_BAR __builtin_amdgcn_s_barrier()
#define PG8_SCHED __builtin_amdgcn_sched_barrier(0)
    Unit cur, nxt; int ui = 0;
    if (!S.next(0, cur)) return;
    f32x4 acc[2][2][4][2];
#pragma unroll
    for (int a = 0; a < 2; ++a)
#pragma unroll
        for (int b = 0; b < 2; ++b)
#pragma unroll
            for (int m = 0; m < 4; ++m)
#pragma unroll
                for (int n = 0; n < 2; ++n) acc[a][b][m][n] = (f32x4){0.f, 0.f, 0.f, 0.f};
    h8 At[4][2], B0[2][2], B1[2][2];
    constexpr bool SKP = SK_ENABLE || SKW;
    const char* cA = (const char*)g.A + (size_t)cur.pm * tstep + (SKP ? (size_t)cur.k0 * 2 : 0); const char* cB = (const char*)g.Bt + (size_t)cur.pn * tstep + (SKP ? (size_t)cur.k0 * 2 : 0);
    if constexpr (SP2) {
        PG8_STAGE(PG8_SB(0, 0), cB, voffB); PG8_STAGE(PG8_SB(0, 1), cB + hstep, voffB); PG8_STAGE(PG8_SA(0, 0), cA, voffA); PG8_STAGE(PG8_SA(0, 1), cA + hstep, voffA);
        if (wr == 1) PG8_BAR;
        PG8_WAIT_V(2); PG8_BAR;
        PG8_STAGE(PG8_SB(1, 0), cB + kstep, voffB); PG8_STAGE(PG8_SA(1, 0), cA + kstep, voffA); PG8_STAGE(PG8_SB(1, 1), cB + hstep + kstep, voffB);
        PG8_WAIT_V(6); PG8_BAR;
    } else {
        PG8_STAGE(PG8_SB(0, 0), cB, voffB); PG8_STAGE(PG8_SA(0, 0), cA, voffA); PG8_STAGE(PG8_SB(0, 1), cB + hstep, voffB); PG8_STAGE(PG8_SA(0, 1), cA + hstep, voffA);
        if (wr == 1) PG8_BAR;
        PG8_WAIT_V(4); PG8_BAR;
        PG8_STAGE(PG8_SB(1, 0), cB + kstep, voffB); PG8_STAGE(PG8_SA(1, 0), cA + kstep, voffA); PG8_STAGE(PG8_SB(1, 1), cB + hstep + kstep, voffB);
        PG8_WAIT_V(6); PG8_BAR;
    }
    for (;;) {
        const bool has_next = S.next(ui + 1, nxt);
        const char* nA = has_next ? (const char*)g.A + (size_t)nxt.pm * tstep + (SKP ? (size_t)nxt.k0 * 2 : 0) : cA; const char* nB = has_next ? (const char*)g.Bt + (size_t)nxt.pn * tstep + (SKP ? (size_t)nxt.k0 * 2 : 0) : cB;
        const int nt = SKP ? cur.nt : K / BK, kt0 = SKP ? (cur.k0 >> 6) : 0;
        for (int t = 0; t < nt; t += 2) {
            const bool last = (t == nt - 2);
            if constexpr (Epi::HOOK) { const int gt = kt0 + t; if (t > 0 && (gt == 16 || gt == 32)) E.hook(acc, cur, gt, wr, wc, fr, fq); }
            const char* a1 = cA + (size_t)(t + 1) * kstep;
            const char* a2 = last ? nA : cA + (size_t)(t + 2) * kstep; const char* b2 = last ? nB : cB + (size_t)(t + 2) * kstep;
            const char* a3 = a2 + kstep; const char* b3 = b2 + kstep;
            if constexpr (SP2) {
            PG8_LDB(B0, 0, 0); PG8_LDB(B1, 0, 1); PG8_SCHED; PG8_LDA(At, 0, 0); PG8_STAGE(PG8_SA(1, 1), a1 + hstep, voffA);
            PG8_WAIT_V(8); PG8_WAIT_L(0); PG8_BAR; PG8_MMA(0, 0, At, B0); PG8_MMA(0, 1, At, B1); PG8_BAR; PG8_SCHED;
            PG8_LDA(At, 0, 1); PG8_STAGE(PG8_SB(0, 0), b2, voffB); PG8_STAGE(PG8_SB(0, 1), b2 + hstep, voffB); PG8_STAGE(PG8_SA(0, 0), a2, voffA);
            PG8_WAIT_V(8); PG8_WAIT_L(0); PG8_BAR; PG8_MMA(1, 0, At, B0); PG8_MMA(1, 1, At, B1); PG8_BAR; PG8_SCHED;
            PG8_LDB(B0, 1, 0); PG8_LDB(B1, 1, 1); PG8_SCHED; PG8_LDA(At, 1, 0); PG8_STAGE(PG8_SA(0, 1), a2 + hstep, voffA);
            PG8_WAIT_V(8); PG8_WAIT_L(0); PG8_BAR; PG8_MMA(0, 0, At, B0); PG8_MMA(0, 1, At, B1); PG8_BAR; PG8_SCHED;
            PG8_LDA(At, 1, 1); PG8_STAGE(PG8_SB(1, 0), b3, voffB); PG8_STAGE(PG8_SB(1, 1), b3 + hstep, voffB); PG8_STAGE(PG8_SA(1, 0), a3, voffA);
            PG8_WAIT_V(8); PG8_WAIT_L(0); PG8_BAR; PG8_MMA(1, 0, At, B0); PG8_MMA(1, 1, At, B1); PG8_BAR; PG8_SCHED;
            } else {
            PG8_LDB(B0, 0, 0); PG8_SCHED; PG8_LDA(At, 0, 0); PG8_STAGE(PG8_SA(1, 1), a1 + hstep, voffA);
            PG8_WAIT_L(8); PG8_BAR; PG8_WAIT_L(0); PG8_MMA(0, 0, At, B0); PG8_BAR; PG8_SCHED;
            PG8_LDB(B1, 0, 1); PG8_STAGE(PG8_SB(0, 0), b2, voffB);
            PG8_BAR; PG8_WAIT_L(0); PG8_MMA(0, 1, At, B1); PG8_BAR;
            PG8_LDA(At, 0, 1); PG8_STAGE(PG8_SA(0, 0), a2, voffA);
            PG8_BAR; PG8_WAIT_L(0); PG8_MMA(1, 0, At, B0); PG8_BAR; PG8_SCHED;
            PG8_STAGE(PG8_SB(0, 1), b2 + hstep, voffB);
            PG8_WAIT_V(6); PG8_BAR; PG8_MMA(1, 1, At, B1); PG8_BAR;
            PG8_LDB(B0, 1, 0); PG8_SCHED; PG8_LDA(At, 1, 0); PG8_STAGE(PG8_SA(0, 1), a2 + hstep, voffA);
            PG8_WAIT_L(8); PG8_BAR; PG8_WAIT_L(0); PG8_MMA(0, 0, At, B0); PG8_BAR; PG8_SCHED;
            PG8_LDB(B1, 1, 1); PG8_STAGE(PG8_SB(1, 0), b3, voffB);
            PG8_BAR; PG8_WAIT_L(0); PG8_MMA(0, 1, At, B1); PG8_BAR;
            PG8_LDA(At, 1, 1); PG8_STAGE(PG8_SA(1, 0), a3, voffA);
            PG8_BAR; PG8_WAIT_L(0); PG8_MMA(1, 0, At, B0); PG8_BAR; PG8_SCHED;
            PG8_STAGE(PG8_SB(1, 1), b3 + hstep, voffB);
            PG8_WAIT_V(6); PG8_BAR; PG8_MMA(1, 1, At, B1); PG8_BAR;
            }
        }
        if constexpr (ALIGN_EPI) { if (wr == 0) PG8_BAR; }
        if constexpr (SKW) {
            f32x4* af = &acc[0][0][0][0];
            const float* s0 = SK.slab + ((size_t)(cur.rid * cur.ns) * 8 + wid) * 8192;
            int voff = lane * 16; asm volatile("" : "+v"(voff));
            { uintptr_t sb = (uintptr_t)(s0 + (size_t)cur.sl * 8 * 8192); const unsigned lo = __builtin_amdgcn_readfirstlane((unsigned)sb), hi = __builtin_amdgcn_readfirstlane((unsigned)(sb >> 32));
              const __amdgpu_buffer_rsrc_t rs = __builtin_amdgcn_make_buffer_rsrc((void*)(((uintptr_t)hi << 32) | lo), 0, 32768, 0x00020000);
#pragma unroll
              for (int q = 0; q < 32; ++q) __builtin_amdgcn_raw_buffer_store_b128(__builtin_bit_cast(u32x4, af[q]), rs, voff, q * 1024, 16); }
            asm volatile("s_waitcnt vmcnt(0)" ::: "memory"); PG8_BAR;
            volatile LAS unsigned* mk = (volatile LAS unsigned*)(lds + MISC_OFF);
            if (wid == 0) { unsigned old = 0; if (voff == 0) old = __hip_atomic_fetch_add(SK.cnt + cur.rid * 16, 1u, __ATOMIC_RELAXED, __HIP_MEMORY_SCOPE_AGENT);
                old = __builtin_amdgcn_readfirstlane(old); if (voff == 0) mk[30] = old; }
            asm volatile("s_waitcnt vmcnt(0) lgkmcnt(0)" ::: "memory"); PG8_BAR;
            if ((unsigned)__builtin_amdgcn_readfirstlane((int)mk[30]) == (unsigned)(cur.ns - 1)) {
                __builtin_amdgcn_fence(__ATOMIC_ACQUIRE, "agent"); asm volatile("s_waitcnt vmcnt(0)" ::: "memory");
#pragma unroll
                for (int q = 0; q < 32; ++q) af[q] = (f32x4){0.f, 0.f, 0.f, 0.f};
                for (int sl = 0; sl < cur.ns; ++sl) {
                    uintptr_t sb = (uintptr_t)(s0 + (size_t)sl * 8 * 8192); const unsigned lo = __builtin_amdgcn_readfirstlane((unsigned)sb), hi = __builtin_amdgcn_readfirstlane((unsigned)(sb >> 32));
                    const __amdgpu_buffer_rsrc_t rs = __builtin_amdgcn_make_buffer_rsrc((void*)(((uintptr_t)hi << 32) | lo), 0, 32768, 0x00020000);
#pragma unroll
                    for (int qg = 0; qg < 2; ++qg) {
                        f32x4 t_[16];
#pragma unroll
                        for (int q = 0; q < 16; ++q) t_[q] = __builtin_bit_cast(f32x4, __builtin_amdgcn_raw_buffer_load_b128(rs, voff, (16 * qg + q) * 1024, 0));
#pragma unroll
                        for (int q = 0; q < 16; ++q) af[16 * qg + q] += t_[q];
                        asm volatile("" : "+v"(af[16 * qg]), "+v"(af[16 * qg + 1]), "+v"(af[16 * qg + 2]), "+v"(af[16 * qg + 3]), "+v"(af[16 * qg + 4]), "+v"(af[16 * qg + 5]), "+v"(af[16 * qg + 6]), "+v"(af[16 * qg + 7]),
                                     "+v"(af[16 * qg + 8]), "+v"(af[16 * qg + 9]), "+v"(af[16 * qg + 10]), "+v"(af[16 * qg + 11]), "+v"(af[16 * qg + 12]), "+v"(af[16 * qg + 13]), "+v"(af[16 * qg + 14]), "+v"(af[16 * qg + 15]) :: "memory"); } }
                E.pre(acc, cur, wr, wc, fr, fq); E(acc, cur, wr, wc, fr, fq);
            }
        } else if (!SK_ENABLE || cur.ns == 1) { E.pre(acc, cur, wr, wc, fr, fq); E(acc, cur, wr, wc, fr, fq); }
        else {
            E.pre(acc, cur, wr, wc, fr, fq);
            f32x4* af = &acc[0][0][0][0];
            const float* s0 = SK.slab + ((size_t)(cur.rid * cur.ns) * 8 + wid) * 8192;
            int voff = lane * 16; asm volatile("" : "+v"(voff));
            { uintptr_t sb = (uintptr_t)(s0 + (size_t)cur.sl * 8 * 8192); const unsigned lo = __builtin_amdgcn_readfirstlane((unsigned)sb), hi = __builtin_amdgcn_readfirstlane((unsigned)(sb >> 32));
              const __amdgpu_buffer_rsrc_t rs = __builtin_amdgcn_make_buffer_rsrc((void*)(((uintptr_t)hi << 32) | lo), 0, 32768, 0x00020000);
#pragma unroll
              for (int q = 0; q < 32; ++q) __builtin_amdgcn_raw_buffer_store_b128(__builtin_bit_cast(u32x4, af[q]), rs, voff, q * 1024, 16); }
            asm volatile("s_waitcnt vmcnt(0)" ::: "memory");
            unsigned old = 0; if (lane == 0) old = __hip_atomic_fetch_add(SK.cnt + cur.rid * 16 + wid, 1u, __ATOMIC_RELAXED, __HIP_MEMORY_SCOPE_AGENT);
            old = __builtin_amdgcn_readfirstlane(old);
            if (old == (unsigned)(cur.ns - 1)) {
                __builtin_amdgcn_fence(__ATOMIC_ACQUIRE, "agent"); asm volatile("s_waitcnt vmcnt(0)" ::: "memory");
#pragma unroll
                for (int q = 0; q < 32; ++q) af[q] = (f32x4){0.f, 0.f, 0.f, 0.f};
                for (int sl = 0; sl < cur.ns; ++sl) {
                    uintptr_t sb = (uintptr_t)(s0 + (size_t)sl * 8 * 8192); const unsigned lo = __builtin_amdgcn_readfirstlane((unsigned)sb), hi = __builtin_amdgcn_readfirstlane((unsigned)(sb >> 32));
                    const __amdgpu_buffer_rsrc_t rs = __builtin_amdgcn_make_buffer_rsrc((void*)(((uintptr_t)hi << 32) | lo), 0, 32768, 0x00020000);
#pragma unroll
                    for (int qg = 0; qg < 4; ++qg) {
#pragma unroll
                        for (int q = 8 * qg; q < 8 * qg + 8; ++q) af[q] += __builtin_bit_cast(f32x4, __builtin_amdgcn_raw_buffer_load_b128(rs, voff, q * 1024, 0));
                        asm volatile("" : "+v"(af[8 * qg]), "+v"(af[8 * qg + 1]), "+v"(af[8 * qg + 2]), "+v"(af[8 * qg + 3]), "+v"(af[8 * qg + 4]), "+v"(af[8 * qg + 5]), "+v"(af[8 * qg + 6]), "+v"(af[8 * qg + 7]) :: "memory"); } }
                E(acc, cur, wr, wc, fr, fq);
            }
        }
        if (!has_next) break;
#pragma unroll
        for (int a = 0; a < 2; ++a)
#pragma unroll
            for (int b = 0; b < 2; ++b)
#pragma unroll
                for (int m = 0; m < 4; ++m)
#pragma unroll
                    for (int n = 0; n < 2; ++n) acc[a][b][m][n] = (f32x4){0.f, 0.f, 0.f, 0.f};
        cur = nxt; cA = nA; cB = nB; ++ui;
        if constexpr (ALIGN_EPI) { if (wr == 1) PG8_BAR; }
    }
    PG8_WAIT_V(0);
    if constexpr (!ALIGN_EPI) { if (wr == 0) PG8_BAR; }
    PG8_BAR;
#undef PG8_SA
#undef PG8_SB
#undef PG8_STAGE
#undef PG8_LDA
#undef PG8_LDB
#undef PG8_MMA
#undef PG8_WAIT_V
#undef PG8_WAIT_L
#undef PG8_BAR
#undef PG8_SCHED
}
}

#define XB_TMO      128
#define XB_XCNT(j)  (256  + 64 * (j))
#define XB_XSUB(j)  (1280 + 64 * (j))
#define XB_XGEN(j)  (2304 + 64 * (j))
#define XB_TOP      3328
#define XB_TOPGEN   3392
#define XCD_BAR_WORDS 3456
#define XB_SPIN_CAP (1u << 22)
__device__ __forceinline__ unsigned xb_ld(unsigned* p)              { return __hip_atomic_load(p, __ATOMIC_RELAXED, __HIP_MEMORY_SCOPE_AGENT); }
__device__ __forceinline__ unsigned xb_add(unsigned* p, unsigned v) { return __hip_atomic_fetch_add(p, v, __ATOMIC_RELAXED, __HIP_MEMORY_SCOPE_AGENT); }
__device__ __forceinline__ unsigned xb_xcc_id() { return (unsigned)__builtin_amdgcn_s_getreg((3 << 11) | 20) & 0xFu; }
#define XB_SPIN(cond, bar) do { unsigned _sp = 0; while (cond) { __builtin_amdgcn_s_sleep(1); \
    if ((++_sp & 255u) == 0u) { if (xb_ld(&(bar)[XB_TMO])) break; if (_sp > XB_SPIN_CAP) { atomicAdd(&(bar)[XB_TMO], 1u); break; } } } } while (0)
struct XcdBarrier { unsigned* bar; unsigned x; volatile LAS unsigned* st; };
__device__ __forceinline__ XcdBarrier xcd_barrier_post(unsigned* bar, volatile LAS unsigned* st, int tid0) {
    XcdBarrier b; b.bar = bar; b.x = xb_xcc_id(); b.st = st;
    if (tid0 == 0) (void)xb_add(&bar[XB_XCNT(b.x)], 1u);
    return b;
}
__device__ __forceinline__ void xcd_barrier_complete(unsigned* bar, unsigned x, unsigned& nloc, unsigned& nx) {
    const unsigned G = gridDim.x * gridDim.y * gridDim.z;
    unsigned sum, cnt, mine, sp = 0u;
    for (;;) {
        sum = 0u; cnt = 0u; mine = 0u;
#pragma unroll
        for (unsigned j = 0; j < 16; ++j) { const unsigned c = xb_ld(&bar[XB_XCNT(j)]); sum += c; cnt += (c > 0u) ? 1u : 0u; mine = (j == x) ? c : mine; }
        if (sum == G) break;
        __builtin_amdgcn_s_sleep(1);
        if ((++sp & 255u) == 0u) { if (xb_ld(&bar[XB_TMO])) break; if (sp > XB_SPIN_CAP) { atomicAdd(&bar[XB_TMO], 1u); break; } }
    }
    nloc = mine > 0u ? mine : 1u; nx = cnt > 0u ? cnt : 1u;
}
__device__ __forceinline__ void xcd_barrier(const XcdBarrier& b, const int wave0) {
    asm volatile("s_waitcnt vmcnt(0)" ::: "memory");
    __syncthreads();
    int t0_ = tid_of(wave0); asm volatile("" : "+v"(t0_));
    if (t0_ == 0) {
        unsigned* bar = b.bar;
        __builtin_amdgcn_s_waitcnt(0);
        unsigned nloc = b.st[0], nx = b.st[1];
        if (nloc == 0u) { unsigned xl = b.x; asm volatile("" : "+s"(xl)); xcd_barrier_complete(bar, xl, nloc, nx); b.st[0] = nloc; b.st[1] = nx; }
        const unsigned old = xb_add(&bar[XB_XSUB(b.x)], 1u);
        const unsigned gen = old / nloc;
        if (old + 1u == (gen + 1u) * nloc) {
            __builtin_amdgcn_fence(__ATOMIC_RELEASE, "agent");
            asm volatile("s_waitcnt vmcnt(0)" ::: "memory");
            const unsigned og = xb_add(&bar[XB_TOP], 1u);
            const unsigned tg = og / nx;
            if (og + 1u == (tg + 1u) * nx) xb_add(&bar[XB_TOPGEN], 1u);
            else XB_SPIN(xb_ld(&bar[XB_TOPGEN]) == tg, bar);
            __builtin_amdgcn_fence(__ATOMIC_ACQUIRE, "agent");
            xb_add(&bar[XB_XGEN(b.x)], 1u);
            asm volatile("s_waitcnt vmcnt(0)" ::: "memory");
        } else {
            XB_SPIN(xb_ld(&bar[XB_XGEN(b.x)]) == gen, bar);
            __builtin_amdgcn_fence(__ATOMIC_ACQUIRE, "agent");
            asm volatile("s_waitcnt vmcnt(0)" ::: "memory");
        }
    }
    __syncthreads();
}

__device__ __forceinline__ void rope_table(f32x2* tab, int tid) {
    for (int e = tid; e < 64 * 32; e += 512) {
        const int pos = e >> 5, i = e & 31;
        double invf = 1.0; for (int j = 0; j < i; ++j) invf *= 0.74989420933245582730;
        const float ang = (float)pos * (float)invf;
        const double xd = (double)ang;
        const double kq = __builtin_rint(xd * 0.63661977236758134308);
        const double r = (xd - kq * 1.5707963267948966192) - kq * 6.123233995736766e-17;
        const double r2 = r * r;
        double sn = r * (1.0 + r2 * (-1.0 / 6 + r2 * (1.0 / 120 + r2 * (-1.0 / 5040 + r2 * (1.0 / 362880 + r2 * (-1.0 / 39916800 + r2 * (1.0 / 6227020800.0 + r2 * (-1.0 / 1307674368000.0))))))));
        double cs = 1.0 + r2 * (-0.5 + r2 * (1.0 / 24 + r2 * (-1.0 / 720 + r2 * (1.0 / 40320 + r2 * (-1.0 / 3628800 + r2 * (1.0 / 479001600 + r2 * (-1.0 / 87178291200.0)))))));
        const int q = ((int)kq) & 3;
        double c2, s2;
        if (q == 0) { c2 = cs; s2 = sn; } else if (q == 1) { c2 = -sn; s2 = cs; } else if (q == 2) { c2 = -cs; s2 = -sn; } else { c2 = sn; s2 = -cs; }
        tab[e] = (f32x2){(float)c2, (float)s2};
    }
}
__device__ __forceinline__ void ph_modgemv(const Args& a, LAS unsigned char* lds, int tid, int lane, int wave, int first, int last_item, int stride) {
    LAS float* sv = (LAS float*)lds;
    LAS float* red = (LAS float*)(lds + 49152);
    float* MOD = (float*)(a.ws + WS_MOD);
    for (int i = tid; i < 3 * DM; i += 512) { const int r = i >> 12, k = i & 4095; const float c = r < 2 ? a.c[r * DM + k] : a.c_ctx[k]; sv[i] = c * sigmoidf_(c); }
    __syncthreads();
    for (int item = first; item < last_item; item += stride) {
        const int l = item >> 7, cb = item & 127;
        f32x4 acc0 = {0.f, 0.f, 0.f, 0.f}, acc1 = acc0, acc2 = acc0;
        if (lane < 48) {
            const float* wp = a.w_mod + (size_t)l * DM * NMOD + (size_t)(wave * 512) * NMOD + cb * 192 + lane * 4;
            const LAS float* s0 = sv + wave * 512;
            for (int k = 0; k < 512; k += 16) {
                f32x4 v[16];
#pragma unroll
                for (int j = 0; j < 16; ++j) v[j] = *(const f32x4*)(wp + (size_t)(k + j) * NMOD);
#pragma unroll
                for (int j = 0; j < 16; ++j) { acc0 += v[j] * s0[k + j]; acc1 += v[j] * s0[DM + k + j]; acc2 += v[j] * s0[2 * DM + k + j]; }
            }
            *(LAS f32x4*)(red + (wave * 3 + 0) * 192 + lane * 4) = acc0; *(LAS f32x4*)(red + (wave * 3 + 1) * 192 + lane * 4) = acc1; *(LAS f32x4*)(red + (wave * 3 + 2) * 192 + lane * 4) = acc2;
        }
        __syncthreads();
        for (int i = tid; i < 3 * 192; i += 512) { const int r = i / 192, n = i % 192; float s = 0.f;
#pragma unroll
            for (int w = 0; w < 8; ++w) s += red[(w * 3 + r) * 192 + n];
            MOD[(size_t)(l * 3 + r) * NMOD + cb * 192 + n] = s + a.b_mod[l * NMOD + cb * 192 + n]; }
        __syncthreads();
    }
}
__device__ __forceinline__ void cvt_item(const float* W, int K, int N, f16* WT, int ldk, LAS unsigned char* tile, int idx, int lane, bool pair_up = false, bool qk_perm = false) {
    const int nblk = N >> 6, kb = idx / nblk, nb = idx - kb * nblk, k0 = kb * 64, n0 = nb * 64;
    const int d0 = !pair_up ? n0 : (n0 < DFF ? (n0 >> 7) * 256 + (n0 & 127) : ((n0 - DFF) >> 7) * 256 + 128 + ((n0 - DFF) & 127));
    const int g = lane >> 4, q = lane & 15;
    const float* src = W + (size_t)(k0 + 2 * g) * N + n0 + 4 * q;
    f32x4 va[8], vb[8];
#pragma unroll
    for (int i = 0; i < 8; ++i) { va[i] = *(const f32x4*)(src + (size_t)(8 * i) * N); vb[i] = *(const f32x4*)(src + (size_t)(8 * i + 1) * N); }
    LAS unsigned* T32 = (LAS unsigned*)tile;
#pragma unroll
    for (int i = 0; i < 8; ++i)
#pragma unroll
        for (int j = 0; j < 4; ++j) T32[(4 * q + j) * 36 + 4 * i + g] = pkh(va[i][j], vb[i][j]);
    LDS_WAIT();
    const int c = lane & 7;
#pragma unroll
    for (int jj = 0; jj < 8; ++jj) { const int n = (lane >> 3) + 8 * jj; const u32x4 o = *(const LAS u32x4*)(tile + n * 144 + 16 * c);
        int dr = d0 + n;
        if (qk_perm) { const int cc = n0 + n; if (cc < 1280 || (cc >= 1536 && cc < 2816) || (cc >= 3072 && cc < 5120)) { const int d = cc & 127;
                dr = (cc & ~127) + 32 * (2 * (d >> 6) + ((d >> 4) & 1)) + 8 * ((d >> 2) & 3) + 4 * ((d >> 5) & 1) + (d & 3); } }
        *(u32x4*)(WT + (size_t)dr * ldk + k0 + 8 * c) = o; }
    LDS_WAIT();
}
constexpr int I_IN = 64 * 304, I_BR = 16 * 64, I_O = 64 * 64, I_UP = 64 * 344, I_DN = 172 * 64;
constexpr int QT_BR0 = 3 * I_BR, QT_O0 = QT_BR0 + I_O, QT_UP0 = QT_O0 + I_UP, QT_DN0 = QT_UP0 + I_DN, QT_IN1 = QT_DN0 + I_IN,
              QT_BR1 = QT_IN1 + 3 * I_BR, QT_O1 = QT_BR1 + I_O, QT_UP1 = QT_O1 + I_UP, QT_DN1 = QT_UP1 + I_DN, QTOT = QT_DN1;
__device__ __forceinline__ void ph_convert0(const Args& a, LAS unsigned char* lds, int lane, int wave, int wg, int nwgs) {
    LAS unsigned char* tile = lds + wave * 9216;
    for (int it = wg * 8 + wave; it < I_IN; it += nwgs * 8) cvt_item(a.w_in, DM, INW, (f16*)(a.ws + WS_WIN), DM, tile, it, lane, false, true);
}
__device__ __forceinline__ void cvt_queue_item(const Args& a, int q, LAS unsigned char* tile, int lane) {
    int l = 0, r = q;
    if (q >= QT_DN0) { r = q - QT_DN0; if (r < I_IN) { cvt_item(a.w_in + (size_t)DM * INW, DM, INW, (f16*)(a.ws + WS_WIN + SZ_WIN), DM, tile, r, lane, false, true); return; } r -= I_IN; l = 1; }
    if (r < 3 * I_BR) { const int br = r / I_BR; r -= br * I_BR; cvt_item(a.w_branch + (size_t)(l * 3 + br) * 1024 * DM, 1024, DM, (f16*)(a.ws + WS_WBR + l * SZ_WBR) + br * 1024, 3072, tile, r, lane); return; } r -= 3 * I_BR;
    if (r < I_O) { cvt_item(a.w_o + (size_t)l * DM * DM, DM, DM, (f16*)(a.ws + WS_WO + l * SZ_WO), DM, tile, r, lane); return; } r -= I_O;
    if (r < I_UP) { cvt_item(a.w_up + (size_t)l * DM * 2 * DFF, DM, 2 * DFF, (f16*)(a.ws + WS_WUP + l * SZ_WUP), DM, tile, r, lane, true); return; } r -= I_UP;
    cvt_item(a.w_down + (size_t)l * DFF * DM, DFF, DM, (f16*)(a.ws + WS_WDN + l * SZ_WDN), DFF, tile, r, lane);
}
__device__ __forceinline__ int q_need(int p) {
    return p < 6 ? 0 : p < 7 ? QT_BR0 : p < 8 ? QT_O0 : p < 11 ? QT_UP0 : p < 12 ? QT_DN0 : p < 18 ? QT_IN1 : p < 19 ? QT_BR1 : p < 20 ? QT_O1 : p < 23 ? QT_UP1 : QT_DN1;
}
__device__ __forceinline__ bool q_gemm_phase(int p) { const int j = (p - 2) % 12; return p >= 2 && (j == 0 || j == 5 || j == 6 || j == 8 || j == 10); }
__device__ __forceinline__ void bg_convert(const Args& a, LAS unsigned char* lds, volatile LAS unsigned* MISC, int p, int G, const int wave0) {
    unsigned* ctl = (unsigned*)(a.ws + WS_CTL);
    int tid = tid_of(wave0); asm volatile("" : "+v"(tid));
    const int lane = tid & 63, wave = __builtin_amdgcn_readfirstlane(tid >> 6);
    const bool opp = q_gemm_phase(p); const int need = q_need(p);
    if (opp && tid == 0) __hip_atomic_fetch_add(ctl + CW_QD + 64 * p, 1u, __ATOMIC_RELAXED, __HIP_MEMORY_SCOPE_AGENT);
    if (p == 10 && G >= 256 && (int)blockIdx.x >= 128) ph_modgemv(a, lds, tid, lane, wave, 128 + (int)blockIdx.x - 128, 256, 128);
    const int skip = G > 64 ? 32 : 0;
    if ((int)blockIdx.x < skip) return;
    const int NW = (G - skip) * 8, w = ((int)blockIdx.x - skip) * 8 + wave;
    LAS unsigned char* tile = lds + wave * 9216;
    int k = (int)MISC[16 + wave];
    for (;;) {
        const int q = w + k * NW;
        if (q >= QTOT) { if (wave == 0 && lane == 0) MISC[31] = (unsigned)(p + 1); break; }
        if (q >= need) {
            if (!opp) break;
            if (wave == 0) { if ((unsigned)__builtin_amdgcn_readfirstlane((int)__hip_atomic_load(ctl + CW_QD + 64 * p, __ATOMIC_RELAXED, __HIP_MEMORY_SCOPE_AGENT)) >= (unsigned)G) { if (lane == 0) MISC[31] = (unsigned)(p + 1); break; } }
            else if (MISC[31] == (unsigned)(p + 1)) break;
        }
        cvt_queue_item(a, q, tile, lane);
        ++k;
    }
    if (lane == 0) MISC[16 + wave] = (unsigned)k;
}
__device__ __forceinline__ void ph_modulate0(const Args& a, int lane, int wave) {
    const float* MOD = (const float*)(a.ws + WS_MOD);
    f16* H = (f16*)(a.ws + WS_H);
    for (int row = blockIdx.x * 8 + wave; row < MTOT; row += gridDim.x * 8) {
        const int mr = row < SEQ ? 0 : (row < NLAT ? 1 : 2);
        const f32x4* src = (const f32x4*)(row < NLAT ? a.x + (size_t)row * DM : a.ctx + (size_t)(row - NLAT) * DM) + lane;
        const f32x4* sh = (const f32x4*)(MOD + (size_t)mr * NMOD) + lane; const f32x4* sc = (const f32x4*)(MOD + (size_t)mr * NMOD + DM) + lane;
        u32x2* o = (u32x2*)(H + (size_t)row * DM) + lane;
#pragma unroll 4
        for (int j = 0; j < 16; ++j) { const f32x4 v = src[64 * j], s = sc[64 * j], t = sh[64 * j]; const f32x4 y = v * (s + 1.0f) + t;
            o[64 * j] = (u32x2){pkh(y[0], y[1]), pkh(y[2], y[3])}; }
    }
}

__device__ __forceinline__ void ph_post(const Args& a, int l, int lane, int wave) {
    f16* P = (f16*)(a.ws + WS_P);
    const f32x2* rope = (const f32x2*)(a.ws + WS_ROPE);
    const float* qg = a.q_norm_g + l * HD; const float* kg = a.k_norm_g + l * HD;
    const int gsub = lane >> 3, s = lane & 7;
    const int e0 = (s & 3) * 8 + (s >> 2) * 64;
    const int nitems = MTOT * 36;
    for (int it = (blockIdx.x * 8 + wave) * 8 + gsub; it < nitems; it += gridDim.x * 64) {
        const int row = it / 36, hv = it - row * 36;
        int col, kind;
        if (hv < 8) { col = QA_OFF + hv * HD; kind = 0; } else if (hv < 10) { col = KA_OFF + (hv - 8) * HD; kind = 0; }
        else if (hv < 18) { col = QB_OFF + (hv - 10) * HD; kind = 1; } else if (hv < 20) { col = KB_OFF + (hv - 18) * HD; kind = 2; }
        else if (hv < 28) { col = QR_OFF + (hv - 20) * HD; kind = 0; } else { col = KR_OFF + (hv - 28) * HD; kind = 3; }
        const bool lat = row < NLAT;
        if (!lat && kind == 0) continue;
        f16* p = P + (size_t)row * INW + col + e0;
        const h8 x1 = *(const h8*)p, x2 = *(const h8*)(p + 32);
        float f1[8], f2[8];
#pragma unroll
        for (int j = 0; j < 8; ++j) { f1[j] = (float)x1[j]; f2[j] = (float)x2[j]; }
        if (kind == 1 || kind == 2) {
            float ss = 0.f;
#pragma unroll
            for (int j = 0; j < 8; ++j) ss += f1[j] * f1[j] + f2[j] * f2[j];
            ss += __shfl_xor(ss, 1); ss += __shfl_xor(ss, 2); ss += __shfl_xor(ss, 4);
            const float rs = 1.0f / sqrtf(ss * (1.0f / HD) + RMS_EPS);
            const float* g = (kind == 1 ? qg : kg) + e0;
#pragma unroll
            for (int j = 0; j < 8; ++j) { f1[j] = f1[j] * rs * g[j]; f2[j] = f2[j] * rs * g[32 + j]; }
        }
        if (lat) {
            const int t = row & (SEQ - 1); const int pos = (s < 4) ? (t >> 6) : (t & 63);
            const f32x2* cs = rope + pos * 32 + (s & 3) * 8;
#pragma unroll
            for (int j = 0; j < 8; ++j) { const f32x2 w = cs[j]; const float o1 = f1[j] * w.x - f2[j] * w.y, o2 = f2[j] * w.x + f1[j] * w.y; f1[j] = o1; f2[j] = o2; }
        }
        if (kind == 3) {
#pragma unroll
            for (int j = 0; j < 8; ++j) { f1[j] *= ATT_SCALE; f2[j] *= ATT_SCALE; }
        }
        u32x4 w1, w2; w1.x = pkh(f1[0], f1[1]); w1.y = pkh(f1[2], f1[3]); w1.z = pkh(f1[4], f1[5]); w1.w = pkh(f1[6], f1[7]);
        w2.x = pkh(f2[0], f2[1]); w2.y = pkh(f2[2], f2[3]); w2.z = pkh(f2[4], f2[5]); w2.w = pkh(f2[6], f2[7]);
        *(u32x4*)p = w1; *(u32x4*)(p + 32) = w2;
    }
}
__device__ __forceinline__ void ph_ln(const Args& a, const float* g, const float* b, const float* msh, const float* msc, bool writeH, bool writeOut, int Mrows, int lane, int wave) {
    const f16* Z = (const f16*)(a.ws + WS_Z); f16* LAT = (f16*)(a.ws + WS_LAT); f16* H = (f16*)(a.ws + WS_H);
    for (int row = blockIdx.x * 8 + wave; row < Mrows; row += gridDim.x * 8) {
        const h8* zr = (const h8*)(Z + (size_t)row * DM) + lane;
        f32x4 v[8][2]; float s = 0.f;
#pragma unroll
        for (int j = 0; j < 8; ++j) { const h8 t = zr[64 * j]; v[j][0] = (f32x4){(float)t[0], (float)t[1], (float)t[2], (float)t[3]}; v[j][1] = (f32x4){(float)t[4], (float)t[5], (float)t[6], (float)t[7]};
            s += ((v[j][0][0] + v[j][0][1]) + (v[j][0][2] + v[j][0][3])) + ((v[j][1][0] + v[j][1][1]) + (v[j][1][2] + v[j][1][3])); }
        const float mean = wave_sum(s) * (1.0f / DM); float s2 = 0.f;
#pragma unroll
        for (int j = 0; j < 8; ++j)
#pragma unroll
            for (int hh = 0; hh < 2; ++hh) { v[j][hh] = v[j][hh] - mean; s2 += (v[j][hh][0] * v[j][hh][0] + v[j][hh][1] * v[j][hh][1]) + (v[j][hh][2] * v[j][hh][2] + v[j][hh][3] * v[j][hh][3]); }
        const float rstd = 1.0f / sqrtf(wave_sum(s2) * (1.0f / DM) + LN_EPS);
        const int mr = row < SEQ ? 0 : (row < NLAT ? 1 : 2);
        u32x4* lo = (u32x4*)(LAT + (size_t)row * DM) + lane;
        u32x4* ho = (u32x4*)(H + (size_t)row * DM) + lane;
        float* oo = a.out + (size_t)row * DM + lane * 8;
        const float* gg = g + lane * 8; const float* bb = b + lane * 8;
        const float* sh = msh + (size_t)mr * NMOD + lane * 8; const float* sc = msc + (size_t)mr * NMOD + lane * 8;
#pragma unroll
        for (int j = 0; j < 8; ++j) {
            const f32x4 y0 = v[j][0] * rstd * *(const f32x4*)(gg + 512 * j) + *(const f32x4*)(bb + 512 * j), y1 = v[j][1] * rstd * *(const f32x4*)(gg + 512 * j + 4) + *(const f32x4*)(bb + 512 * j + 4);
            if (writeOut) { if (row < NLAT) { *(f32x4*)(oo + 512 * j) = y0; *(f32x4*)(oo + 512 * j + 4) = y1; } }
            else lo[64 * j] = (u32x4){pkh(y0[0], y0[1]), pkh(y0[2], y0[3]), pkh(y1[0], y1[1]), pkh(y1[2], y1[3])};
            if (writeH) { const f32x4 h0 = y0 * (*(const f32x4*)(sc + 512 * j) + 1.0f) + *(const f32x4*)(sh + 512 * j), h1 = y1 * (*(const f32x4*)(sc + 512 * j + 4) + 1.0f) + *(const f32x4*)(sh + 512 * j + 4);
                ho[64 * j] = (u32x4){pkh(h0[0], h0[1]), pkh(h0[2], h0[3]), pkh(h1[0], h1[1]), pkh(h1[2], h1[3])}; } }
    }
}
__device__ __forceinline__ void ph_convfix(const Args& a, int l, int Mrows, int tid) {
    const float* GE = (const float*)(a.ws + WS_SLAB); const float* XP = GE + (size_t)34 * 2 * DFF; const float* UPE = XP + (size_t)34 * 2 * DFF;
    f16* ACT = (f16*)(a.ws + WS_ACT);
    const float* cw = a.conv_w + (size_t)l * 3 * DFF;
    constexpr int NF4 = DFF / 4;
    const int nitems = (Mrows / 256) * 2 * NF4;
    for (int it = blockIdx.x * 512 + tid; it < nitems; it += gridDim.x * 512) {
        const int pe = it / NF4, f = (it - pe * NF4) * 4, pm = pe >> 1, e = pe & 1;
        f32x4 x = *(const f32x4*)(XP + (size_t)pe * DFF + f); const f32x4 up = *(const f32x4*)(UPE + (size_t)pe * DFF + f);
        const bool has = e == 0 ? !(pm >= 32 || (pm & 15) == 0) : !(pm >= 32 || (pm & 15) == 15);
        if (has) { const f32x4 ge = *(const f32x4*)(GE + (size_t)((e ? pm + 1 : pm - 1) * 2 + (e ? 0 : 1)) * DFF + f); const f32x4 w = *(const f32x4*)(cw + (e ? 2 : 0) * DFF + f); x += w * ge; }
        float o[4];
#pragma unroll
        for (int j = 0; j < 4; ++j) o[j] = x[j] * sigmoidf_(x[j]) * up[j];
        *(u32x2*)(ACT + (size_t)(pm * 256 + 255 * e) * DFF + f) = (u32x2){pkh(o[0], o[1]), pkh(o[2], o[3])};
    }
}

namespace att {
constexpr int D = 128, NW = 8, QBLK = 32, KVBLK = 64;
constexpr float SCALE = ATT_SCALE;
constexpr float THR = 8.f;
constexpr int LDQ = INW, LDK = INW, LDO = 3072;
constexpr size_t SHM_V = KVBLK * D * 2, SHM_K = KVBLK * D * 2, SHM_ATTN = 2 * SHM_V + 2 * SHM_K + NW * 64 * 4;
#define KSWZ(row, colB) ((row) * 256 + ((colB) ^ (((row) & 7) << 4)))
#define SBAR() __builtin_amdgcn_sched_barrier(0)
__device__ __forceinline__ int crow(int r, int hi) { return (r & 3) + 8 * (r >> 2) + 4 * hi; }
struct Unit { const f16* Q; const f16* Kc; const f16* Vc; const f16* Kl; const f16* Vl; f16* O; int NT; int qpos0; int kpos0; float sink; int has_sink; };
template <bool MASK>
__device__ __forceinline__ void partialSM(f32x16& p0, f32x16& p1, float& m_reg, float& mn, float& alpha, int dq, bool domask) {
    constexpr float C = SCALE * 1.4426950408889634f;
    if (MASK) { if (domask) {
#pragma unroll
        for (int r = 0; r < 16; ++r) { const int k0 = (r & 3) + 8 * (r >> 2); const int d0 = dq - k0, d1 = dq - 32 - k0;
            p0[r] = (d0 > 128 || d0 < -128) ? -1e30f : p0[r]; p1[r] = (d1 > 128 || d1 < -128) ? -1e30f : p1[r]; } } }
    float pmax = p0[0];
#pragma unroll
    for (int r = 1; r < 16; ++r) pmax = fmaxf(pmax, p0[r]);
#pragma unroll
    for (int r = 0; r < 16; ++r) pmax = fmaxf(pmax, p1[r]);
    { auto rr = __builtin_amdgcn_permlane32_swap(__float_as_uint(pmax), __float_as_uint(pmax), false, false);
      pmax = fmaxf(__uint_as_float(rr[0]), __uint_as_float(rr[1])); }
    if (__builtin_expect(__all(pmax - m_reg <= THR / SCALE), 1)) { mn = m_reg; alpha = 1.f; }
    else { mn = fmaxf(m_reg, pmax); alpha = __builtin_amdgcn_exp2f((m_reg - mn) * C); m_reg = mn; }
    const float mnC = -mn * C;
#pragma unroll
    for (int r = 0; r < 16; ++r) p0[r] = fmaf(p0[r], C, mnC);
#pragma unroll
    for (int r = 0; r < 16; ++r) p1[r] = fmaf(p1[r], C, mnC);
#pragma unroll
    for (int r = 0; r < 16; ++r) p0[r] = __builtin_amdgcn_exp2f(p0[r]);
}
__device__ __forceinline__ void finishSM(f32x16& p0, f32x16& p1, float alpha, float& l_reg, h8& pa0, h8& pa1, h8& pa2, h8& pa3) {
#pragma unroll
    for (int r = 0; r < 16; ++r) p1[r] = __builtin_amdgcn_exp2f(p1[r]);
    float ps = 0;
#pragma unroll
    for (int r = 0; r < 16; ++r) ps += p0[r];
#pragma unroll
    for (int r = 0; r < 16; ++r) ps += p1[r];
    { auto rr = __builtin_amdgcn_permlane32_swap(__float_as_uint(ps), __float_as_uint(ps), false, false);
      ps = __uint_as_float(rr[0]) + __uint_as_float(rr[1]); }
    l_reg = l_reg * alpha + ps;
#define PK4(P, BASE, OUT) do { unsigned a0 = pkh(P[BASE + 0], P[BASE + 1]), a1 = pkh(P[BASE + 2], P[BASE + 3]);   \
    unsigned b0 = pkh(P[BASE + 4], P[BASE + 5]), b1 = pkh(P[BASE + 6], P[BASE + 7]);                              \
    auto r0 = __builtin_amdgcn_permlane32_swap(a0, b0, false, false); auto r1 = __builtin_amdgcn_permlane32_swap(a1, b1, false, false); \
    u32x4 w = {r0[0], r1[0], r0[1], r1[1]}; OUT = __builtin_bit_cast(h8, w); } while (0)
    PK4(p0, 0, pa0); PK4(p0, 8, pa1); PK4(p1, 0, pa2); PK4(p1, 8, pa3);
#undef PK4
}
__device__ __forceinline__ void qkt(f32x16& p0, f32x16& p1, const char* Ks, const h8* qr, int r32, int hi) {
    p0 = f32x16{}; p1 = f32x16{};
#pragma unroll
    for (int d0 = 0; d0 < 8; ++d0) { const int cb = (d0 * 16 + hi * 8) * 2;
        const h8 b0 = *reinterpret_cast<const h8*>(Ks + KSWZ(r32, cb));
        const h8 b1 = *reinterpret_cast<const h8*>(Ks + KSWZ(32 + r32, cb));
        p0 = __builtin_amdgcn_mfma_f32_32x32x16_f16(b0, qr[d0], p0, 0, 0, 0);
        p1 = __builtin_amdgcn_mfma_f32_32x32x16_f16(b1, qr[d0], p1, 0, 0, 0); }
}
__device__ __forceinline__ int v_st(int k, int c) { const int kk = (k & ~0xC) | ((k & 4) << 1) | ((k & 8) >> 1); return ((kk >> 3) * 4 + (c >> 5)) * 512 + ((kk & 7) * 32 + (c & 31)) * 2; }
__device__ __forceinline__ int v_rd_base(int lane) { return ((lane & 3) << 3) | (((lane >> 2) & 3) << 6) | (((lane >> 4) & 1) << 5) | (((lane >> 5) & 1) << 8); }
constexpr int v_rd_off(int d0, int ks, int half) { return d0 * 512 + ks * 4096 + half * 2048; }
template <int OFF> __device__ __forceinline__ s16x4 tr_read(int vb) {
    s16x4 r; asm volatile("ds_read_b64_tr_b16 %0, %1 offset:%2" : "=&v"(r) : "v"(vb), "i"(OFF) : "memory"); return r;
}
template <int D0> __device__ __forceinline__ void pv_one(f32x16& od, int vb, h8 pa0, h8 pa1, h8 pa2, h8 pa3) {
    const s16x4 l0 = tr_read<v_rd_off(D0, 0, 0)>(vb), h0 = tr_read<v_rd_off(D0, 0, 1)>(vb), l1 = tr_read<v_rd_off(D0, 1, 0)>(vb), h1 = tr_read<v_rd_off(D0, 1, 1)>(vb);
    const s16x4 l2 = tr_read<v_rd_off(D0, 2, 0)>(vb), h2_ = tr_read<v_rd_off(D0, 2, 1)>(vb), l3 = tr_read<v_rd_off(D0, 3, 0)>(vb), h3 = tr_read<v_rd_off(D0, 3, 1)>(vb);
    asm volatile("s_waitcnt lgkmcnt(0)" ::: "memory"); SBAR();
#define PK(L, H) __builtin_bit_cast(h8, (__attribute__((ext_vector_type(8))) short){L[0], L[1], L[2], L[3], H[0], H[1], H[2], H[3]})
    od = __builtin_amdgcn_mfma_f32_32x32x16_f16(pa0, PK(l0, h0), od, 0, 0, 0);
    od = __builtin_amdgcn_mfma_f32_32x32x16_f16(pa1, PK(l1, h1), od, 0, 0, 0);
    od = __builtin_amdgcn_mfma_f32_32x32x16_f16(pa2, PK(l2, h2_), od, 0, 0, 0);
    od = __builtin_amdgcn_mfma_f32_32x32x16_f16(pa3, PK(l3, h3), od, 0, 0, 0);
#undef PK
}
__device__ __forceinline__ void pv_d0(f32x16* o, int vb, h8 pa0, h8 pa1, h8 pa2, h8 pa3) {
    pv_one<0>(o[0], vb, pa0, pa1, pa2, pa3); pv_one<1>(o[1], vb, pa0, pa1, pa2, pa3); pv_one<2>(o[2], vb, pa0, pa1, pa2, pa3); pv_one<3>(o[3], vb, pa0, pa1, pa2, pa3);
}
template <bool MASK>
__device__ __forceinline__ void attn_unit(const Unit& u, char* lds, const int wave0) {
    int tid = tid_of(wave0); asm volatile("" : "+v"(tid));
    const int wid = tid >> 6, lane = tid & 63, r32 = lane & 31, hi = lane >> 5;
    char* V_lds = lds; char* K_lds = lds + 2 * SHM_V;
    float* ws = (float*)(lds + 2 * SHM_V + 2 * SHM_K) + wid * 64; float* li_l = ws; float* al_l = ws + 32;
    float m_reg = u.has_sink ? u.sink * (1.0f / SCALE) : -1e30f, l_reg = u.has_sink ? 1.0f : 0.0f; f32x16 o[4] = {}; h8 qr[8];
    const f16* Qw = u.Q + (long)(wid * QBLK + r32) * LDQ + hi * 8;
#pragma unroll
    for (int d0 = 0; d0 < 8; ++d0) qr[d0] = *reinterpret_cast<const h8*>(Qw + d0 * 16);
    const int sr = tid >> 4, sc = (tid & 15) * 8, vst0 = v_st(sr, sc), vst1 = v_st(32 + sr, sc);
    const int vb0 = (int)(uintptr_t)V_lds + v_rd_base(lane);
    struct { h8 vs0, vs1, ks0, ks1; } sr_[2];
    const int qposw = u.qpos0 + wid * QBLK + r32;
#define TILEK(j) ((j) < 4 ? u.Kc + (long)(j) * KVBLK * LDK : u.Kl + (long)((j) - 4) * KVBLK * LDK)
#define TILEV(j) ((j) < 4 ? u.Vc + (long)(j) * KVBLK * LDK : u.Vl + (long)((j) - 4) * KVBLK * LDK)
#define SLOAD(i, j) do { const f16* kp_ = TILEK(j); const f16* vp_ = TILEV(j); sr_[i].vs0 = *(const h8*)(vp_ + (long)sr * LDK + sc); sr_[i].vs1 = *(const h8*)(vp_ + (long)(32 + sr) * LDK + sc); \
    sr_[i].ks0 = *(const h8*)(kp_ + (long)sr * LDK + sc); sr_[i].ks1 = *(const h8*)(kp_ + (long)(32 + sr) * LDK + sc); } while (0)
#define SWRITE(b, i) do { *(h8*)(V_lds + (b) * SHM_V + vst0) = sr_[i].vs0;          \
    *(h8*)(V_lds + (b) * SHM_V + vst1) = sr_[i].vs1; const int kc = sc * 2;               \
    *(h8*)(K_lds + (b) * SHM_K + KSWZ(sr, kc)) = sr_[i].ks0;                       \
    *(h8*)(K_lds + (b) * SHM_K + KSWZ(32 + sr, kc)) = sr_[i].ks1; } while (0)
#define SWAIT() asm volatile("s_waitcnt vmcnt(4)" ::: "memory")
#define RESC(a) do { if (__any((a) < 1.f)) { if (hi == 0) al_l[r32] = (a); asm volatile("s_waitcnt lgkmcnt(0)" ::: "memory"); \
    _Pragma("unroll") for (int d = 0; d < 4; ++d) _Pragma("unroll") for (int r = 0; r < 16; ++r) o[d][r] *= al_l[crow(r, hi)]; } } while (0)
#define DQ(j) (qposw - (u.kpos0 + ((j) - 4) * KVBLK) - 4 * hi)
    f32x16 pA0, pA1, pB0, pB1; float mnA, mnB, alA, alB; h8 pa0, pa1, pa2, pa3; const int NT = u.NT;
    constexpr int SE = 0, SO = 1;
    SLOAD(SE, 0); asm volatile("s_waitcnt vmcnt(0)" ::: "memory"); SWRITE(0, SE); __syncthreads();
    qkt(pA0, pA1, K_lds, qr, r32, hi); partialSM<MASK>(pA0, pA1, m_reg, mnA, alA, 0, false);
    SLOAD(SO, 1); if (2 < NT) SLOAD(SE, 2);
    SWAIT(); SWRITE(1, SO); __syncthreads();
    for (int j = 1; j + 1 < NT; j += 2) {
        SBAR(); qkt(pB0, pB1, K_lds + SHM_K, qr, r32, hi);
        finishSM(pA0, pA1, alA, l_reg, pa0, pa1, pa2, pa3); SBAR();
        SLOAD(SO, j + 2); SBAR();
        pv_d0(o, vb0, pa0, pa1, pa2, pa3); partialSM<MASK>(pB0, pB1, m_reg, mnB, alB, DQ(j), j >= 4);
        __syncthreads(); SWAIT(); SWRITE(0, SE);
        RESC(alB); __syncthreads();
        SBAR(); qkt(pA0, pA1, K_lds, qr, r32, hi);
        finishSM(pB0, pB1, alB, l_reg, pa0, pa1, pa2, pa3); SBAR();
        if (j + 3 < NT) SLOAD(SE, j + 3); SBAR();
        pv_d0(o, vb0 + (int)SHM_V, pa0, pa1, pa2, pa3); partialSM<MASK>(pA0, pA1, m_reg, mnA, alA, DQ(j + 1), j + 1 >= 4);
        __syncthreads(); SWAIT(); SWRITE(1, SO);
        RESC(alA); __syncthreads();
    }
    SBAR(); qkt(pB0, pB1, K_lds + SHM_K, qr, r32, hi);
    finishSM(pA0, pA1, alA, l_reg, pa0, pa1, pa2, pa3); SBAR();
    pv_d0(o, vb0, pa0, pa1, pa2, pa3); partialSM<MASK>(pB0, pB1, m_reg, mnB, alB, DQ(NT - 1), NT - 1 >= 4);
    __syncthreads(); RESC(alB);
    finishSM(pB0, pB1, alB, l_reg, pa0, pa1, pa2, pa3); SBAR();
    pv_d0(o, vb0 + (int)SHM_V, pa0, pa1, pa2, pa3);
    if (hi == 0) li_l[r32] = l_reg; asm volatile("s_waitcnt lgkmcnt(0)" ::: "memory");
    float rli[16];
#pragma unroll
    for (int r = 0; r < 16; ++r) rli[r] = __builtin_amdgcn_rcpf(li_l[crow(r, hi)]);
    f16* Ow = u.O + (long)(wid * QBLK) * LDO;
#pragma unroll
    for (int r = 0; r < 16; ++r) { const int orow = crow(r, hi);
#pragma unroll
        for (int d0 = 0; d0 < 4; ++d0) Ow[(long)orow * LDO + d0 * 32 + r32] = (f16)(o[d0][r] * rli[r]); }
    __syncthreads();
#undef TILEK
#undef TILEV
#undef SLOAD
#undef SWRITE
#undef SWAIT
#undef RESC
#undef DQ
}
}

__device__ __forceinline__ int chunk_row0(int cidx) { const int b = cidx / 34, cid = cidx - b * 34; return cid < 2 ? NLAT + b * CTXL + cid * 128 : b * SEQ + (cid - 2) * 128; }
constexpr int RS = 136;
template <int NOUT>
__device__ __forceinline__ void load_transposed(const f16* src, LAS f16* T0, LAS f16* T1, float lg0, float lg1, int tid) {
#pragma unroll
    for (int it = 0; it < 4; ++it) { const int idx = tid + it * 512, g = idx >> 7, t = idx & 127;
        const h8 x = *(const h8*)(src + (size_t)t * INW + g * 8);
        if (NOUT == 1) {
#pragma unroll
            for (int i = 0; i < 8; ++i) T0[(g * 8 + i) * RS + t] = x[i];
        } else {
            const float wf = __builtin_amdgcn_exp2f(lg0 * (float)(127 - t)), wb = __builtin_amdgcn_exp2f(lg1 * (float)t);
#pragma unroll
            for (int i = 0; i < 8; ++i) { T0[(g * 8 + i) * RS + t] = (f16)((float)x[i] * wf); T1[(g * 8 + i) * RS + t] = (f16)((float)x[i] * wb); }
        } }
}
__device__ __forceinline__ void load_rows(const f16* src, size_t ld, LAS f16* T, int tid) {
#pragma unroll
    for (int it = 0; it < 4; ++it) { const int idx = tid + it * 512, r = idx >> 4, c = (idx & 15) * 8;
        *(LAS h8*)(T + r * RS + c) = *(const h8*)(src + (size_t)r * ld + c); }
}
__device__ __forceinline__ void ret_c1_unit(const Args& a, int l, int cidx, int h, LAS unsigned char* lds, const int wave0) {
    int tid = tid_of(wave0); asm volatile("" : "+v"(tid));
    const int lane = tid & 63, wave = __builtin_amdgcn_readfirstlane(tid >> 6);
    const f16* P = (const f16*)(a.ws + WS_P);
    float* UT = (float*)(a.ws + WS_UT);
    LAS f16* VT = (LAS f16*)lds; LAS f16* KTf = VT + 128 * RS; LAS f16* KTb = KTf + 128 * RS;
    const float lgf = -__expf(a.ret_decay[(l * 2 + 0) * 8 + h]) * 1.4426950408889634f, lgb = -__expf(a.ret_decay[(l * 2 + 1) * 8 + h]) * 1.4426950408889634f;
    const int row0 = chunk_row0(cidx);
    load_transposed<1>(P + (size_t)row0 * INW + VR_OFF + h * HD, VT, VT, 0.f, 0.f, tid);
    load_transposed<2>(P + (size_t)row0 * INW + KR_OFF + h * HD, KTf, KTb, lgf, lgb, tid);
    __syncthreads();
    const int fr = lane & 15, fq = lane >> 4;
    f32x4 af[8], ab[8];
#pragma unroll
    for (int n = 0; n < 8; ++n) { af[n] = (f32x4){0.f, 0.f, 0.f, 0.f}; ab[n] = af[n]; }
#pragma unroll
    for (int ks = 0; ks < 4; ++ks) {
        const h8 A = *(const LAS h8*)(VT + (16 * wave + fr) * RS + 32 * ks + 8 * fq);
#pragma unroll
        for (int n = 0; n < 8; ++n) {
            const h8 Bf = *(const LAS h8*)(KTf + (16 * n + fr) * RS + 32 * ks + 8 * fq);
            const h8 Bb = *(const LAS h8*)(KTb + (16 * n + fr) * RS + 32 * ks + 8 * fq);
            af[n] = __builtin_amdgcn_mfma_f32_16x16x32_f16(Bf, A, af[n], 0, 0, 0);
            ab[n] = __builtin_amdgcn_mfma_f32_16x16x32_f16(Bb, A, ab[n], 0, 0, 0);
        }
    }
    float* uf = UT + ((size_t)(cidx * 8 + h) * 2 + 0) * 16384 + (16 * wave + fr) * 128 + 4 * fq; float* ub = uf + 16384;
#pragma unroll
    for (int n = 0; n < 8; ++n) { *(f32x4*)(uf + 16 * n) = af[n]; *(f32x4*)(ub + 16 * n) = ab[n]; }
    __syncthreads();
}
__device__ __forceinline__ void ph_scan(const Args& a, int l, int tid) {
    const float* UT = (const float*)(a.ws + WS_UT); f16* ST = (f16*)(a.ws + WS_ST);
    for (int it = blockIdx.x * 512 + tid; it < NBATCH * 8 * 2 * 4096; it += gridDim.x * 512) {
        const int e4 = it & 4095, dir = (it >> 12) & 1, h = (it >> 13) & 7, b = it >> 16;
        const float decay = __expf(-__expf(a.ret_decay[(l * 2 + dir) * 8 + h]) * 128.0f);
        f32x4 s = {0.f, 0.f, 0.f, 0.f};
#pragma unroll 17
        for (int i = 0; i < 34; ++i) {
            const int cid = dir == 0 ? i : (i < 2 ? 1 - i : 35 - i);
            const size_t off = ((size_t)((b * 34 + cid) * 8 + h) * 2 + dir) * 16384 + (size_t)e4 * 4;
            const f32x4 uv = *(const f32x4*)(UT + off);
            *(u32x2*)(ST + off) = (u32x2){pkh(s[0], s[1]), pkh(s[2], s[3])};
            s = s * decay + uv;
        }
    }
}
__device__ __forceinline__ void ret_c3_unit(const Args& a, int l, int cidx, int h, LAS unsigned char* lds, const int wave0) {
    int tid = tid_of(wave0); asm volatile("" : "+v"(tid));
    const int lane = tid & 63, wave = __builtin_amdgcn_readfirstlane(tid >> 6);
    unsigned char* wsl = a.ws; asm volatile("" : "+s"(wsl));
    const f16* P = (const f16*)(wsl + WS_P);
    const f16* ST = (const f16*)(wsl + WS_ST);
    f16* Yc = (f16*)(wsl + WS_Y) + 2048;
    LAS f16* KS = (LAS f16*)lds; LAS f16* VT = KS + 128 * RS; LAS f16* ATT = VT + 128 * RS + wave * 16 * RS;
    const float lgf = -__expf(a.ret_decay[(l * 2 + 0) * 8 + h]) * 1.4426950408889634f, lgb = -__expf(a.ret_decay[(l * 2 + 1) * 8 + h]) * 1.4426950408889634f;
    const int row0 = chunk_row0(cidx);
    const int fr = lane & 15, fq = lane >> 4;
    const int pc = 16 * wave + fr;
    const f16* STf = ST + ((size_t)(cidx * 8 + h) * 2 + 0) * 16384; const f16* STb = STf + 16384;
    h8 kr[4], vr[4], sf[4], sb[4], qf[4]; h4 grv[8]; f32x4 gnv[8];
#pragma unroll
    for (int it = 0; it < 4; ++it) { const int idx = tid + it * 512, r = idx >> 4, c = (idx & 15) * 8, g = idx >> 7, t = idx & 127;
        kr[it] = *(const h8*)(P + (size_t)(row0 + r) * INW + KR_OFF + h * HD + c);
        vr[it] = *(const h8*)(P + (size_t)(row0 + t) * INW + VR_OFF + h * HD + g * 8); }
#pragma unroll
    for (int ks = 0; ks < 4; ++ks) qf[ks] = *(const h8*)(P + (size_t)(row0 + pc) * INW + QR_OFF + h * HD + 32 * ks + 8 * fq);
#pragma unroll
    for (int it = 0; it < 4; ++it) { const int idx = tid + it * 512, r = idx >> 4, c = (idx & 15) * 8; sf[it] = *(const h8*)(STf + r * 128 + c); }
    const float* gn = a.ret_gn_g + l * 1024 + h * HD;
#pragma unroll
    for (int it = 0; it < 4; ++it) { const int idx = tid + it * 512, r = idx >> 4, c = (idx & 15) * 8, g = idx >> 7, t = idx & 127;
        *(LAS h8*)(KS + r * RS + c) = kr[it];
#pragma unroll
        for (int i = 0; i < 8; ++i) VT[(g * 8 + i) * RS + t] = vr[it][i]; }
    __syncthreads();
#pragma unroll
    for (int it = 0; it < 4; ++it) { const int idx = tid + it * 512, r = idx >> 4, c = (idx & 15) * 8; sb[it] = *(const h8*)(STb + r * 128 + c); }
#pragma unroll
    for (int n = 0; n < 8; ++n) grv[n] = *(const h4*)(P + (size_t)(row0 + pc) * INW + GR_OFF + h * HD + 16 * n + 4 * fq);
    f32x4 acc[8];
#pragma unroll
    for (int n = 0; n < 8; ++n) acc[n] = (f32x4){0.f, 0.f, 0.f, 0.f};
#pragma unroll
    for (int ks = 0; ks < 4; ++ks)
#pragma unroll
        for (int n = 0; n < 8; ++n) acc[n] = __builtin_amdgcn_mfma_f32_16x16x32_f16(*(const LAS h8*)(KS + (16 * n + fr) * RS + 32 * ks + 8 * fq), qf[ks], acc[n], 0, 0, 0);
#pragma unroll
    for (int n = 0; n < 8; ++n) { h4 w;
#pragma unroll
        for (int r = 0; r < 4; ++r) { const int m = 16 * n + 4 * fq + r, dl = pc - m;
            const float wgt = dl >= 0 ? __builtin_amdgcn_exp2f(lgf * (float)dl) : __builtin_amdgcn_exp2f(lgb * (float)(-dl));
            w[r] = (f16)(acc[n][r] * wgt); }
        *(LAS h4*)(ATT + fr * RS + 16 * n + 4 * fq) = w; }
    __syncthreads();
#pragma unroll
    for (int it = 0; it < 4; ++it) { const int idx = tid + it * 512, r = idx >> 4, c = (idx & 15) * 8; *(LAS h8*)(KS + r * RS + c) = sf[it]; }
    f32x4 o[8];
#pragma unroll
    for (int n = 0; n < 8; ++n) o[n] = (f32x4){0.f, 0.f, 0.f, 0.f};
#pragma unroll
    for (int ks = 0; ks < 4; ++ks) { const h8 B = *(const LAS h8*)(ATT + fr * RS + 32 * ks + 8 * fq);
#pragma unroll
        for (int n = 0; n < 8; ++n) o[n] = __builtin_amdgcn_mfma_f32_16x16x32_f16(*(const LAS h8*)(VT + (16 * n + fr) * RS + 32 * ks + 8 * fq), B, o[n], 0, 0, 0); }
    __syncthreads();
#pragma unroll
    for (int it = 0; it < 4; ++it) { const int idx = tid + it * 512, r = idx >> 4, c = (idx & 15) * 8; *(LAS h8*)(VT + r * RS + c) = sb[it]; }
#pragma unroll
    for (int n = 0; n < 8; ++n) acc[n] = (f32x4){0.f, 0.f, 0.f, 0.f};
#pragma unroll
    for (int ks = 0; ks < 4; ++ks)
#pragma unroll
        for (int n = 0; n < 8; ++n) acc[n] = __builtin_amdgcn_mfma_f32_16x16x32_f16(*(const LAS h8*)(KS + (16 * n + fr) * RS + 32 * ks + 8 * fq), qf[ks], acc[n], 0, 0, 0);
    { const float dq = __builtin_amdgcn_exp2f(lgf * (float)(pc + 1));
#pragma unroll
      for (int n = 0; n < 8; ++n) o[n] += dq * acc[n]; }
    __syncthreads();
#pragma unroll
    for (int n = 0; n < 8; ++n) gnv[n] = *(const f32x4*)(gn + 16 * n + 4 * fq);
#pragma unroll
    for (int n = 0; n < 8; ++n) acc[n] = (f32x4){0.f, 0.f, 0.f, 0.f};
#pragma unroll
    for (int ks = 0; ks < 4; ++ks)
#pragma unroll
        for (int n = 0; n < 8; ++n) acc[n] = __builtin_amdgcn_mfma_f32_16x16x32_f16(*(const LAS h8*)(VT + (16 * n + fr) * RS + 32 * ks + 8 * fq), qf[ks], acc[n], 0, 0, 0);
    { const float dq = __builtin_amdgcn_exp2f(lgb * (float)(128 - pc));
#pragma unroll
      for (int n = 0; n < 8; ++n) o[n] += dq * acc[n]; }
    float s = 0.f;
#pragma unroll
    for (int n = 0; n < 8; ++n) s += (o[n][0] + o[n][1]) + (o[n][2] + o[n][3]);
    s += __shfl_xor(s, 16); s += __shfl_xor(s, 32);
    const float mean = s * (1.0f / 128.0f); float q = 0.f;
#pragma unroll
    for (int n = 0; n < 8; ++n) { const f32x4 d = o[n] - mean; q += (d[0] * d[0] + d[1] * d[1]) + (d[2] * d[2] + d[3] * d[3]); }
    q += __shfl_xor(q, 16); q += __shfl_xor(q, 32);
    const float rstd = 1.0f / sqrtf(q * (1.0f / 128.0f) + GN_EPS);
    f16* yrow = Yc + (size_t)(row0 + pc) * 3072 + h * HD + 4 * fq;
#pragma unroll
    for (int n = 0; n < 8; ++n) { h4 w;
#pragma unroll
        for (int r = 0; r < 4; ++r) { const float gr = (float)grv[n][r]; w[r] = (f16)(gr * sigmoidf_(gr) * ((o[n][r] - mean) * rstd * gnv[n][r])); }
        *(h4*)(yrow + 16 * n) = w; }
    __syncthreads();
}

constexpr int N_PHASES = 26;
__global__ void __launch_bounds__(512, 2) mixer_fwd(Args a) {
    extern __shared__ __attribute__((aligned(16))) unsigned char lds_raw[];
    LAS unsigned char* lds = (LAS unsigned char*)lds_raw;
    const int tid = threadIdx.x, lane = tid & 63, wave = __builtin_amdgcn_readfirstlane(tid >> 6);
    const int wave0 = wave;
    const int G = gridDim.x;
    volatile LAS unsigned* MISC = (volatile LAS unsigned*)(lds + MISC_OFF);
    for (int u = tid; u < (LDS_BYTES - RING_BYTES) / 4; u += 512) ((LAS unsigned*)(lds + RING_BYTES))[u] = 0u;
    __syncthreads();
    unsigned* ctl = (unsigned*)(a.ws + WS_CTL);
    XcdBarrier bar; bar.bar = ctl + CW_BAR; bar.x = 0; bar.st = nullptr;
    if (!MK_PER_PHASE) bar = xcd_barrier_post(ctl + CW_BAR, MISC + 8, tid);
    const int lo = a.ph_lo, hi = a.ph_hi;
#ifndef PH_MASK
#define PH_MASK 0xFFFFFFFFu
#endif
#define PH_ON(b) (((PH_MASK) >> (b)) & 1u)
#ifndef RPT_MASK
#define RPT_MASK 0u
#endif
#define NREP(b) ((((RPT_MASK) >> (b)) & 1u) ? 2 : 1)
#define REPBAR(b, rep) do { if (NREP(b) == 2 && (rep) == 0) xcd_barrier(bar, wave0); } while (0)
#define IN(k) (lo <= (k) && (k) < hi)
#define SEAM(k) do { if (IN(k)) { if ((k) >= 2) bg_convert(a, lds, MISC, (k), G, wave0); if (IN((k) + 1)) xcd_barrier(bar, wave0); } } while (0)
#define TL() int tid = tid_of(wave0); asm volatile("" : "+v"(tid)); const int lane = tid & 63, wave = __builtin_amdgcn_readfirstlane(tid >> 6); (void)lane; (void)wave;
#define WSP() unsigned char* ws_ = a.ws; asm volatile("" : "+s"(ws_)); \
    float* MOD = (float*)(ws_ + WS_MOD); f16* H = (f16*)(ws_ + WS_H); f16* P = (f16*)(ws_ + WS_P); f16* Y = (f16*)(ws_ + WS_Y); f16* MH = (f16*)(ws_ + WS_MH); \
    f16* Z = (f16*)(ws_ + WS_Z); f16* LAT = (f16*)(ws_ + WS_LAT); f16* ACT = (f16*)(ws_ + WS_ACT); float* slab = (float*)(ws_ + WS_SLAB); unsigned* ctl_ = (unsigned*)(ws_ + WS_CTL); \
    const float* modl = MOD + (size_t)l * 3 * NMOD; (void)H; (void)P; (void)Y; (void)MH; (void)Z; (void)LAT; (void)ACT; (void)slab; (void)ctl_; (void)modl;
    if (PH_ON(0) && IN(0)) _Pragma("unroll") for (int rep_ = 0; rep_ < NREP(0); ++rep_) { {
        if (blockIdx.x == 0) rope_table((f32x2*)(a.ws + WS_ROPE), tid);
        if (G >= 256) {
            if ((int)blockIdx.x < 128) ph_modgemv(a, lds, tid, lane, wave, (int)blockIdx.x, 128, 128);
            else ph_convert0(a, lds, lane, wave, (int)blockIdx.x - 128, G - 128);
        } else { ph_modgemv(a, lds, tid, lane, wave, (int)blockIdx.x, 256, G); ph_convert0(a, lds, lane, wave, (int)blockIdx.x, G); }
    } REPBAR(0, rep_); }
    SEAM(0);
    if (PH_ON(1) && IN(1)) _Pragma("unroll") for (int rep_ = 0; rep_ < NREP(1); ++rep_) { { ph_modulate0(a, lane, wave); } REPBAR(1, rep_); }
    SEAM(1);

#pragma unroll 1
    for (int l = 0; l < 2; ++l) {
        const int pb = 2 + 12 * l;
        const bool last = (l == 1);
        const int Mrows = last ? NLAT : MTOT;
        if (PH_ON(2) && IN(pb + 0)) _Pragma("unroll") for (int rep_ = 0; rep_ < NREP(2); ++rep_) { { WSP();
            pg8::Gemm g{H, (const f16*)(a.ws + WS_WIN + l * SZ_WIN), MTOT, INW, DM}; pg8::SKOrder S; S.init(last ? NLAT : MTOT, INW, DM, G, (int)blockIdx.x, last ? 24 : 0);
            pg8::EpiIn E{P, (const f32x2*)(ws_ + WS_ROPE), a.q_norm_g + l * HD, a.k_norm_g + l * HD, (LAS float*)(lds + RING_BYTES + 1024), (f16*)(ws_ + WS_GLT), a.b_gate + l * 3 * DM};
            pg8::gemm_phase<pg8::EpiIn, pg8::SKOrder>(lds, g, S, E, pg8::SKCtx{slab, ctl_ + CW_SK + (l * 5 + 0) * SK_BANK}, wave0);
        } REPBAR(2, rep_); }
        do { if (IN(pb + 0)) { bg_convert(a, lds, MISC, pb + 0, G, wave0); if (IN(pb + 1) || IN(pb + 2)) xcd_barrier(bar, wave0); } } while (0);
        if (PH_ON(4) && IN(pb + 2)) _Pragma("unroll") for (int rep_ = 0; rep_ < NREP(4); ++rep_) { { WSP();
            for (int ui = blockIdx.x; ui < 256; ui += G) {
                const int b = ui >> 7, h = (ui >> 4) & 7, qb = ui & 15, g = h >> 2;
                const int kl0 = qb == 0 ? 0 : qb * 256 - 128, kend = qb == 15 ? SEQ : qb * 256 + 384;
                att::Unit u;
                u.Q = P + (size_t)(b * SEQ + qb * 256) * INW + QA_OFF + h * HD;
                u.Kc = P + (size_t)(NLAT + b * CTXL) * INW + KA_OFF + g * HD; u.Vc = P + (size_t)(NLAT + b * CTXL) * INW + VA_OFF + g * HD;
                u.Kl = P + (size_t)(b * SEQ + kl0) * INW + KA_OFF + g * HD; u.Vl = P + (size_t)(b * SEQ + kl0) * INW + VA_OFF + g * HD;
                u.O = Y + (size_t)(b * SEQ + qb * 256) * 3072 + h * HD; u.NT = 4 + (kend - kl0) / 64; u.qpos0 = qb * 256; u.kpos0 = kl0;
                u.sink = a.attn_sink[l * 8 + h]; u.has_sink = 1;
                att::attn_unit<true>(u, (char*)lds_raw, wave0);
            }
            if (!last) {
                for (int v = blockIdx.x; v < 32; v += G) {
                    const int isB = v >> 4, b = (v >> 3) & 1, h = v & 7, g = h >> 2;
                    att::Unit u;
                    const size_t r0 = (size_t)(NLAT + b * CTXL);
                    u.Q = P + r0 * INW + (isB ? QB_OFF : QA_OFF) + h * HD;
                    u.Kc = P + r0 * INW + (isB ? KB_OFF : KA_OFF) + g * HD; u.Vc = P + r0 * INW + (isB ? VB_OFF : VA_OFF) + g * HD;
                    u.Kl = u.Kc; u.Vl = u.Vc; u.O = Y + r0 * 3072 + (isB ? 1024 : 0) + h * HD; u.NT = 4; u.qpos0 = 0; u.kpos0 = 0;
                    u.sink = a.attn_sink[l * 8 + h]; u.has_sink = isB ? 0 : 1;
                    att::attn_unit<false>(u, (char*)lds_raw, wave0);
                }
            }
            for (int v = G - 1 - (int)blockIdx.x; v < NCHUNK * 8; v += G) ret_c1_unit(a, l, v >> 3, v & 7, lds, wave0);
        } REPBAR(4, rep_); }
        SEAM(pb + 2);
        if (PH_ON(5) && IN(pb + 3)) _Pragma("unroll") for (int rep_ = 0; rep_ < NREP(5); ++rep_) { { TL(); ph_scan(a, l, tid); } REPBAR(5, rep_); }
        SEAM(pb + 3);
        if (PH_ON(6) && IN(pb + 4)) _Pragma("unroll") for (int rep_ = 0; rep_ < NREP(6); ++rep_) { { WSP();
            for (int ui = blockIdx.x; ui < 256; ui += G) {
                const int b = ui >> 7, h = (ui >> 4) & 7, qb = ui & 15, g = h >> 2;
                att::Unit u;
                u.Q = P + (size_t)(b * SEQ + qb * 256) * INW + QB_OFF + h * HD;
                u.Kc = P + (size_t)(NLAT + b * CTXL) * INW + KB_OFF + g * HD; u.Vc = P + (size_t)(NLAT + b * CTXL) * INW + VB_OFF + g * HD;
                u.Kl = P + (size_t)(b * SEQ) * INW + KB_OFF + g * HD; u.Vl = P + (size_t)(b * SEQ) * INW + VB_OFF + g * HD;
                u.O = Y + (size_t)(b * SEQ + qb * 256) * 3072 + 1024 + h * HD; u.NT = 4 + SEQ / 64; u.qpos0 = 0; u.kpos0 = 0; u.sink = 0.f; u.has_sink = 0;
                att::attn_unit<false>(u, (char*)lds_raw, wave0);
            }
            for (int v = G - 1 - (int)blockIdx.x; v < NCHUNK * 8; v += G) {
                if (last && (v >> 3) % 34 < 2) continue;
                ret_c3_unit(a, l, v >> 3, v & 7, lds, wave0);
            }
        } REPBAR(6, rep_); }
        SEAM(pb + 4);
        if (PH_ON(7) && IN(pb + 5)) _Pragma("unroll") for (int rep_ = 0; rep_ < NREP(7); ++rep_) { { WSP();
            pg8::Gemm g{Y, (const f16*)(a.ws + WS_WBR + l * SZ_WBR), Mrows, DM, 3072}; pg8::SKOrder S; S.init(Mrows, DM, 3072, G, (int)blockIdx.x);
            pg8::EpiGateK E{(const f16*)(ws_ + WS_GLT), MH};
            pg8::gemm_phase<pg8::EpiGateK, pg8::SKOrder>(lds, g, S, E, pg8::SKCtx{slab, ctl_ + CW_SK + (l * 5 + 1) * SK_BANK}, wave0);
        } REPBAR(7, rep_); }
        SEAM(pb + 5);
        if (PH_ON(8) && IN(pb + 6)) _Pragma("unroll") for (int rep_ = 0; rep_ < NREP(8); ++rep_) { { WSP();
            pg8::Gemm g{MH, (const f16*)(a.ws + WS_WO + l * SZ_WO), Mrows, DM, DM}; pg8::SKOrder S; S.init(Mrows, DM, DM, G, (int)blockIdx.x, 0, 1);
            pg8::EpiResLN E{l == 0 ? (const void*)a.x : (const void*)LAT, l == 0 ? (const void*)a.ctx : (const void*)(LAT + (size_t)NLAT * DM), modl + 2 * DM, l == 0 ? 0 : 1,
                            a.ln1_g + l * DM, a.ln1_b + l * DM, modl + 3 * DM, modl + 4 * DM, LAT, H, a.out, 0,
                            (unsigned long long*)(slab + (size_t)4 * 1024 * 1024), ctl_ + CW_LN + (l * 2 + 0) * LN_BANK, lds + RING_BYTES + 1024};
            pg8::gemm_phase<pg8::EpiResLN, pg8::SKOrder>(lds, g, S, E, pg8::SKCtx{slab, ctl_ + CW_SK + (l * 5 + 2) * SK_BANK}, wave0);
        } REPBAR(8, rep_); }
        do { if (IN(pb + 6)) { bg_convert(a, lds, MISC, pb + 6, G, wave0); if (IN(pb + 7) || IN(pb + 8)) xcd_barrier(bar, wave0); } } while (0);
        if (PH_ON(10) && IN(pb + 8)) _Pragma("unroll") for (int rep_ = 0; rep_ < NREP(10); ++rep_) { { WSP();
            pg8::Gemm g{H, (const f16*)(a.ws + WS_WUP + l * SZ_WUP), Mrows, 2 * DFF, DM}; pg8::SKOrder S; S.init(Mrows, 2 * DFF, DM, G, (int)blockIdx.x);
            pg8::EpiConv E{a.conv_w + (size_t)l * 3 * DFF, a.conv_b + (size_t)l * DFF, ACT, slab, slab + (size_t)34 * 2 * DFF, slab + (size_t)2 * 34 * 2 * DFF, (LAS float*)(lds + RING_BYTES + 1024)};
            pg8::gemm_phase<pg8::EpiConv, pg8::SKOrder>(lds, g, S, E, pg8::SKCtx{slab, ctl_ + CW_SK + (l * 5 + 3) * SK_BANK}, wave0);
        } REPBAR(10, rep_); }
        SEAM(pb + 8);
        if (PH_ON(11) && IN(pb + 9)) _Pragma("unroll") for (int rep_ = 0; rep_ < NREP(11); ++rep_) { { TL(); ph_convfix(a, l, Mrows, tid); } REPBAR(11, rep_); }
        SEAM(pb + 9);
        if (PH_ON(12) && IN(pb + 10)) _Pragma("unroll") for (int rep_ = 0; rep_ < NREP(12); ++rep_) { { WSP();
            const float* modn = MOD + (size_t)(l + 1) * 3 * NMOD;
            int Gs_ = G; asm volatile("" : "+s"(Gs_));
            const bool sk8 = SK8_DN && l == 0 && Gs_ == 256;
            pg8::Gemm g{ACT, (const f16*)(a.ws + WS_WDN + l * SZ_WDN), Mrows, DM, DFF}; pg8::SKOrder S; S.init(sk8 ? NLAT : Mrows, DM, DFF, G, (int)blockIdx.x, 0, 1);
            pg8::EpiResLN E{(const void*)LAT, (const void*)(LAT + (size_t)NLAT * DM), modl + 5 * DM, 1,
                            a.ln2_g + l * DM, a.ln2_b + l * DM, last ? modl : modn, last ? modl : modn + DM, LAT, H, a.out, last ? 1 : 0,
                            (unsigned long long*)(slab + (size_t)4 * 1024 * 1024), ctl_ + CW_LN + (l * 2 + 1) * LN_BANK, lds + RING_BYTES + 1024};
            pg8::gemm_phase<pg8::EpiResLN, pg8::SKOrder>(lds, g, S, E, pg8::SKCtx{slab, ctl_ + CW_SK + (l * 5 + 4) * SK_BANK}, wave0);
            if (sk8) { pg8::SK8Order S8; S8.init(DFF, (int)blockIdx.x);
                pg8::gemm_phase<pg8::EpiResLN, pg8::SK8Order, true, true, true>(lds, g, S8, E, pg8::SKCtx{(float*)(ws_ + WS_MF), ctl_ + CW_SK + (l * 5 + 4) * SK_BANK}, wave0); }
        } REPBAR(12, rep_); }
        if (!last) do { if (IN(pb + 10)) { bg_convert(a, lds, MISC, pb + 10, G, wave0); if (IN(pb + 11) || IN(pb + 12)) xcd_barrier(bar, wave0); } } while (0);
    }
#undef IN
#undef SEAM
}

extern "C" void kernel_launch(void* const* d_in, const int* in_sizes, int n_in, void* d_out, int out_size, void* d_ws, size_t ws_size, hipStream_t stream) {
    static int grid = 0;
    if (grid == 0) {
        if (n_in != 23 || out_size != NLAT * DM || ws_size < WS_END) { fprintf(stderr, "kernel_launch: unexpected shapes (n_in %d out %d ws %zu, need %zu)\n", n_in, out_size, ws_size, (size_t)WS_END); grid = -1; return; }
        int dev = 0, cus = 0, per_cu = 0;
        if (hipGetDevice(&dev) != hipSuccess || hipDeviceGetAttribute(&cus, hipDeviceAttributeMultiprocessorCount, dev) != hipSuccess) { grid = -1; return; }
        if (hipFuncSetAttribute((const void*)mixer_fwd, hipFuncAttributeMaxDynamicSharedMemorySize, LDS_BYTES) != hipSuccess) { fprintf(stderr, "kernel_launch: hipFuncSetAttribute failed\n"); grid = -1; return; }
        if (hipOccupancyMaxActiveBlocksPerMultiprocessor(&per_cu, (const void*)mixer_fwd, 512, LDS_BYTES) != hipSuccess || per_cu < 1)
            fprintf(stderr, "kernel_launch: occupancy query reports %d workgroups per CU\n", per_cu);
        (void)hipGetLastError();
        grid = cus;
    }
    if (grid < 0) return;
    if (hipMemsetAsync((char*)d_ws + WS_CTL, 0, CTL_ZERO_BYTES, stream) != hipSuccess) return;
    Args a{};
    const float** ap = (const float**)&a;
    for (int i = 0; i < 23; ++i) ap[i] = (const float*)d_in[i];
    a.out = (float*)d_out; a.ws = (unsigned char*)d_ws; a.li = 0; a.pad = 0;
#if MK_PER_PHASE
    for (int p = 0; p < N_PHASES; ++p) { a.ph_lo = p; a.ph_hi = p + 1; hipLaunchKernelGGL(mixer_fwd, dim3(grid), dim3(512), LDS_BYTES, stream, a); }
#else
    a.ph_lo = 0; a.ph_hi = N_PHASES;
    hipLaunchKernelGGL(mixer_fwd, dim3(grid), dim3(512), LDS_BYTES, stream, a);
#endif
    const hipError_t le = hipPeekAtLastError();
    if (le != hipSuccess) fprintf(stderr, "kernel_launch: launch failed: %s\n", hipGetErrorName(le));
}
```
